# Optimizing an MI355X kernel written in HIP

```python
import math
import jax, jax.numpy as jnp
from jax import lax
import numpy as np

D_MODEL = 2048
BATCH = 2
SEQ = 8192
DEPTH = 4

MIX_WIDTH = D_MODEL
N_MIXERS = 4
GROUP_WIDTH = MIX_WIDTH // N_MIXERS
HEAD_DIM = 128
N_HEADS = GROUP_WIDTH // HEAD_DIM
LRU_BLOCKS = 8
LRU_BLOCK_DIM = GROUP_WIDTH // LRU_BLOCKS
LRU_C = 8.0
SHORT_CONV = 4
FFN_CONV = 3
D_FF = ((8 * D_MODEL // 3 + 255) // 256) * 256
FOX_BLOCK = 128
GDN_CHUNK = 64
DILATED_PAIRS = ((128, 1), (512, 4), (2048, 16))
EPS = 1e-6
NEG_INF = -1e30

IN_SIZES = (GROUP_WIDTH, GROUP_WIDTH,
            3 * GROUP_WIDTH, N_HEADS,
            3 * GROUP_WIDTH, GROUP_WIDTH, N_HEADS, N_HEADS,
            3 * GROUP_WIDTH)
IN_COLS = sum(IN_SIZES)

kernel_name = "hybrid_parallel_heads_rglru_fox_gdn_dilated"


def rmsnorm(x, gain):
    xf = x.astype(jnp.float32)
    y = xf * lax.rsqrt(jnp.mean(xf * xf, axis=-1, keepdims=True) + EPS)
    return (y * gain).astype(x.dtype)


def group_rmsnorm(y, gain, group):
    B, T, W = y.shape
    yg = y.astype(jnp.float32).reshape(B, T, W // group, group)
    yg = yg * lax.rsqrt(jnp.mean(yg * yg, axis=-1, keepdims=True) + EPS)
    return yg.reshape(B, T, W) * gain


def causal_dwconv(x, w, b=None):
    K = w.shape[0]
    T = x.shape[1]
    xp = jnp.pad(x, ((0, 0), (K - 1, 0), (0, 0)))
    y = sum(xp[:, k:k + T, :] * w[k] for k in range(K))
    return y if b is None else y + b


def split_cols(z, sizes):
    idx = np.cumsum(sizes)[:-1].tolist()
    return jnp.split(z, idx, axis=-1)


def to_heads(z):
    B, T, W = z.shape
    return z.reshape(B, T, W // HEAD_DIM, HEAD_DIM).transpose(0, 2, 1, 3)


def from_heads(z):
    B, H, T, d = z.shape
    return z.transpose(0, 2, 1, 3).reshape(B, T, H * d)


def l2norm(t):
    return t * lax.rsqrt(jnp.sum(t * t, axis=-1, keepdims=True) + EPS)


def rg_lru(xa, conv_w, conv_b, wa, ba, wx, bx, lam):
    B, T, W = xa.shape
    xc = causal_dwconv(xa, conv_w, conv_b).astype(jnp.float32)
    xb = xc.reshape(B, T, LRU_BLOCKS, LRU_BLOCK_DIM)
    r = jax.nn.sigmoid(jnp.einsum('btnc,ncd->btnd', xb, wa).reshape(B, T, W) + ba)
    i = jax.nn.sigmoid(jnp.einsum('btnc,ncd->btnd', xb, wx).reshape(B, T, W) + bx)
    log_a = -LRU_C * r * jax.nn.softplus(-lam)
    a = jnp.exp(log_a)
    u = jnp.sqrt(-jnp.expm1(2.0 * log_a)) * (i * xc)

    def combine(left, right):
        a_l, h_l = left
        a_r, h_r = right
        return a_l * a_r, a_r * h_l + h_r

    _, h = lax.associative_scan(combine, (a, u), axis=1)
    return h


def forgetting_attention(q, k, v, log_f):
    B, H, T, hd = q.shape
    nb = T // FOX_BLOCK
    c = jnp.cumsum(log_f, axis=-1)
    q = q * hd ** -0.5
    qb = jnp.moveaxis(q.reshape(B, H, nb, FOX_BLOCK, hd), 2, 0)
    cb = jnp.moveaxis(c.reshape(B, H, nb, FOX_BLOCK), 2, 0)
    starts = jnp.arange(nb) * FOX_BLOCK
    kpos = jnp.arange(T)

    def block(args):
        q_blk, c_blk, start = args
        s = jnp.einsum('bhqd,bhkd->bhqk', q_blk, k).astype(jnp.float32)
        s = s + c_blk[..., :, None] - c[..., None, :]
        qpos = start + jnp.arange(FOX_BLOCK)
        s = jnp.where(kpos[None, :] <= qpos[:, None], s, NEG_INF)
        p = jax.nn.softmax(s, axis=-1)
        return jnp.einsum('bhqk,bhkd->bhqd', p.astype(v.dtype), v)

    o = lax.map(block, (qb, cb, starts))
    return jnp.moveaxis(o, 0, 2).reshape(B, H, T, hd)


def gated_delta_rule(q, k, v, g, beta):
    B, H, T, dk = q.shape
    dv = v.shape[-1]
    C = GDN_CHUNK
    N = T // C
    q = q * dk ** -0.5
    qc = q.reshape(B, H, N, C, dk)
    kc = k.reshape(B, H, N, C, dk)
    vc = v.reshape(B, H, N, C, dv)
    bc = beta.reshape(B, H, N, C)
    gc = jnp.cumsum(g.reshape(B, H, N, C), axis=-1)
    tril = jnp.tril(jnp.ones((C, C), bool))
    strict = jnp.tril(jnp.ones((C, C), bool), -1)
    diff = gc[..., :, None] - gc[..., None, :]
    decay = jnp.where(tril, jnp.exp(jnp.where(tril, diff, 0.0)), 0.0)
    kbeta = kc * bc[..., None]
    vbeta = vc * bc[..., None]
    kk = jnp.einsum('bhnid,bhnjd->bhnij', kbeta, kc) * decay
    a_mat = jnp.where(strict, kk, 0.0) + jnp.eye(C, dtype=jnp.float32)
    rhs = jnp.concatenate([vbeta, kbeta * jnp.exp(gc)[..., None]], axis=-1)
    sol = lax.linalg.triangular_solve(a_mat, rhs, left_side=True, lower=True, unit_diagonal=True)
    u, w = sol[..., :dv], sol[..., dv:]
    qk = jnp.where(tril, jnp.einsum('bhnid,bhnjd->bhnij', qc, kc) * decay, 0.0)
    xs = tuple(jnp.moveaxis(t, 2, 0) for t in (qc, kc, u, w, qk, gc))

    def step(S, inp):
        q_i, k_i, u_i, w_i, qk_i, g_i = inp
        v_new = u_i - jnp.einsum('bhcd,bhde->bhce', w_i, S)
        o_inter = jnp.einsum('bhcd,bhde->bhce', q_i * jnp.exp(g_i)[..., None], S)
        o = o_inter + jnp.einsum('bhij,bhje->bhie', qk_i, v_new)
        g_last = g_i[..., -1:]
        S = S * jnp.exp(g_last)[..., None] + jnp.einsum(
            'bhcd,bhce->bhde', k_i * jnp.exp(g_last - g_i)[..., None], v_new)
        return S, o

    S0 = jnp.zeros((B, H, dk, dv), jnp.float32)
    _, o = lax.scan(step, S0, xs)
    return jnp.moveaxis(o, 0, 2).reshape(B, H, T, dv)


def gated_deltanet(qkv, z, beta_logit, alpha_logit, conv_w, a_log, dt_bias, norm_g):
    qkv = jax.nn.silu(causal_dwconv(qkv, conv_w)).astype(jnp.float32)
    q, k, v = [to_heads(t) for t in jnp.split(qkv, 3, axis=-1)]
    q, k = l2norm(q), l2norm(k)
    beta = jax.nn.sigmoid(beta_logit.astype(jnp.float32)).transpose(0, 2, 1)
    g = (-jnp.exp(a_log) * jax.nn.softplus(alpha_logit.astype(jnp.float32) + dt_bias)).transpose(0, 2, 1)
    o = gated_delta_rule(q, k, v, g, beta)
    o = o * lax.rsqrt(jnp.mean(o * o, axis=-1, keepdims=True) + EPS) * norm_g
    o = o * jax.nn.silu(to_heads(z).astype(jnp.float32))
    return from_heads(o)


def window_attention_lse(q, k, v, span):
    *lead, L, hd = q.shape
    nl = len(lead)
    n = -(-L // span)
    padw = [(0, 0)] * nl + [(0, n * span - L), (0, 0)]

    def blocks(t):
        return jnp.pad(t, padw).reshape(*lead, n, span, hd)

    def with_prev(t):
        prev = jnp.pad(t, [(0, 0)] * nl + [(1, 0), (0, 0), (0, 0)])[..., :-1, :, :]
        return jnp.concatenate([prev, t], axis=-2)

    qb = blocks(q * hd ** -0.5)
    kk = with_prev(blocks(k))
    vv = with_prev(blocks(v))
    s = jnp.einsum('...nqd,...nkd->...nqk', qb, kk).astype(jnp.float32)
    i = jnp.arange(span)[:, None]
    j = jnp.arange(2 * span)[None, :]
    dist = i + span - j
    key_pos = jnp.arange(n)[:, None, None] * span - span + j
    mask = (dist >= 0) & (dist <= span) & (key_pos >= 0)
    s = jnp.where(mask, s, NEG_INF)
    m = jnp.max(s, axis=-1, keepdims=True)
    p = jnp.exp(s - m)
    den = jnp.sum(p, axis=-1, keepdims=True)
    out = jnp.einsum('...nqk,...nkd->...nqd', p.astype(v.dtype), vv) / den.astype(v.dtype)
    lse = (m + jnp.log(den))[..., 0]
    out = out.reshape(*lead, n * span, hd)[..., :L, :]
    lse = lse.reshape(*lead, n * span)[..., :L]
    return out, lse


def dilated_branch(q, k, v, window, dil):
    B, H, T, hd = q.shape
    Td = T // dil

    def to_res(t):
        return t.reshape(B, H, Td, dil, hd).swapaxes(2, 3)

    o, lse = window_attention_lse(to_res(q), to_res(k), to_res(v), window // dil)
    return o.swapaxes(2, 3).reshape(B, H, T, hd), lse.swapaxes(2, 3).reshape(B, H, T)


def dilated_attention(q, k, v):
    outs, lses = [], []
    for window, dil in DILATED_PAIRS:
        o, lse = dilated_branch(q, k, v, window, dil)
        outs.append(o)
        lses.append(lse)
    wts = jax.nn.softmax(jnp.stack(lses), axis=0)
    return jnp.einsum('gbht,gbhtd->bhtd', wts.astype(q.dtype), jnp.stack(outs))


def conv_ffn(h, w_up, conv_w, conv_b, w_down):
    u = causal_dwconv(h @ w_up, conv_w, conv_b)
    up, gate = jnp.split(u, 2, axis=-1)
    return (jax.nn.silu(gate) * up) @ w_down


def setup_inputs(seed: int = 0) -> dict:
    key = jax.random.key(seed)
    ks = iter(jax.random.split(key, 32))
    f32 = jnp.float32

    def nrm(shape, scale):
        return scale * jax.random.normal(next(ks), shape, f32)

    def gain(shape):
        return 1.0 + 0.02 * jax.random.normal(next(ks), shape, f32)

    res_scale = (2 * DEPTH) ** -0.5
    x = jax.random.normal(next(ks), (BATCH, SEQ, D_MODEL), f32)
    norm_mix = gain((DEPTH, D_MODEL))
    w_in = nrm((DEPTH, D_MODEL, IN_COLS), D_MODEL ** -0.5)
    lru_conv_w = nrm((DEPTH, SHORT_CONV, GROUP_WIDTH), SHORT_CONV ** -0.5)
    lru_conv_b = nrm((DEPTH, GROUP_WIDTH), 0.01)
    lru_wa = nrm((DEPTH, LRU_BLOCKS, LRU_BLOCK_DIM, LRU_BLOCK_DIM), LRU_BLOCK_DIM ** -0.5)
    lru_ba = nrm((DEPTH, GROUP_WIDTH), 0.01)
    lru_wx = nrm((DEPTH, LRU_BLOCKS, LRU_BLOCK_DIM, LRU_BLOCK_DIM), LRU_BLOCK_DIM ** -0.5)
    lru_bx = nrm((DEPTH, GROUP_WIDTH), 0.01)
    a_c = jax.random.uniform(next(ks), (DEPTH, GROUP_WIDTH), f32, 0.9, 0.999)
    a_base = a_c ** (1.0 / LRU_C)
    lru_lambda = jnp.log(a_base) - jnp.log1p(-a_base)
    fox_f_bias = 3.0 + nrm((DEPTH, N_HEADS), 0.5)
    gdn_conv_w = nrm((DEPTH, SHORT_CONV, 3 * GROUP_WIDTH), SHORT_CONV ** -0.5)
    gdn_a_log = jnp.log(jax.random.uniform(next(ks), (DEPTH, N_HEADS), f32, 1.0, 16.0))
    dt = jnp.exp(jax.random.uniform(next(ks), (DEPTH, N_HEADS), f32, math.log(1e-3), math.log(1e-1)))
    gdn_dt_bias = dt + jnp.log(-jnp.expm1(-dt))
    gdn_norm = gain((DEPTH, HEAD_DIM))
    norm_a = gain((DEPTH, GROUP_WIDTH))
    norm_b = gain((DEPTH, GROUP_WIDTH))
    norm_d = gain((DEPTH, GROUP_WIDTH))
    w_out = nrm((DEPTH, MIX_WIDTH, D_MODEL), MIX_WIDTH ** -0.5 * res_scale)
    norm_ffn = gain((DEPTH, D_MODEL))
    ffn_w_up = nrm((DEPTH, D_MODEL, 2 * D_FF), D_MODEL ** -0.5)
    ffn_conv_w = nrm((DEPTH, FFN_CONV, 2 * D_FF), FFN_CONV ** -0.5)
    ffn_conv_b = nrm((DEPTH, 2 * D_FF), 0.01)
    ffn_w_down = nrm((DEPTH, D_FF, D_MODEL), D_FF ** -0.5 * res_scale)
    norm_final = gain((D_MODEL,))
    return {"x": x, "norm_mix": norm_mix, "w_in": w_in,
            "lru_conv_w": lru_conv_w, "lru_conv_b": lru_conv_b,
            "lru_wa": lru_wa, "lru_ba": lru_ba, "lru_wx": lru_wx, "lru_bx": lru_bx,
            "lru_lambda": lru_lambda, "fox_f_bias": fox_f_bias,
            "gdn_conv_w": gdn_conv_w, "gdn_a_log": gdn_a_log, "gdn_dt_bias": gdn_dt_bias,
            "gdn_norm": gdn_norm, "norm_a": norm_a, "norm_b": norm_b, "norm_d": norm_d,
            "w_out": w_out, "norm_ffn": norm_ffn, "ffn_w_up": ffn_w_up,
            "ffn_conv_w": ffn_conv_w, "ffn_conv_b": ffn_conv_b, "ffn_w_down": ffn_w_down,
            "norm_final": norm_final}


def reference(x, norm_mix, w_in, lru_conv_w, lru_conv_b, lru_wa, lru_ba, lru_wx, lru_bx,
              lru_lambda, fox_f_bias, gdn_conv_w, gdn_a_log, gdn_dt_bias, gdn_norm,
              norm_a, norm_b, norm_d, w_out, norm_ffn, ffn_w_up, ffn_conv_w, ffn_conv_b,
              ffn_w_down, norm_final):
    for l in range(DEPTH):
        h = rmsnorm(x, norm_mix[l])
        z = h @ w_in[l]
        a_x, a_gate, b_qkv, b_f, c_qkv, c_z, c_beta, c_alpha, d_qkv = split_cols(z, IN_SIZES)

        h_a = rg_lru(a_x, lru_conv_w[l], lru_conv_b[l], lru_wa[l], lru_ba[l],
                     lru_wx[l], lru_bx[l], lru_lambda[l])
        y_a = group_rmsnorm(h_a, norm_a[l], LRU_BLOCK_DIM) * jax.nn.gelu(a_gate.astype(jnp.float32))

        bq, bk, bv = [to_heads(t) for t in jnp.split(b_qkv, 3, axis=-1)]
        log_f = jax.nn.log_sigmoid(b_f.astype(jnp.float32) + fox_f_bias[l]).transpose(0, 2, 1)
        y_b = group_rmsnorm(from_heads(forgetting_attention(bq, bk, bv, log_f)), norm_b[l], HEAD_DIM)

        y_c = gated_deltanet(c_qkv, c_z, c_beta, c_alpha, gdn_conv_w[l], gdn_a_log[l],
                             gdn_dt_bias[l], gdn_norm[l])

        dq, dk, dv = [to_heads(t) for t in jnp.split(d_qkv, 3, axis=-1)]
        y_d = group_rmsnorm(from_heads(dilated_attention(dq, dk, dv)), norm_d[l], HEAD_DIM)

        y = jnp.concatenate([y_a, y_b, y_c, y_d], axis=-1).astype(x.dtype)
        x = x + y @ w_out[l]

        h = rmsnorm(x, norm_ffn[l])
        x = x + conv_ffn(h, ffn_w_up[l], ffn_conv_w[l], ffn_conv_b[l], ffn_w_down[l])
    return rmsnorm(x, norm_final)
```

```cpp
#include <hip/hip_runtime.h>
#include <hip/hip_cooperative_groups.h>
#include <cstdio>
#include <cstdint>
namespace cg = cooperative_groups;
namespace pg8 {
#define PG8_LAS __attribute__((address_space(3)))
typedef unsigned short bf16_t;
typedef short bf16x8 __attribute__((ext_vector_type(8)));
typedef float f32x4 __attribute__((ext_vector_type(4)));
typedef unsigned u32x4 __attribute__((ext_vector_type(4)));
constexpr int BM = 256, BK = 64, HALF = 128, HTB = HALF * BK * 2  , STAGE_BYTES = 8 * HTB, NXCD = 8, WGM = 8;

__host__ __device__ __forceinline__ int lds_byte(int r, int c) { const int st = (r >> 4) * 2 + (c >> 5), rr = r & 15, cc = c & 31, ob = rr * 64 + cc * 2; return st * 1024 + (ob ^ (((ob >> 9) & 1) << 5)); }
__host__ __device__ __forceinline__ void stage_rc(int b, int& R, int& C) { const int st = b / 1024, sb = b % 1024, swz = sb ^ (((sb >> 9) & 1) << 5); R = (st >> 1) * 16 + swz / 64; C = (st & 1) * 32 + (swz % 64) / 2; }
__host__ __device__ __forceinline__ int perm32(int rho) { const int n = rho >> 4, i = rho & 15; return 8 * (i >> 2) + 4 * n + (i & 3); }

struct Unit { int pm, pn; };
struct Gemm { const bf16_t* A; const bf16_t* Bt; int M, N, K; };

struct StaticOrder {
    int nM, nN, nwg, G, c;
    __host__ __device__ void init(int M, int N, int G_, int c_) { nM = M / BM; nN = N / BM; nwg = nM * nN; G = G_; c = c_; }
    __host__ __device__ bool next(int i, Unit& u) const {
        const long L = (long)i * G + c; if (L >= nwg) return false;
        int wgid = (int)L; { const int q = nwg / NXCD, r = nwg % NXCD, xcd = wgid % NXCD, off = wgid / NXCD; wgid = (xcd < r ? xcd * (q + 1) : r * (q + 1) + (xcd - r) * q) + off; }
        const int nig = WGM * nN, gid = wgid / nig, fm = gid * WGM, gsz = (nM - fm) < WGM ? (nM - fm) : WGM;
        u.pm = fm + ((wgid % nig) % gsz); u.pn = (wgid % nig) / gsz; return true;
    }
    __device__ __forceinline__ void a_ready(const Unit&) const {}
    __device__ __forceinline__ void done(const Unit&) const {}
};

__device__ __forceinline__ unsigned cvt_pk_bf16(float lo, float hi) { unsigned r; asm volatile("v_cvt_pk_bf16_f32 %0, %1, %2" : "=v"(r) : "v"(lo), "v"(hi)); return r; }
typedef float f32x2 __attribute__((ext_vector_type(2)));
__device__ __forceinline__ f32x2 gelu_pk(f32x2 v) {
    const f32x2 av = __builtin_elementwise_abs(v), d = av * 0.2316418882f + 1.0f;
    f32x2 t; t.x = __builtin_amdgcn_rcpf(d.x); t.y = __builtin_amdgcn_rcpf(d.y);
    f32x2 q = t * 0.5307027145f + (-0.7265760135f); q = q * t + 0.7107068705f; q = q * t + (-0.142248368f); q = q * t + 0.127414796f; q = q * t;
    const f32x2 s = (v * v) * (-0.72134752044f);
    f32x2 e; e.x = __builtin_amdgcn_exp2f(s.x); e.y = __builtin_amdgcn_exp2f(s.y);
    const f32x2 m = v * (q * e), r = v - m;
    f32x2 o; o.x = v.x < 0.f ? m.x : r.x; o.y = v.y < 0.f ? m.y : r.y; return o;
}

template <int ACT  > struct EpiBf16 {
    static constexpr bool PERM = true, AFTER_DRAIN = false; static_assert(ACT == 0 || ACT == 1, "EpiBf16: ACT is 0 (none) or 1 (gelu_pk)");
    bf16_t* O; int ldc; const float* bias; int split_cols; size_t split_stride; float scale0;
    __device__ __forceinline__ void operator()(const f32x4 (&acc)[2][2][4][2], const Unit& u, int wr, int wc, int fr, int fq) const {
        const int row0 = u.pm * BM + wr * 64 + fr; int colt = u.pn * BM; bf16_t* base = O;
        float sc = 1.f; if (split_cols) { const int t = colt / split_cols; base += (size_t)t * split_stride; colt -= t * split_cols; if (t == 0) sc = scale0; }
        const int col0 = colt + wc * 32 + 8 * fq, bcol0 = u.pn * BM + wc * 32 + 8 * fq;
        f32x4 bv[2][2];
#pragma unroll
        for (int bj = 0; bj < 2; ++bj)
#pragma unroll
            for (int n = 0; n < 2; ++n) bv[bj][n] = bias ? *(const f32x4*)(bias + bcol0 + bj * HALF + 4 * n) : (f32x4){0.f, 0.f, 0.f, 0.f};
#pragma unroll
        for (int ai = 0; ai < 2; ++ai)
#pragma unroll
            for (int m = 0; m < 4; ++m) { bf16_t* rowp = base + (size_t)(row0 + ai * HALF + m * 16) * ldc + col0;
#pragma unroll
                for (int bj = 0; bj < 2; ++bj) { f32x4 v0 = acc[ai][bj][m][0] + bv[bj][0], v1 = acc[ai][bj][m][1] + bv[bj][1];
                    if (ACT == 1) { f32x2 a = gelu_pk((f32x2){v0[0], v0[1]}), b = gelu_pk((f32x2){v0[2], v0[3]}), c = gelu_pk((f32x2){v1[0], v1[1]}), d = gelu_pk((f32x2){v1[2], v1[3]});
                        v0 = (f32x4){a.x, a.y, b.x, b.y}; v1 = (f32x4){c.x, c.y, d.x, d.y}; }
                    v0 = v0 * sc; v1 = v1 * sc; u32x4 w; w.x = cvt_pk_bf16(v0[0], v0[1]); w.y = cvt_pk_bf16(v0[2], v0[3]); w.z = cvt_pk_bf16(v1[0], v1[1]); w.w = cvt_pk_bf16(v1[2], v1[3]);
                    *(u32x4*)(rowp + bj * HALF) = w; } }
    }
};
template <class Epi, class Sched, bool ALIGN_EPI = false, bool SP2 = false>
__device__ __forceinline__ void gemm_phase(PG8_LAS unsigned char* lds, const Gemm g, const Sched& S, const Epi& E) {
    int tid_l = threadIdx.x; asm volatile("" : "+v"(tid_l)); const int tid = tid_l, wid = __builtin_amdgcn_readfirstlane(tid >> 6), lane = tid & 63, wr = wid >> 2, wc = wid & 3, fr = lane & 15, fq = lane >> 4;
    const int K = g.K, nt = K / BK;
    unsigned voffA[2], voffB[2];
#pragma unroll
    for (int i = 0; i < 2; ++i) { int R, C; stage_rc(tid * 16 + i * 8192, R, C); const int Rb = Epi::PERM ? ((R & ~31) + perm32(R & 31)) : R;
        voffA[i] = (unsigned)(R * K + C) * 2u; voffB[i] = (unsigned)(Rb * K + C) * 2u; }
    const size_t kstep = (size_t)(BK * 2);
    const size_t hstep = (size_t)HALF * K * 2;
    const size_t tstep = 2 * hstep;
    const unsigned ldsw = (unsigned)wid * 1024u;
    const int aoff = lds_byte(wr * 64 + fr, fq * 8), boff = lds_byte(wc * 32 + fr, fq * 8);
#define PG8_SA(b, h) (((b) * 2 + (h)) * HTB)
#define PG8_SB(b, h) ((4 + (b) * 2 + (h)) * HTB)
#define PG8_STAGE(bufoff, gbase, voff) do { _Pragma("unroll") for (int _i = 0; _i < 2; ++_i) \
        __builtin_amdgcn_global_load_lds((const unsigned*)((const char*)(gbase) + (voff)[_i]), (PG8_LAS unsigned*)(lds + (bufoff) + ldsw + _i * 8192), 16, 0, 0); } while (0)
#define PG8_LDA(dst, b, h) do { _Pragma("unroll") for (int m = 0; m < 4; ++m) _Pragma("unroll") for (int k = 0; k < 2; ++k) dst[m][k] = *(const PG8_LAS bf16x8*)(lds + PG8_SA(b, h) + aoff + m * 2048 + k * 1024); } while (0)
#define PG8_LDB(dst, b, h) do { _Pragma("unroll") for (int n = 0; n < 2; ++n) _Pragma("unroll") for (int k = 0; k < 2; ++k) dst[n][k] = *(const PG8_LAS bf16x8*)(lds + PG8_SB(b, h) + boff + n * 2048 + k * 1024); } while (0)
#define PG8_MMA(ai, bj, At, Bt) do { __builtin_amdgcn_s_setprio(1); _Pragma("unroll") for (int m = 0; m < 4; ++m) _Pragma("unroll") for (int n = 0; n < 2; ++n) _Pragma("unroll") for (int k = 0; k < 2; ++k) \
        acc[ai][bj][m][n] = __builtin_amdgcn_mfma_f32_16x16x32_bf16(Bt[n][k], At[m][k], acc[ai][bj][m][n], 0, 0, 0); __builtin_amdgcn_s_setprio(0); } while (0)
#define PG8_WAIT_V(n) asm volatile("s_waitcnt vmcnt(" #n ")" ::: "memory")
#define PG8_WAIT_L(n) asm volatile("s_waitcnt lgkmcnt(" #n ")" ::: "memory")
#define PG8_BAR __builtin_amdgcn_s_barrier()
#define PG8_SCHED __builtin_amdgcn_sched_barrier(0)
    Unit cur, nxt; int ui = 0;
    if (!S.next(0, cur)) return;
    f32x4 acc[2][2][4][2];
#pragma unroll
    for (int a = 0; a < 2; ++a)
#pragma unroll
        for (int b = 0; b < 2; ++b)
#pragma unroll
            for (int m = 0; m < 4; ++m)
#pragma unroll
                for (int n = 0; n < 2; ++n) acc[a][b][m][n] = (f32x4){0.f, 0.f, 0.f, 0.f};
    bf16x8 At[4][2], B0[2][2], B1[2][2];
    const char* cA = (const char*)g.A + (size_t)cur.pm * tstep; const char* cB = (const char*)g.Bt + (size_t)cur.pn * tstep;
    S.a_ready(cur);
    if constexpr (SP2) {
        PG8_STAGE(PG8_SB(0, 0), cB, voffB); PG8_STAGE(PG8_SB(0, 1), cB + hstep, voffB); PG8_STAGE(PG8_SA(0, 0), cA, voffA); PG8_STAGE(PG8_SA(0, 1), cA + hstep, voffA);
        if (wr == 1) PG8_BAR;
        PG8_WAIT_V(2); PG8_BAR;
        PG8_STAGE(PG8_SB(1, 0), cB + kstep, voffB); PG8_STAGE(PG8_SA(1, 0), cA + kstep, voffA); PG8_STAGE(PG8_SB(1, 1), cB + hstep + kstep, voffB);
        PG8_WAIT_V(6); PG8_BAR;
    } else {
        PG8_STAGE(PG8_SB(0, 0), cB, voffB); PG8_STAGE(PG8_SA(0, 0), cA, voffA); PG8_STAGE(PG8_SB(0, 1), cB + hstep, voffB); PG8_STAGE(PG8_SA(0, 1), cA + hstep, voffA);
        if (wr == 1) PG8_BAR;
        PG8_WAIT_V(4); PG8_BAR;
        PG8_STAGE(PG8_SB(1, 0), cB + kstep, voffB); PG8_STAGE(PG8_SA(1, 0), cA + kstep, voffA); PG8_STAGE(PG8_SB(1, 1), cB + hstep + kstep, voffB);
        PG8_WAIT_V(6); PG8_BAR;
    }
    for (;;) {
        const bool has_next = S.next(ui + 1, nxt);
        const char* nA = has_next ? (const char*)g.A + (size_t)nxt.pm * tstep : cA; const char* nB = has_next ? (const char*)g.Bt + (size_t)nxt.pn * tstep : cB;
        for (int t = 0; t < nt; t += 2) {
            const bool last = (t == nt - 2);
            const char* a1 = cA + (size_t)(t + 1) * kstep;
            const char* a2 = last ? nA : cA + (size_t)(t + 2) * kstep; const char* b2 = last ? nB : cB + (size_t)(t + 2) * kstep;
            const char* a3 = a2 + kstep; const char* b3 = b2 + kstep;
            if (last && has_next) S.a_ready(nxt);
            if constexpr (SP2) {
            PG8_LDB(B0, 0, 0); PG8_LDB(B1, 0, 1); PG8_SCHED; PG8_LDA(At, 0, 0); PG8_STAGE(PG8_SA(1, 1), a1 + hstep, voffA);
            PG8_WAIT_V(8); PG8_WAIT_L(0); PG8_BAR; PG8_MMA(0, 0, At, B0); PG8_MMA(0, 1, At, B1); PG8_BAR; PG8_SCHED;
            PG8_LDA(At, 0, 1); PG8_STAGE(PG8_SB(0, 0), b2, voffB); PG8_STAGE(PG8_SB(0, 1), b2 + hstep, voffB); PG8_STAGE(PG8_SA(0, 0), a2, voffA);
            PG8_WAIT_V(8); PG8_WAIT_L(0); PG8_BAR; PG8_MMA(1, 0, At, B0); PG8_MMA(1, 1, At, B1); PG8_BAR; PG8_SCHED;
            PG8_LDB(B0, 1, 0); PG8_LDB(B1, 1, 1); PG8_SCHED; PG8_LDA(At, 1, 0); PG8_STAGE(PG8_SA(0, 1), a2 + hstep, voffA);
            PG8_WAIT_V(8); PG8_WAIT_L(0); PG8_BAR; PG8_MMA(0, 0, At, B0); PG8_MMA(0, 1, At, B1); PG8_BAR; PG8_SCHED;
            PG8_LDA(At, 1, 1); PG8_STAGE(PG8_SB(1, 0), b3, voffB); PG8_STAGE(PG8_SB(1, 1), b3 + hstep, voffB); PG8_STAGE(PG8_SA(1, 0), a3, voffA);
            PG8_WAIT_V(8); PG8_WAIT_L(0); PG8_BAR; PG8_MMA(1, 0, At, B0); PG8_MMA(1, 1, At, B1); PG8_BAR; PG8_SCHED;
            } else {
            PG8_LDB(B0, 0, 0); PG8_SCHED; PG8_LDA(At, 0, 0); PG8_STAGE(PG8_SA(1, 1), a1 + hstep, voffA);
            PG8_WAIT_L(8); PG8_BAR; PG8_WAIT_L(0); PG8_MMA(0, 0, At, B0); PG8_BAR; PG8_SCHED;
            PG8_LDB(B1, 0, 1); PG8_STAGE(PG8_SB(0, 0), b2, voffB);
            PG8_BAR; PG8_WAIT_L(0); PG8_MMA(0, 1, At, B1); PG8_BAR;
            PG8_LDA(At, 0, 1); PG8_STAGE(PG8_SA(0, 0), a2, voffA);
            PG8_BAR; PG8_WAIT_L(0); PG8_MMA(1, 0, At, B0); PG8_BAR; PG8_SCHED;
            PG8_STAGE(PG8_SB(0, 1), b2 + hstep, voffB);
            PG8_WAIT_V(6); PG8_BAR; PG8_MMA(1, 1, At, B1); PG8_BAR;
            PG8_LDB(B0, 1, 0); PG8_SCHED; PG8_LDA(At, 1, 0); PG8_STAGE(PG8_SA(0, 1), a2 + hstep, voffA);
            PG8_WAIT_L(8); PG8_BAR; PG8_WAIT_L(0); PG8_MMA(0, 0, At, B0); PG8_BAR; PG8_SCHED;
            PG8_LDB(B1, 1, 1); PG8_STAGE(PG8_SB(1, 0), b3, voffB);
            PG8_BAR; PG8_WAIT_L(0); PG8_MMA(0, 1, At, B1); PG8_BAR;
            PG8_LDA(At, 1, 1); PG8_STAGE(PG8_SA(1, 0), a3, voffA);
            PG8_BAR; PG8_WAIT_L(0); PG8_MMA(1, 0, At, B0); PG8_BAR; PG8_SCHED;
            PG8_STAGE(PG8_SB(1, 1), b3 + hstep, voffB);
            PG8_WAIT_V(6); PG8_BAR; PG8_MMA(1, 1, At, B1); PG8_BAR;
            }
        }
        if constexpr (ALIGN_EPI) { if (wr == 0) PG8_BAR; }
        if constexpr (!Epi::AFTER_DRAIN) { E(acc, cur, wr, wc, fr, fq); S.done(cur); }
        if (!has_next) break;
#pragma unroll
        for (int a = 0; a < 2; ++a)
#pragma unroll
            for (int b = 0; b < 2; ++b)
#pragma unroll
                for (int m = 0; m < 4; ++m)
#pragma unroll
                    for (int n = 0; n < 2; ++n) acc[a][b][m][n] = (f32x4){0.f, 0.f, 0.f, 0.f};
        cur = nxt; cA = nA; cB = nB; ++ui;
        if constexpr (ALIGN_EPI) { if (wr == 1) PG8_BAR; }
    }
    PG8_WAIT_V(0);
    if constexpr (!ALIGN_EPI) { if (wr == 0) PG8_BAR; }
    PG8_BAR;
    if constexpr (Epi::AFTER_DRAIN) { E.fused(acc, cur, wr, wc, fr, fq, lds, wid, lane); S.done(cur); }
#undef PG8_SA
#undef PG8_SB
#undef PG8_STAGE
#undef PG8_LDA
#undef PG8_LDB
#undef PG8_MMA
#undef PG8_WAIT_V
#undef PG8_WAIT_L
#undef PG8_BAR
#undef PG8_SCHED
}
}

#define LAS __attribute__((address_space(3)))
typedef unsigned short bf16_t;
typedef short bf16x8 __attribute__((ext_vector_type(8)));
typedef short s16x4 __attribute__((ext_vector_type(4)));
typedef float f32x4 __attribute__((ext_vector_type(4)));
typedef float f32x16 __attribute__((ext_vector_type(16)));
typedef unsigned u32x4 __attribute__((ext_vector_type(4)));
typedef unsigned u32x2 __attribute__((ext_vector_type(2)));

constexpr int NB = 2, T = 8192, M = NB * T, DM = 2048, NZ = 6144, DFF = 5632, NFF2 = 11264, DEPTH = 4;
constexpr int WIN_COLS = 6156;
constexpr int ZC_AX = 0, ZC_AG = 512, ZC_BQ = 1024, ZC_BK = 1536, ZC_BV = 2048, ZC_CQ = 2560, ZC_CZ = 4096, ZC_DQ = 4608, ZC_DK = 5120, ZC_DV = 5632;
constexpr float EPS = 1e-6f;
constexpr int NTHR = 512;

constexpr size_t MiB = 1u << 20;
constexpr size_t WS_CTL = 0, WS_WIN = 1 * MiB, WS_WOUT = 97 * MiB, WS_WUP = 129 * MiB, WS_WDN = 305 * MiB, WS_WG = 393 * MiB, WS_HB = 394 * MiB, WS_ACT = 458 * MiB;
constexpr size_t WS_Z = 634 * MiB, WS_Y = 826 * MiB, WS_GL = 890 * MiB, WS_FOXC = 891 * MiB, WS_LRUA = 892 * MiB, WS_LRUU = 924 * MiB, WS_LAGG = 956 * MiB;
constexpr size_t WS_GREC = 957 * MiB, WS_GU = 1013 * MiB, WS_GLAST = 1045 * MiB, WS_OC = 1046 * MiB, WS_OD = 1078 * MiB, WS_LSE = 1126 * MiB, WS_END = 1127 * MiB;
constexpr size_t WS_U = 634 * MiB;
constexpr int GREC_BYTES = 57344;

constexpr int LDS_BYTES = 147456;
constexpr int LDS_MISC = 140 * 1024;

__device__ __forceinline__ unsigned f2bf(float f) { unsigned u = __builtin_bit_cast(unsigned, f); return (u + 0x7fffu + ((u >> 16) & 1u)) >> 16; }
__device__ __forceinline__ unsigned pk2(float lo, float hi) { return f2bf(lo) | (f2bf(hi) << 16); }
__device__ __forceinline__ float bf2f(unsigned short u) { return __builtin_bit_cast(float, (unsigned)u << 16); }
__device__ __forceinline__ float bflo(unsigned w) { return __builtin_bit_cast(float, w << 16); }
__device__ __forceinline__ float bfhi(unsigned w) { return __builtin_bit_cast(float, w & 0xffff0000u); }
__device__ __forceinline__ float wave_sum(float v) {
#pragma unroll
    for (int o = 1; o < 64; o <<= 1) v += __shfl_xor(v, o);
    return v;
}
__device__ __forceinline__ float sigmoidf_(float x) { return 1.0f / (1.0f + __expf(-x)); }
__device__ __forceinline__ float siluf_(float x) { return x / (1.0f + __expf(-x)); }
__device__ __forceinline__ float softplusf_(float x) { return fmaxf(x, 0.f) + log1pf(__expf(-fabsf(x))); }
__device__ __forceinline__ float gelu_tanh(float x) { const float u = 0.7978845608028654f * (x + 0.044715f * x * x * x); return 0.5f * x * (1.0f + tanhf(u)); }
__device__ __forceinline__ int perm32(int p) { const int g = p >> 3, j = p & 7; return (j < 4) ? (4 * g + j) : (16 + 4 * g + (j - 4)); }
__device__ __forceinline__ int invperm32(int x) { return (x < 16) ? (8 * (x >> 2) + (x & 3)) : (8 * ((x - 16) >> 2) + 4 + (x & 3)); }

struct Params {
    const float* in[25];
    float* out;
    unsigned char* ws;
};
struct Ctx {
    const LAS unsigned* tab;
    __device__ __forceinline__ unsigned long long ld(int i) const {
        const LAS unsigned* t = tab; asm volatile("" : "+v"(t));
        const unsigned lo = __builtin_amdgcn_readfirstlane(t[2 * i]), hi = __builtin_amdgcn_readfirstlane(t[2 * i + 1]);
        return ((unsigned long long)hi << 32) | lo;
    }
    __device__ __forceinline__ const float* in(int i) const { return (const float*)ld(i); }
    __device__ __forceinline__ float* out() const { return (float*)ld(25); }
    __device__ __forceinline__ unsigned char* ws() const { return (unsigned char*)ld(26); }
};

__device__ __forceinline__ void p0_item(const float* W, int ldw, int ncol0, bf16_t* WT, int K, int nrow0, int k0, LAS float* scr, int lane) {
#pragma unroll 8
    for (int i = 0; i < 32; ++i) { const int kk = 2 * i + (lane >> 5); scr[kk * 33 + (lane & 31)] = W[(size_t)(k0 + kk) * ldw + ncol0 + (lane & 31)]; }
    asm volatile("s_waitcnt lgkmcnt(0)" ::: "memory");
    const int c = lane & 7;
#pragma unroll
    for (int j = 0; j < 4; ++j) {
        const int n = (lane >> 3) + 8 * j; const LAS float* s = scr + (8 * c) * 33 + n;
        u32x4 o; o.x = pk2(s[0 * 33], s[1 * 33]); o.y = pk2(s[2 * 33], s[3 * 33]); o.z = pk2(s[4 * 33], s[5 * 33]); o.w = pk2(s[6 * 33], s[7 * 33]);
        *(u32x4*)(WT + (size_t)(nrow0 + n) * K + k0 + 8 * c) = o;
    }
    asm volatile("s_waitcnt lgkmcnt(0)" ::: "memory");
}
__device__ __forceinline__ int win_orig_col(int p) { return p < 2560 ? p : (p < 4096 ? p + 4 : (p < 4608 ? p + 4 : p + 12)); }

__device__ __forceinline__ void p0_prologue(const Ctx& P, LAS unsigned char* lds, int gw, int NGW, int wave, int lane) {
    LAS float* scr = (LAS float*)(lds + wave * 16384);
    constexpr int I_IN = (DM / 64) * (NZ / 32), I_OUT = (DM / 64) * (DM / 32), I_UP = (DM / 64) * (NFF2 / 32), I_DN = (DFF / 64) * (DM / 32);
    constexpr int PER_L = I_IN + I_OUT + I_UP + I_DN;
    unsigned char* ws = P.ws();
    for (int it = gw; it < PER_L * DEPTH; it += NGW) {
        const int l = it / PER_L; int r = it % PER_L;
        if (r < I_IN) { const int nblk = NZ / 32, kb = r / nblk, nb = r % nblk;
            p0_item(P.in(2) + (size_t)l * DM * WIN_COLS, WIN_COLS, win_orig_col(32 * nb), (bf16_t*)(ws + WS_WIN) + (size_t)l * NZ * DM, DM, 32 * nb, 64 * kb, scr, lane); continue; }
        r -= I_IN;
        if (r < I_OUT) { const int nblk = DM / 32, kb = r / nblk, nb = r % nblk;
            p0_item(P.in(18) + (size_t)l * DM * DM, DM, 32 * nb, (bf16_t*)(ws + WS_WOUT) + (size_t)l * DM * DM, DM, 32 * nb, 64 * kb, scr, lane); continue; }
        r -= I_OUT;
        if (r < I_UP) { const int nblk = NFF2 / 32, kb = r / nblk, nb = r % nblk;
            p0_item(P.in(20) + (size_t)l * DM * NFF2, NFF2, 32 * nb, (bf16_t*)(ws + WS_WUP) + (size_t)l * NFF2 * DM, DM, 32 * nb, 64 * kb, scr, lane); continue; }
        r -= I_UP;
        { const int nblk = DM / 32, kb = r / nblk, nb = r % nblk;
            p0_item(P.in(23) + (size_t)l * DFF * DM, DM, 32 * nb, (bf16_t*)(ws + WS_WDN) + (size_t)l * DM * DFF, DFF, 32 * nb, 64 * kb, scr, lane); }
    }
    float* WG = (float*)(ws + WS_WG);
    const int gt = gw * 64 + lane, NGT = NGW * 64;
    for (int i = gt; i < DEPTH * 12 * DM; i += NGT) {
        const int l = i / (12 * DM), j = (i / DM) % 12, k = i % DM;
        const int col = (j < 4) ? (2560 + j) : (j < 8 ? 4612 + (j - 4) : 4616 + (j - 8));
        WG[i] = P.in(2)[(size_t)l * DM * WIN_COLS + (size_t)k * WIN_COLS + col];
    }
}

template <bool GATES>
__device__ __forceinline__ void norm_phase(const float* src, float* copy_dst, const float* gain, bf16_t* HB, const float* WGl, float* GL,
                                           LAS unsigned char* lds, int tid, int wave, int lane, int bid, int nblk) {
    LAS float* wg = (LAS float*)lds;
    if (GATES) {
        for (int i = tid; i < 12 * DM / 4; i += NTHR) ((LAS f32x4*)wg)[i] = ((const f32x4*)WGl)[i];
        __syncthreads();
    }
    f32x4 gv[8];
#pragma unroll
    for (int j = 0; j < 8; ++j) gv[j] = ((const f32x4*)gain)[lane + 64 * j];
    for (int m = bid * 8 + wave; m < M; m += nblk * 8) {
        const f32x4* xr = (const f32x4*)(src + (size_t)m * DM);
        f32x4 v[8]; float ss = 0.f;
#pragma unroll
        for (int j = 0; j < 8; ++j) { v[j] = xr[lane + 64 * j]; ss += (v[j].x * v[j].x + v[j].y * v[j].y) + (v[j].z * v[j].z + v[j].w * v[j].w); }
        if (copy_dst) {
            f32x4* cr = (f32x4*)(copy_dst + (size_t)m * DM);
#pragma unroll
            for (int j = 0; j < 8; ++j) cr[lane + 64 * j] = v[j];
        }
        const float rs = rsqrtf(wave_sum(ss) * (1.0f / DM) + EPS);
        u32x2* o8 = (u32x2*)(HB + (size_t)m * DM);
#pragma unroll
        for (int j = 0; j < 8; ++j) { v[j] = v[j] * rs * gv[j]; u32x2 w; w.x = pk2(v[j].x, v[j].y); w.y = pk2(v[j].z, v[j].w); o8[lane + 64 * j] = w; }
        if (GATES) {
            float myv = 0.f;
#pragma unroll 1
            for (int g = 0; g < 12; ++g) {
                float a = 0.f;
#pragma unroll
                for (int j = 0; j < 8; ++j) { const f32x4 w = ((LAS f32x4*)(wg + g * DM))[lane + 64 * j]; a += (v[j].x * w.x + v[j].y * w.y) + (v[j].z * w.z + v[j].w * w.w); }
                a = wave_sum(a);
                if (lane == g) myv = a;
            }
            if (lane < 12) GL[(size_t)m * 16 + lane] = myv;
        }
    }
    if (GATES) __syncthreads();
}

__device__ __forceinline__ void final_norm_phase(float* X, const float* gain, int wave, int lane, int bid, int nblk) {
    f32x4 gv[8];
#pragma unroll
    for (int j = 0; j < 8; ++j) gv[j] = ((const f32x4*)gain)[lane + 64 * j];
    for (int m = bid * 8 + wave; m < M; m += nblk * 8) {
        f32x4* xr = (f32x4*)(X + (size_t)m * DM);
        f32x4 v[8]; float ss = 0.f;
#pragma unroll
        for (int j = 0; j < 8; ++j) { v[j] = xr[lane + 64 * j]; ss += (v[j].x * v[j].x + v[j].y * v[j].y) + (v[j].z * v[j].z + v[j].w * v[j].w); }
        const float rs = rsqrtf(wave_sum(ss) * (1.0f / DM) + EPS);
#pragma unroll
        for (int j = 0; j < 8; ++j) xr[lane + 64 * j] = v[j] * rs * gv[j];
    }
}

struct EpiResAdd {
    static constexpr bool PERM = false, AFTER_DRAIN = false;
    float* X; int ldc;
    __device__ __forceinline__ void operator()(const pg8::f32x4 (&acc)[2][2][4][2], const pg8::Unit& u, int wr, int wc, int fr, int fq) const {
#pragma unroll
        for (int ai = 0; ai < 2; ++ai)
#pragma unroll
            for (int m = 0; m < 4; ++m) {
                float* rowp = X + (size_t)(u.pm * 256 + ai * 128 + wr * 64 + m * 16 + fr) * ldc + u.pn * 256 + wc * 32 + 4 * fq;
#pragma unroll
                for (int bj = 0; bj < 2; ++bj)
#pragma unroll
                    for (int n = 0; n < 2; ++n) { pg8::f32x4* p = (pg8::f32x4*)(rowp + bj * 128 + n * 16); *p = *p + acc[ai][bj][m][n]; }
            }
    }
};

__device__ __forceinline__ void lru_chunk_unit(const Ctx& P, int l, int unit, LAS unsigned char* lds, int tid, int wave, int lane) {
    const bf16_t* Z = (const bf16_t*)(P.ws() + WS_Z);
    float* LA = (float*)(P.ws() + WS_LRUA); float* LU = (float*)(P.ws() + WS_LRUU); float* AGG = (float*)(P.ws() + WS_LAGG);
    const int b = unit >> 7, ck = unit & 127, t0 = ck * 64; const size_t m0 = (size_t)b * T + t0;
    const int ch = tid;
    const float* cw = P.in(3) + (size_t)l * 4 * 512; const float cb = P.in(4)[l * 512 + ch];
    const float w0 = cw[ch], w1 = cw[512 + ch], w2 = cw[1024 + ch], w3 = cw[1536 + ch];
    LAS float* xw = (LAS float*)(lds + wave * 16384);
    float x3 = 0.f, x2 = 0.f, x1 = 0.f;
    if (t0 > 0) { x3 = bf2f(Z[(m0 - 3) * NZ + ZC_AX + ch]); x2 = bf2f(Z[(m0 - 2) * NZ + ZC_AX + ch]); x1 = bf2f(Z[(m0 - 1) * NZ + ZC_AX + ch]); }
#pragma unroll 4
    for (int t = 0; t < 64; ++t) {
        const float x0 = bf2f(Z[(m0 + t) * NZ + ZC_AX + ch]);
        xw[t * 64 + lane] = cb + w0 * x3 + w1 * x2 + w2 * x1 + w3 * x0;
        x3 = x2; x2 = x1; x1 = x0;
    }
    asm volatile("s_waitcnt lgkmcnt(0)" ::: "memory");
    const float* wa = P.in(5) + ((size_t)l * 8 + wave) * 4096; const float* wx = P.in(7) + ((size_t)l * 8 + wave) * 4096;
    const float ba = P.in(6)[l * 512 + ch], bx = P.in(8)[l * 512 + ch];
    const float lam = P.in(9)[l * 512 + ch]; const float sp = softplusf_(-lam);
    float h = 0.f, ap = 1.f;
    for (int half = 0; half < 2; ++half) {
        float ra[32], ia[32];
#pragma unroll
        for (int t = 0; t < 32; ++t) { ra[t] = ba; ia[t] = bx; }
        for (int c = 0; c < 64; c += 4) {
            const float a0 = wa[(c + 0) * 64 + lane], a1 = wa[(c + 1) * 64 + lane], a2 = wa[(c + 2) * 64 + lane], a3 = wa[(c + 3) * 64 + lane];
            const float b0 = wx[(c + 0) * 64 + lane], b1 = wx[(c + 1) * 64 + lane], b2 = wx[(c + 2) * 64 + lane], b3 = wx[(c + 3) * 64 + lane];
#pragma unroll
            for (int t = 0; t < 32; ++t) {
                const f32x4 xv = *(const LAS f32x4*)(xw + (half * 32 + t) * 64 + c);
                ra[t] += xv.x * a0 + xv.y * a1 + xv.z * a2 + xv.w * a3;
                ia[t] += xv.x * b0 + xv.y * b1 + xv.z * b2 + xv.w * b3;
            }
        }
#pragma unroll
        for (int t = 0; t < 32; ++t) {
            const int tt = half * 32 + t;
            const float r = sigmoidf_(ra[t]), ig = sigmoidf_(ia[t]);
            const float log_a = -8.0f * r * sp;
            const float a = __expf(log_a);
            const float u = sqrtf(-expm1f(2.0f * log_a)) * (ig * xw[tt * 64 + lane]);
            LA[(m0 + tt) * 512 + ch] = a; LU[(m0 + tt) * 512 + ch] = u;
            h = a * h + u; ap *= a;
        }
    }
    AGG[((size_t)unit * 2 + 0) * 512 + ch] = ap; AGG[((size_t)unit * 2 + 1) * 512 + ch] = h;
}

__device__ __forceinline__ void fox_cumsum_unit(const Ctx& P, int l, int unit, LAS unsigned char* lds, int tid, int wave, int lane) {
    const float* GL = (const float*)(P.ws() + WS_GL); float* FC = (float*)(P.ws() + WS_FOXC);
    const int b = unit >> 2, hh = unit & 3; const float fb = P.in(10)[l * 4 + hh];
    LAS float* wtot = (LAS float*)lds;
    float v[16]; float s = 0.f;
#pragma unroll
    for (int i = 0; i < 16; ++i) { const float x = GL[((size_t)b * T + tid * 16 + i) * 16 + hh] + fb; const float lf = fminf(x, 0.f) - log1pf(__expf(-fabsf(x))); s += lf; v[i] = s; }
    float sc = s;
#pragma unroll
    for (int o = 1; o < 64; o <<= 1) { const float n = __shfl_up(sc, o); if (lane >= o) sc += n; }
    __syncthreads();
    if (lane == 63) wtot[wave] = sc;
    __syncthreads();
    float base = sc - s;
    for (int w = 0; w < wave; ++w) base += wtot[w];
#pragma unroll
    for (int i = 0; i < 16; ++i) FC[((size_t)unit) * T + tid * 16 + i] = base + v[i];
    __syncthreads();
}

__device__ __forceinline__ void gdn_prep_unit(const Ctx& P, int l, int unit, LAS unsigned char* lds, int tid, int wave, int lane) {
    const bf16_t* Z = (const bf16_t*)(P.ws() + WS_Z); const float* GL = (const float*)(P.ws() + WS_GL);
    const int bh = unit >> 7, n = unit & 127, b = bh >> 2, hh = bh & 3; const size_t m0 = (size_t)b * T + n * 64;
    LAS float* Kf = (LAS float*)lds; LAS float* Qf = Kf + 64 * 132; LAS float* Vf = Qf + 64 * 132; LAS float* KK = Vf + 64 * 132; LAS float* QKm = KK + 64 * 68;
    LAS float* gcs = QKm + 64 * 68; LAS float* bet = gcs + 64; LAS float* eg = bet + 64;
    __syncthreads();
    {
        const int ch = tid & 127, tg = tid >> 7, tb = tg * 16;
        const float* cw = P.in(11) + (size_t)l * 4 * 1536;
#pragma unroll
        for (int part = 0; part < 3; ++part) {
            const int cc = part * 512 + hh * 128 + ch; const int zc = ZC_CQ + cc;
            const float w0 = cw[cc], w1 = cw[1536 + cc], w2 = cw[3072 + cc], w3 = cw[4608 + cc];
            float x3 = 0.f, x2 = 0.f, x1 = 0.f;
            if (n * 64 + tb > 0) { x3 = bf2f(Z[(m0 + tb - 3) * NZ + zc]); x2 = bf2f(Z[(m0 + tb - 2) * NZ + zc]); x1 = bf2f(Z[(m0 + tb - 1) * NZ + zc]); }
            LAS float* dst = (part == 0) ? Qf : (part == 1 ? Kf : Vf);
#pragma unroll 4
            for (int t = 0; t < 16; ++t) {
                const float x0 = bf2f(Z[(m0 + tb + t) * NZ + zc]);
                dst[(tb + t) * 132 + ch] = siluf_(w0 * x3 + w1 * x2 + w2 * x1 + w3 * x0);
                x3 = x2; x2 = x1; x1 = x0;
            }
        }
        if (tid < 64) {
            const float bl = GL[(m0 + tid) * 16 + 4 + hh], al = GL[(m0 + tid) * 16 + 8 + hh];
            const float g = -__expf(P.in(12)[l * 4 + hh]) * softplusf_(al + P.in(13)[l * 4 + hh]);
            float sc = g;
#pragma unroll
            for (int o = 1; o < 64; o <<= 1) { const float nn = __shfl_up(sc, o); if (lane >= o) sc += nn; }
            gcs[tid] = sc; eg[tid] = __expf(sc); bet[tid] = sigmoidf_(bl);
        }
    }
    __syncthreads();
    {
        const int row = tid >> 2, j = tid & 3; LAS float* base = (row < 64) ? (Qf + row * 132) : (Kf + (row - 64) * 132);
        float ss = 0.f;
#pragma unroll 8
        for (int e = 0; e < 32; ++e) { const float x = base[4 * e + j]; ss += x * x; }
        ss += __shfl_xor(ss, 1); ss += __shfl_xor(ss, 2);
        const float rn = rsqrtf(ss + EPS) * ((row < 64) ? 0.08838834764831845f : 1.0f);
#pragma unroll 8
        for (int e = 0; e < 32; ++e) base[4 * e + j] *= rn;
    }
    __syncthreads();
    {
        const int ti = tid >> 3, tj = tid & 7;
        float akk[8], aqk[8];
#pragma unroll
        for (int jj = 0; jj < 8; ++jj) { akk[jj] = 0.f; aqk[jj] = 0.f; }
        for (int d = 0; d < 128; d += 4) {
            const f32x4 ki = *(const LAS f32x4*)(Kf + ti * 132 + d), qi = *(const LAS f32x4*)(Qf + ti * 132 + d);
#pragma unroll
            for (int jj = 0; jj < 8; ++jj) {
                const f32x4 kj = *(const LAS f32x4*)(Kf + (8 * jj + tj) * 132 + d);
                akk[jj] += (ki.x * kj.x + ki.y * kj.y) + (ki.z * kj.z + ki.w * kj.w);
                aqk[jj] += (qi.x * kj.x + qi.y * kj.y) + (qi.z * kj.z + qi.w * kj.w);
            }
        }
        const float gi = gcs[ti], bi = bet[ti];
#pragma unroll
        for (int jj = 0; jj < 8; ++jj) {
            const int j = 8 * jj + tj;
            const float dec = (j <= ti) ? __expf(gi - gcs[j]) : 0.f;
            KK[ti * 68 + j] = (j < ti) ? akk[jj] * bi * dec : 0.f;
            QKm[ti * 68 + j] = (j <= ti) ? aqk[jj] * dec : 0.f;
        }
    }
    __syncthreads();
    unsigned char* rec = P.ws() + WS_GREC + (size_t)unit * GREC_BYTES;
    {
#pragma unroll
        for (int it = 0; it < 2; ++it) {
            const int chunk = tid + it * NTHR, c = chunk >> 4, p0 = (chunk & 15) * 8; const float e = eg[c]; float v[8];
#pragma unroll
            for (int j = 0; j < 8; ++j) v[j] = Qf[c * 132 + (p0 & ~31) + perm32((p0 & 31) + j)] * e;
            u32x4 o; o.x = pk2(v[0], v[1]); o.y = pk2(v[2], v[3]); o.z = pk2(v[4], v[5]); o.w = pk2(v[6], v[7]);
            *(u32x4*)(rec + 16384 + (size_t)(c * 128 + p0) * 2) = o;
        }
        {
            const int i = tid >> 3, p0 = (tid & 7) * 8; float v[8];
#pragma unroll
            for (int j = 0; j < 8; ++j) v[j] = QKm[i * 68 + (p0 & ~31) + perm32((p0 & 31) + j)];
            u32x4 o; o.x = pk2(v[0], v[1]); o.y = pk2(v[2], v[3]); o.z = pk2(v[4], v[5]); o.w = pk2(v[6], v[7]);
            *(u32x4*)(rec + 32768 + (size_t)(i * 64 + p0) * 2) = o;
        }
        const float glast = gcs[63];
#pragma unroll
        for (int it = 0; it < 2; ++it) {
            const int chunk = tid + it * NTHR, dk = chunk & 127, p0 = (chunk >> 7) * 8; float v[8];
#pragma unroll
            for (int j = 0; j < 8; ++j) { const int c = (p0 & ~31) + perm32((p0 & 31) + j); v[j] = Kf[c * 132 + dk] * __expf(glast - gcs[c]); }
            u32x4 o; o.x = pk2(v[0], v[1]); o.y = pk2(v[2], v[3]); o.z = pk2(v[4], v[5]); o.w = pk2(v[6], v[7]);
            *(u32x4*)(rec + 40960 + (size_t)(dk * 64 + p0) * 2) = o;
        }
        if (tid == 0) ((float*)(P.ws() + WS_GLAST))[unit] = __expf(glast);
    }
    if (tid < 256) {
        const int col = tid; float sol[64];
        if (col < 128) {
#pragma unroll
            for (int j = 0; j < 64; ++j) sol[j] = Vf[j * 132 + col] * bet[j];
        } else {
#pragma unroll
            for (int j = 0; j < 64; ++j) sol[j] = Kf[j * 132 + (col - 128)] * bet[j] * eg[j];
        }
#pragma unroll
        for (int i = 1; i < 64; ++i) {
            float acc = sol[i];
#pragma unroll
            for (int j4 = 0; j4 < (i + 3) / 4; ++j4) {
                const f32x4 kk = *(const LAS f32x4*)(KK + i * 68 + 4 * j4);
                acc -= kk.x * sol[4 * j4 + 0]; acc -= kk.y * sol[4 * j4 + 1]; acc -= kk.z * sol[4 * j4 + 2]; acc -= kk.w * sol[4 * j4 + 3];
            }
            sol[i] = acc;
        }
        if (col < 128) {
            float* U = (float*)(P.ws() + WS_GU) + (size_t)unit * 8192;
#pragma unroll
            for (int i = 0; i < 64; ++i) U[i * 128 + col] = sol[i];
        } else {
            const int dk = col - 128; const int pos = (dk & ~31) + invperm32(dk & 31);
            bf16_t* Wp = (bf16_t*)rec;
#pragma unroll
            for (int i = 0; i < 64; ++i) Wp[i * 128 + pos] = (bf16_t)f2bf(-sol[i]);
        }
    }
    __syncthreads();
}

constexpr int AT_KSTR = 272, AT_VSTR = 320;
constexpr int AT_KBUF = 64 * AT_KSTR, AT_VBUF = 64 * AT_VSTR;
constexpr int AT_K0 = 0, AT_V0 = 2 * AT_KBUF, AT_C0 = AT_V0 + 2 * AT_VBUF;

__device__ __forceinline__ s16x4 vtr(const LAS unsigned char* p) {
    typedef short v4i16_t __attribute__((ext_vector_type(4)));
    return __builtin_bit_cast(s16x4, __builtin_amdgcn_ds_read_tr16_b64_v4i16((LAS v4i16_t*)p));
}

template <int MODE>
__device__ __forceinline__ void attn_unit(const Ctx& P, int l, LAS unsigned char* lds, int tid, int wave, int lane,
                                          int b, int hh, int dil, int res, int m0, int branch) {
    const bf16_t* Z = (const bf16_t*)(P.ws() + WS_Z);
    const int qcol = (MODE == 0 ? ZC_BQ : ZC_DQ) + hh * 128, kcol = (MODE == 0 ? ZC_BK : ZC_DK) + hh * 128, vcol = (MODE == 0 ? ZC_BV : ZC_DV) + hh * 128;
    const size_t rowbase = (size_t)b * T + res;
    const float* FC = (const float*)(P.ws() + WS_FOXC) + (size_t)(b * 4 + hh) * T;
    const int ql = lane & 31, hi = lane >> 5;
    const int mq_lo = m0 + 32 * wave, mq = mq_lo + ql, mq_hi = mq_lo + 31;
    const int kt_lo = (MODE == 0) ? 0 : ((m0 >= 128 ? m0 - 128 : 0) >> 6), kt_hi = (m0 >> 6) + 3;
    constexpr float SC2 = 0.08838834764831845f * 1.4426950408889634f, L2E = 1.4426950408889634f;

    bf16x8 qf[8];
    {
        const bf16_t* qp = Z + (rowbase + (size_t)mq * dil) * NZ + qcol + 8 * hi;
#pragma unroll
        for (int ks = 0; ks < 8; ++ks) qf[ks] = *(const bf16x8*)(qp + 16 * ks);
    }
    float cq2 = 0.f;
    if (MODE == 0) cq2 = FC[mq] * L2E;

    const int srow = tid >> 3, spart = tid & 7;
    u32x4 kr0, kr1, vr0, vr1; float cr = 0.f;
    auto gload = [&](int kt) {
        const int mk = 64 * kt + srow;
        const bf16_t* rp = Z + (rowbase + (size_t)mk * dil) * NZ;
        kr0 = *(const u32x4*)(rp + kcol + spart * 16); kr1 = *(const u32x4*)(rp + kcol + spart * 16 + 8);
        vr0 = *(const u32x4*)(rp + vcol + spart * 16); vr1 = *(const u32x4*)(rp + vcol + spart * 16 + 8);
        if (MODE == 0 && tid < 64) cr = FC[64 * kt + tid] * L2E;
    };
    auto lstore = [&](int buf) {
        LAS unsigned char* kb = lds + AT_K0 + buf * AT_KBUF + srow * AT_KSTR + spart * 32;
        *(LAS u32x4*)kb = kr0; *(LAS u32x4*)(kb + 16) = kr1;
        LAS unsigned char* vb = lds + AT_V0 + buf * AT_VBUF + srow * AT_VSTR + spart * 32;
        *(LAS u32x4*)vb = vr0; *(LAS u32x4*)(vb + 16) = vr1;
        if (MODE == 0 && tid < 64) ((LAS float*)(lds + AT_C0))[buf * 64 + tid] = cr;
    };

    f32x16 O[4];
#pragma unroll
    for (int mt = 0; mt < 4; ++mt)
#pragma unroll
        for (int r = 0; r < 16; ++r) O[mt][r] = 0.f;
    float m_run = -INFINITY, l_run = 0.f;

    __syncthreads();
    gload(kt_lo); lstore(0);
    __syncthreads();

    const int gq = lane >> 4, li = lane & 15, tq = li >> 2, tp = li & 3;
    const int vbase_lane = (4 * (gq >> 1) + tq) * AT_VSTR + (16 * (gq & 1) + 4 * tp) * 2;

    for (int kt = kt_lo; kt <= kt_hi; ++kt) {
        const int buf = (kt - kt_lo) & 1;
        if (kt < kt_hi) gload(kt + 1);
        const bool need = (MODE == 0) ? (64 * kt <= mq_hi) : ((64 * kt + 63 >= mq_lo - 128) && (64 * kt <= mq_hi));
        if (need) {
            const LAS unsigned char* kb = lds + AT_K0 + buf * AT_KBUF + ql * AT_KSTR + hi * 16;
            f32x16 p0, p1;
#pragma unroll
            for (int r = 0; r < 16; ++r) { p0[r] = 0.f; p1[r] = 0.f; }
#pragma unroll
            for (int ks = 0; ks < 8; ++ks) {
                const bf16x8 a0 = *(const LAS bf16x8*)(kb + ks * 32);
                const bf16x8 a1 = *(const LAS bf16x8*)(kb + 32 * AT_KSTR + ks * 32);
                p0 = __builtin_amdgcn_mfma_f32_32x32x16_bf16(a0, qf[ks], p0, 0, 0, 0);
                p1 = __builtin_amdgcn_mfma_f32_32x32x16_bf16(a1, qf[ks], p1, 0, 0, 0);
            }
            const LAS float* cb = (const LAS float*)(lds + AT_C0) + buf * 64;
            float mx = -INFINITY;
#pragma unroll
            for (int a = 0; a < 4; ++a) {
                f32x4 c0 = {0.f, 0.f, 0.f, 0.f}, c1 = {0.f, 0.f, 0.f, 0.f};
                if (MODE == 0) { c0 = *(const LAS f32x4*)(cb + 8 * a + 4 * hi); c1 = *(const LAS f32x4*)(cb + 32 + 8 * a + 4 * hi); }
#pragma unroll
                for (int e = 0; e < 4; ++e) {
                    const int r = 4 * a + e; const int k0 = 64 * kt + 8 * a + 4 * hi + e, k1 = k0 + 32;
                    float s0 = p0[r] * SC2, s1 = p1[r] * SC2;
                    if (MODE == 0) { s0 += cq2 - c0[e]; s1 += cq2 - c1[e]; }
                    const bool ok0 = (MODE == 0) ? (k0 <= mq) : (k0 <= mq && mq - k0 <= 128);
                    const bool ok1 = (MODE == 0) ? (k1 <= mq) : (k1 <= mq && mq - k1 <= 128);
                    s0 = ok0 ? s0 : -INFINITY; s1 = ok1 ? s1 : -INFINITY;
                    p0[r] = s0; p1[r] = s1; mx = fmaxf(mx, fmaxf(s0, s1));
                }
            }
            mx = fmaxf(mx, __shfl_xor(mx, 32));
            const float m_new = fmaxf(m_run, mx);
            const float m_use = (m_new == -INFINITY) ? 0.f : m_new;
            const float alpha = __builtin_amdgcn_exp2f(m_run - m_use);
            float ls = 0.f;
#pragma unroll
            for (int r = 0; r < 16; ++r) { p0[r] = __builtin_amdgcn_exp2f(p0[r] - m_use); p1[r] = __builtin_amdgcn_exp2f(p1[r] - m_use); ls += p0[r] + p1[r]; }
            l_run = l_run * alpha + ls; m_run = m_new;
#pragma unroll
            for (int mt = 0; mt < 4; ++mt)
#pragma unroll
                for (int r = 0; r < 16; ++r) O[mt][r] *= alpha;
            bf16x8 pf[4];
#pragma unroll
            for (int s = 0; s < 4; ++s) {
                u32x4 w;
                if (s < 2) { w.x = pk2(p0[8 * s + 0], p0[8 * s + 1]); w.y = pk2(p0[8 * s + 2], p0[8 * s + 3]); w.z = pk2(p0[8 * s + 4], p0[8 * s + 5]); w.w = pk2(p0[8 * s + 6], p0[8 * s + 7]); }
                else { const int s2 = s - 2; w.x = pk2(p1[8 * s2 + 0], p1[8 * s2 + 1]); w.y = pk2(p1[8 * s2 + 2], p1[8 * s2 + 3]); w.z = pk2(p1[8 * s2 + 4], p1[8 * s2 + 5]); w.w = pk2(p1[8 * s2 + 6], p1[8 * s2 + 7]); }
                pf[s] = __builtin_bit_cast(bf16x8, w);
            }
            const LAS unsigned char* vb = lds + AT_V0 + buf * AT_VBUF + vbase_lane;
#pragma unroll
            for (int mt = 0; mt < 4; ++mt)
#pragma unroll
                for (int s = 0; s < 4; ++s) {
                    const s16x4 lo = vtr(vb + (16 * s) * AT_VSTR + mt * 64);
                    const s16x4 hi4 = vtr(vb + (16 * s + 8) * AT_VSTR + mt * 64);
                    const bf16x8 vf = {lo[0], lo[1], lo[2], lo[3], hi4[0], hi4[1], hi4[2], hi4[3]};
                    O[mt] = __builtin_amdgcn_mfma_f32_32x32x16_bf16(vf, pf[s], O[mt], 0, 0, 0);
                }
        }
        if (kt < kt_hi) lstore(buf ^ 1);
        __syncthreads();
    }
    const float l_tot = l_run + __shfl_xor(l_run, 32);
    const float inv = 1.0f / l_tot;
    const size_t orow = rowbase + (size_t)mq * dil;
    if (MODE == 0) {
        float ss = 0.f;
#pragma unroll
        for (int mt = 0; mt < 4; ++mt)
#pragma unroll
            for (int r = 0; r < 16; ++r) { O[mt][r] *= inv; ss += O[mt][r] * O[mt][r]; }
        ss += __shfl_xor(ss, 32);
        const float rn = rsqrtf(ss * (1.0f / 128.0f) + EPS);
        const float* nb = P.in(16) + l * 512 + hh * 128;
        bf16_t* yp = (bf16_t*)(P.ws() + WS_Y) + orow * DM + 512 + hh * 128;
#pragma unroll
        for (int mt = 0; mt < 4; ++mt)
#pragma unroll
            for (int a = 0; a < 4; ++a) {
                const int dv = 32 * mt + 8 * a + 4 * hi; const f32x4 g = *(const f32x4*)(nb + dv);
                u32x2 w; w.x = pk2(O[mt][4 * a + 0] * rn * g.x, O[mt][4 * a + 1] * rn * g.y); w.y = pk2(O[mt][4 * a + 2] * rn * g.z, O[mt][4 * a + 3] * rn * g.w);
                *(u32x2*)(yp + dv) = w;
            }
    } else {
        bf16_t* op = (bf16_t*)(P.ws() + WS_OD) + ((size_t)branch * M + orow) * 512 + hh * 128;
#pragma unroll
        for (int mt = 0; mt < 4; ++mt)
#pragma unroll
            for (int a = 0; a < 4; ++a) {
                const int dv = 32 * mt + 8 * a + 4 * hi;
                u32x2 w; w.x = pk2(O[mt][4 * a + 0] * inv, O[mt][4 * a + 1] * inv); w.y = pk2(O[mt][4 * a + 2] * inv, O[mt][4 * a + 3] * inv);
                *(u32x2*)(op + dv) = w;
            }
        if (hi == 0) ((float*)(P.ws() + WS_LSE))[((size_t)branch * M + orow) * 4 + hh] = (m_run + __builtin_amdgcn_logf(l_tot)) * 0.6931471805599453f;
    }
}

constexpr int GS_WP = 0, GS_QP = 64 * 272, GS_QK = 2 * 64 * 272, GS_KT = GS_QK + 64 * 144, GS_BUF = GS_KT + 128 * 144;
__device__ __forceinline__ void gdn_seq_unit(const Ctx& P, int l, int bh, LAS unsigned char* lds, int tid, int wave, int lane) {
    const int b = bh >> 2, hh = bh & 3;
    const unsigned char* recs = P.ws() + WS_GREC + (size_t)bh * 128 * GREC_BYTES;
    const float* Ug = (const float*)(P.ws() + WS_GU) + (size_t)bh * 128 * 8192;
    const float* GLv = (const float*)(P.ws() + WS_GLAST) + bh * 128;
    float* OC = (float*)(P.ws() + WS_OC);
    const int fr = lane & 15, g = lane >> 4;
    int soff[7];
#pragma unroll
    for (int i = 0; i < 7; ++i) {
        const int q = tid + i * NTHR; int off;
        if (q < 1024) off = GS_WP + (q >> 4) * 272 + (q & 15) * 16;
        else if (q < 2048) off = GS_QP + ((q - 1024) >> 4) * 272 + (q & 15) * 16;
        else if (q < 2560) off = GS_QK + ((q - 2048) >> 3) * 144 + (q & 7) * 16;
        else off = GS_KT + ((q - 2560) >> 3) * 144 + (q & 7) * 16;
        soff[i] = off;
    }
    u32x4 stg;
    const unsigned lane_off = (unsigned)tid * 16u;
#define GS_LOAD(n_, i_) stg = *(const u32x4*)((recs + (size_t)(n_) * GREC_BYTES + (size_t)(i_) * 8192) + lane_off)
#define GS_STORE(buf_, i_) *(LAS u32x4*)(lds + (buf_) * GS_BUF + soff[i_]) = stg
#define GS_PF(i_) do { if (n < 127) { if ((i_) > 0) GS_STORE(buf ^ 1, (i_) - 1); GS_LOAD(n + 1, (i_)); } } while (0)
    f32x4 S[8];
#pragma unroll
    for (int i = 0; i < 8; ++i) S[i] = (f32x4){0.f, 0.f, 0.f, 0.f};
    __syncthreads();
#pragma unroll
    for (int i = 0; i < 7; ++i) { GS_LOAD(0, i); GS_STORE(0, i); }
    __syncthreads();
    for (int n = 0; n < 128; ++n) {
        const int buf = n & 1;
        GS_PF(0);
        const LAS unsigned char* base = lds + buf * GS_BUF;
        const float* U = Ug + (size_t)n * 8192;
        f32x4 vn[4];
#pragma unroll
        for (int mt = 0; mt < 4; ++mt)
#pragma unroll
            for (int i = 0; i < 4; ++i) vn[mt][i] = U[(16 * mt + 4 * g + i) * 128 + 16 * wave + fr];
        const float gl = GLv[n];
        bf16x8 sb[4];
#pragma unroll
        for (int s = 0; s < 4; ++s) {
            u32x4 w; w.x = pk2(S[2 * s][0], S[2 * s][1]); w.y = pk2(S[2 * s][2], S[2 * s][3]); w.z = pk2(S[2 * s + 1][0], S[2 * s + 1][1]); w.w = pk2(S[2 * s + 1][2], S[2 * s + 1][3]);
            sb[s] = __builtin_bit_cast(bf16x8, w);
        }
        f32x4 oa[4];
#pragma unroll
        for (int mt = 0; mt < 4; ++mt) {
            oa[mt] = (f32x4){0.f, 0.f, 0.f, 0.f};
            __builtin_amdgcn_sched_barrier(0);
            if (mt == 1) GS_PF(1);
            if (mt == 3) GS_PF(2);
#pragma unroll
            for (int s = 0; s < 4; ++s) {
                const bf16x8 aw = *(const LAS bf16x8*)(base + GS_WP + (16 * mt + fr) * 272 + (32 * s + 8 * g) * 2);
                const bf16x8 aq = *(const LAS bf16x8*)(base + GS_QP + (16 * mt + fr) * 272 + (32 * s + 8 * g) * 2);
                vn[mt] = __builtin_amdgcn_mfma_f32_16x16x32_bf16(aw, sb[s], vn[mt], 0, 0, 0);
                oa[mt] = __builtin_amdgcn_mfma_f32_16x16x32_bf16(aq, sb[s], oa[mt], 0, 0, 0);
            }
        }
        bf16x8 vb[2];
#pragma unroll
        for (int s = 0; s < 2; ++s) {
            u32x4 w; w.x = pk2(vn[2 * s][0], vn[2 * s][1]); w.y = pk2(vn[2 * s][2], vn[2 * s][3]); w.z = pk2(vn[2 * s + 1][0], vn[2 * s + 1][1]); w.w = pk2(vn[2 * s + 1][2], vn[2 * s + 1][3]);
            vb[s] = __builtin_bit_cast(bf16x8, w);
        }
        GS_PF(3);
        __builtin_amdgcn_sched_barrier(0);
#pragma unroll
        for (int mt = 0; mt < 4; ++mt)
#pragma unroll
            for (int s = 0; s < 2; ++s) {
                const bf16x8 a = *(const LAS bf16x8*)(base + GS_QK + (16 * mt + fr) * 144 + (32 * s + 8 * g) * 2);
                oa[mt] = __builtin_amdgcn_mfma_f32_16x16x32_bf16(a, vb[s], oa[mt], 0, 0, 0);
            }
        {
            float* op = OC + ((size_t)b * T + n * 64) * 512 + hh * 128 + 16 * wave + fr;
#pragma unroll
            for (int mt = 0; mt < 4; ++mt)
#pragma unroll
                for (int i = 0; i < 4; ++i) op[(size_t)(16 * mt + 4 * g + i) * 512] = oa[mt][i];
        }
        GS_PF(4);
#pragma unroll
        for (int dt = 0; dt < 8; ++dt) {
            __builtin_amdgcn_sched_barrier(0);
            if (dt == 3) GS_PF(5);
            if (dt == 6) GS_PF(6);
            S[dt] = S[dt] * gl;
#pragma unroll
            for (int s = 0; s < 2; ++s) {
                const bf16x8 a = *(const LAS bf16x8*)(base + GS_KT + (16 * dt + fr) * 144 + (32 * s + 8 * g) * 2);
                S[dt] = __builtin_amdgcn_mfma_f32_16x16x32_bf16(a, vb[s], S[dt], 0, 0, 0);
            }
        }
        if (n < 127) GS_STORE(buf ^ 1, 6);
        __syncthreads();
    }
#undef GS_LOAD
#undef GS_STORE
#undef GS_PF
}

__device__ __forceinline__ void lru_final_unit(const Ctx& P, int l, int unit, int tid, int wave, int lane) {
    const bf16_t* Z = (const bf16_t*)(P.ws() + WS_Z);
    const float* LA = (const float*)(P.ws() + WS_LRUA); const float* LU = (const float*)(P.ws() + WS_LRUU); const float* AGG = (const float*)(P.ws() + WS_LAGG);
    bf16_t* Y = (bf16_t*)(P.ws() + WS_Y);
    const int b = unit >> 7, ck = unit & 127; const size_t m0 = (size_t)b * T + ck * 64; const int ch = tid;
    float h = 0.f;
    for (int j = 0; j < ck; ++j) { const float a = AGG[((size_t)(b * 128 + j) * 2 + 0) * 512 + ch], hh2 = AGG[((size_t)(b * 128 + j) * 2 + 1) * 512 + ch]; h = a * h + hh2; }
    const float gn = P.in(15)[l * 512 + ch];
#pragma unroll 4
    for (int t = 0; t < 64; ++t) {
        const float a = LA[(m0 + t) * 512 + ch], u = LU[(m0 + t) * 512 + ch];
        h = a * h + u;
        const float ss = wave_sum(h * h);
        const float gate = bf2f(Z[(m0 + t) * NZ + ZC_AG + ch]);
        const float y = h * rsqrtf(ss * (1.0f / 64.0f) + EPS) * gn * gelu_tanh(gate);
        Y[(m0 + t) * DM + ch] = (bf16_t)f2bf(y);
    }
}

__device__ __forceinline__ void finalize_phase(const Ctx& P, int l, int wave, int lane, int bid, int nblk) {
    const bf16_t* Z = (const bf16_t*)(P.ws() + WS_Z); const float* OC = (const float*)(P.ws() + WS_OC);
    const bf16_t* OD = (const bf16_t*)(P.ws() + WS_OD); const float* LSE = (const float*)(P.ws() + WS_LSE);
    bf16_t* Y = (bf16_t*)(P.ws() + WS_Y);
    const float gc0 = P.in(14)[l * 128 + 2 * lane], gc1 = P.in(14)[l * 128 + 2 * lane + 1];
    for (int task = bid * 8 + wave; task < M * 4; task += nblk * 8) {
        const size_t m = task >> 2; const int hh = task & 3;
        {
            const float o0 = OC[m * 512 + hh * 128 + 2 * lane], o1 = OC[m * 512 + hh * 128 + 2 * lane + 1];
            const float rn = rsqrtf(wave_sum(o0 * o0 + o1 * o1) * (1.0f / 128.0f) + EPS);
            const unsigned zz = *(const unsigned*)(Z + m * NZ + ZC_CZ + hh * 128 + 2 * lane);
            const float z0 = bflo(zz), z1 = bfhi(zz);
            *(unsigned*)(Y + m * DM + 1024 + hh * 128 + 2 * lane) = pk2(o0 * rn * gc0 * siluf_(z0), o1 * rn * gc1 * siluf_(z1));
        }
        {
            const float l0 = LSE[((size_t)0 * M + m) * 4 + hh], l1 = LSE[((size_t)1 * M + m) * 4 + hh], l2 = LSE[((size_t)2 * M + m) * 4 + hh];
            const float mx = fmaxf(l0, fmaxf(l1, l2));
            float w0 = __expf(l0 - mx), w1 = __expf(l1 - mx), w2 = __expf(l2 - mx);
            const float inv = 1.0f / (w0 + w1 + w2); w0 *= inv; w1 *= inv; w2 *= inv;
            const unsigned a0 = *(const unsigned*)(OD + ((size_t)0 * M + m) * 512 + hh * 128 + 2 * lane);
            const unsigned a1 = *(const unsigned*)(OD + ((size_t)1 * M + m) * 512 + hh * 128 + 2 * lane);
            const unsigned a2 = *(const unsigned*)(OD + ((size_t)2 * M + m) * 512 + hh * 128 + 2 * lane);
            const float o0 = w0 * bflo(a0) + w1 * bflo(a1) + w2 * bflo(a2), o1 = w0 * bfhi(a0) + w1 * bfhi(a1) + w2 * bfhi(a2);
            const float rn = rsqrtf(wave_sum(o0 * o0 + o1 * o1) * (1.0f / 128.0f) + EPS);
            const float g0 = P.in(17)[l * 512 + hh * 128 + 2 * lane], g1 = P.in(17)[l * 512 + hh * 128 + 2 * lane + 1];
            *(unsigned*)(Y + m * DM + 1536 + hh * 128 + 2 * lane) = pk2(o0 * rn * g0, o1 * rn * g1);
        }
    }
}

__device__ __forceinline__ void ffn_act_phase(const Ctx& P, int l, int tid, int bid, int nblk) {
    const bf16_t* U = (const bf16_t*)(P.ws() + WS_U); bf16_t* ACT = (bf16_t*)(P.ws() + WS_ACT);
    const float* cw = P.in(21) + (size_t)l * 3 * NFF2; const float* cb = P.in(22) + (size_t)l * NFF2;
    constexpr int CG = DFF / 8, RUN = 32, NRUN = M / RUN;
    for (int item = bid * NTHR + tid; item < CG * NRUN; item += nblk * NTHR) {
        const int cg8 = item % CG, run = item / CG; const int c0 = cg8 * 8; const size_t mstart = (size_t)run * RUN; const int tin = (int)(mstart % T);
        float wu[3][8], wg[3][8], bu[8], bg[8];
#pragma unroll
        for (int k = 0; k < 3; ++k)
#pragma unroll
            for (int e = 0; e < 8; ++e) { wu[k][e] = cw[k * NFF2 + c0 + e]; wg[k][e] = cw[k * NFF2 + DFF + c0 + e]; }
#pragma unroll
        for (int e = 0; e < 8; ++e) { bu[e] = cb[c0 + e]; bg[e] = cb[DFF + c0 + e]; }
        u32x4 u2 = {0, 0, 0, 0}, u1 = {0, 0, 0, 0}, g2 = {0, 0, 0, 0}, g1 = {0, 0, 0, 0};
        if (tin > 0) {
            u2 = *(const u32x4*)(U + (mstart - 2) * NFF2 + c0); u1 = *(const u32x4*)(U + (mstart - 1) * NFF2 + c0);
            g2 = *(const u32x4*)(U + (mstart - 2) * NFF2 + DFF + c0); g1 = *(const u32x4*)(U + (mstart - 1) * NFF2 + DFF + c0);
        }
        for (int t = 0; t < RUN; ++t) {
            const u32x4 u0 = *(const u32x4*)(U + (mstart + t) * NFF2 + c0), g0 = *(const u32x4*)(U + (mstart + t) * NFF2 + DFF + c0);
            float r[8];
#pragma unroll
            for (int q = 0; q < 4; ++q) {
                const float up0 = bu[2 * q] + wu[0][2 * q] * bflo(u2[q]) + wu[1][2 * q] * bflo(u1[q]) + wu[2][2 * q] * bflo(u0[q]);
                const float up1 = bu[2 * q + 1] + wu[0][2 * q + 1] * bfhi(u2[q]) + wu[1][2 * q + 1] * bfhi(u1[q]) + wu[2][2 * q + 1] * bfhi(u0[q]);
                const float ga0 = bg[2 * q] + wg[0][2 * q] * bflo(g2[q]) + wg[1][2 * q] * bflo(g1[q]) + wg[2][2 * q] * bflo(g0[q]);
                const float ga1 = bg[2 * q + 1] + wg[0][2 * q + 1] * bfhi(g2[q]) + wg[1][2 * q + 1] * bfhi(g1[q]) + wg[2][2 * q + 1] * bfhi(g0[q]);
                r[2 * q] = siluf_(ga0) * up0; r[2 * q + 1] = siluf_(ga1) * up1;
            }
            u32x4 o; o.x = pk2(r[0], r[1]); o.y = pk2(r[2], r[3]); o.z = pk2(r[4], r[5]); o.w = pk2(r[6], r[7]);
            *(u32x4*)(ACT + (mstart + t) * DFF + c0) = o;
            u2 = u1; u1 = u0; g2 = g1; g1 = g0;
        }
    }
}

#ifndef N_LAYERS_RUN
#define N_LAYERS_RUN DEPTH
#endif
constexpr int D_NUNITS = 8 + 256 + 768 + 256;

__global__ void __launch_bounds__(NTHR, 2) fwd_megakernel(Params KP) {
    extern __shared__ __attribute__((aligned(16))) unsigned char lds_raw[];
    LAS unsigned char* lds0 = (LAS unsigned char*)lds_raw;
    cg::grid_group grid = cg::this_grid();
    const int tid = threadIdx.x, lane = tid & 63, wave = __builtin_amdgcn_readfirstlane(tid >> 6);
    const int bid = blockIdx.x, nblk = gridDim.x;
    volatile LAS int* misc = (volatile LAS int*)(lds0 + LDS_MISC);
    {
        LAS unsigned long long* tabw = (LAS unsigned long long*)(lds0 + LDS_MISC + 64);
        if (threadIdx.x == 0) {
#pragma unroll
            for (int i = 0; i < 25; ++i) tabw[i] = (unsigned long long)KP.in[i];
            tabw[25] = (unsigned long long)KP.out; tabw[26] = (unsigned long long)KP.ws;
        }
        __syncthreads();
    }
    Ctx P; P.tab = (const LAS unsigned*)(lds0 + LDS_MISC + 64);
#define WSP (P.ws())
#define XP (P.out())

#ifndef SK_P0
    p0_prologue(P, lds0, bid * 8 + wave, nblk * 8, wave, lane);
#endif
    grid.sync();

    for (int l0 = 0; l0 < N_LAYERS_RUN; ++l0) {
#define FRESH() LAS unsigned char* lds = lds0; asm volatile("" : "+v"(lds)); int l = l0; asm volatile("" : "+s"(l)); int tid = threadIdx.x; asm volatile("" : "+v"(tid)); const int lane = tid & 63, wave = __builtin_amdgcn_readfirstlane(tid >> 6); (void)lane; (void)wave; (void)l;
#ifndef SK_A
        { FRESH()
        norm_phase<true>(l == 0 ? P.in(0) : XP, l == 0 ? XP : nullptr, P.in(1) + l * DM, (bf16_t*)(WSP + WS_HB), (const float*)(WSP + WS_WG) + (size_t)l * 12 * DM,
                         (float*)(WSP + WS_GL), lds, tid, wave, lane, bid, nblk); }
#endif
        grid.sync();
#ifndef SK_B
        { FRESH()
            pg8::Gemm g{(const bf16_t*)(WSP + WS_HB), (const bf16_t*)(WSP + WS_WIN) + (size_t)l * NZ * DM, M, NZ, DM};
            pg8::StaticOrder S; S.init(M, NZ, nblk, bid);
            pg8::EpiBf16<0> E{(bf16_t*)(WSP + WS_Z), NZ, nullptr, 0, 0, 1.f};
            pg8::gemm_phase<pg8::EpiBf16<0>, pg8::StaticOrder, true, true>(lds, g, S, E);
        }
#endif
        grid.sync();
        for (int u = bid; u < 1024 + 256 + 8; u += nblk) { FRESH()
#ifndef SK_C3
            if (u < 1024) gdn_prep_unit(P, l, u, lds, tid, wave, lane); else
#endif
#ifndef SK_C1
            if (u >= 1024 && u < 1280) { __syncthreads(); lru_chunk_unit(P, l, u - 1024, lds, tid, wave, lane); __syncthreads(); } else
#endif
#ifndef SK_C2
            if (u >= 1280) fox_cumsum_unit(P, l, u - 1280, lds, tid, wave, lane);
#else
            {}
#endif
        }
        grid.sync();
        {
            unsigned* ctr = (unsigned*)(WSP + WS_CTL) + 64 * (1 + l0);
            for (;;) {
                __syncthreads();
                if (threadIdx.x == 0) misc[0] = (int)atomicAdd(ctr, 1u);
                __syncthreads();
                const int u = misc[0];
                if (u >= D_NUNITS) break;
                FRESH()
#ifndef SK_D1
                if (u < 8) gdn_seq_unit(P, l, u, lds, tid, wave, lane); else
#endif
#ifndef SK_D2
                if (u >= 8 && u < 264) { const int i = u - 8; attn_unit<0>(P, l, lds, tid, wave, lane, (i & 7) >> 2, i & 3, 1, 0, (31 - (i >> 3)) * 256, 0); } else
#endif
#ifndef SK_D3
                if (u >= 264 && u < 1032) {
                    const int i = u - 264; const int bh = i & 7, j = i >> 3;
                    const int br = j >> 5, k = j & 31;
                    const int dil = (br == 0) ? 1 : (br == 1 ? 4 : 16);
                    const int nqb = 32 / dil;
                    const int res = k / nqb, qb = k % nqb;
                    attn_unit<1>(P, l, lds, tid, wave, lane, bh >> 2, bh & 3, dil, res, qb * 256, br);
                } else
#endif
#ifndef SK_D4
                if (u >= 1032) lru_final_unit(P, l, u - 1032, tid, wave, lane);
#else
                {}
#endif
            }
        }
        grid.sync();
#ifndef SK_E
        { FRESH() finalize_phase(P, l, wave, lane, bid, nblk); }
#endif
        grid.sync();
#ifndef SK_F
        { FRESH()
            pg8::Gemm g{(const bf16_t*)(WSP + WS_Y), (const bf16_t*)(WSP + WS_WOUT) + (size_t)l * DM * DM, M, DM, DM};
            pg8::StaticOrder S; S.init(M, DM, nblk, bid);
            EpiResAdd E{XP, DM};
            pg8::gemm_phase<EpiResAdd, pg8::StaticOrder, true, true>(lds, g, S, E);
        }
#endif
        grid.sync();
#ifndef SK_G
        { FRESH() norm_phase<false>(XP, nullptr, P.in(19) + l * DM, (bf16_t*)(WSP + WS_HB), nullptr, nullptr, lds, tid, wave, lane, bid, nblk); }
#endif
        grid.sync();
#ifndef SK_H
        { FRESH()
            pg8::Gemm g{(const bf16_t*)(WSP + WS_HB), (const bf16_t*)(WSP + WS_WUP) + (size_t)l * NFF2 * DM, M, NFF2, DM};
            pg8::StaticOrder S; S.init(M, NFF2, nblk, bid);
            pg8::EpiBf16<0> E{(bf16_t*)(WSP + WS_U), NFF2, nullptr, 0, 0, 1.f};
            pg8::gemm_phase<pg8::EpiBf16<0>, pg8::StaticOrder, true, true>(lds, g, S, E);
        }
#endif
        grid.sync();
#ifndef SK_I
        { FRESH() ffn_act_phase(P, l, tid, bid, nblk); }
#endif
        grid.sync();
#ifndef SK_J
        { FRESH()
            pg8::Gemm g{(const bf16_t*)(WSP + WS_ACT), (const bf16_t*)(WSP + WS_WDN) + (size_t)l * DM * DFF, M, DM, DFF};
            pg8::StaticOrder S; S.init(M, DM, nblk, bid);
            EpiResAdd E{XP, DM};
            pg8::gemm_phase<EpiResAdd, pg8::StaticOrder, true, true>(lds, g, S, E);
        }
#endif
        grid.sync();
    }
#ifndef SK_FN
    { int tid = threadIdx.x; asm volatile("" : "+v"(tid)); const int lane = tid & 63, wave = __builtin_amdgcn_readfirstlane(tid >> 6);
      final_norm_phase(XP, P.in(24), wave, lane, bid, nblk); }
#endif
}

extern "C" void kernel_launch(void* const* d_in, const int* in_sizes, int n_in, void* d_out, int out_size, void* d_ws, size_t ws_size, hipStream_t stream) {
    static int grid_blocks = 0;
    if (grid_blocks == 0) {
        if (n_in != 25 || ws_size < WS_END) { fprintf(stderr, "kernel_launch: unexpected inputs (n_in %d, ws %zu < %zu)\n", n_in, ws_size, (size_t)WS_END); grid_blocks = -1; return; }
        int dev = 0, cus = 0, per_cu = 0;
        hipGetDevice(&dev);
        hipDeviceGetAttribute(&cus, hipDeviceAttributeMultiprocessorCount, dev);
        if (hipFuncSetAttribute((const void*)fwd_megakernel, hipFuncAttributeMaxDynamicSharedMemorySize, LDS_BYTES) != hipSuccess) { fprintf(stderr, "kernel_launch: hipFuncSetAttribute failed\n"); grid_blocks = -1; return; }
        if (hipOccupancyMaxActiveBlocksPerMultiprocessor(&per_cu, (const void*)fwd_megakernel, NTHR, LDS_BYTES) != hipSuccess || per_cu < 1) { fprintf(stderr, "kernel_launch: occupancy query says %d\n", per_cu); per_cu = 1; }
        (void)hipGetLastError();
        grid_blocks = cus * per_cu;
        if (grid_blocks > 256) grid_blocks = 256;
    }
    if (grid_blocks < 0) return;
    hipMemsetAsync((char*)d_ws + WS_CTL, 0, 4096, stream);
    Params p{};
    for (int i = 0; i < 25; ++i) p.in[i] = (const float*)d_in[i];
    p.out = (float*)d_out; p.ws = (unsigned char*)d_ws;
    void* args[] = {&p};
    hipError_t e = hipLaunchCooperativeKernel((const void*)fwd_megakernel, dim3(grid_blocks), dim3(NTHR), args, LDS_BYTES, stream);
    if (e != hipSuccess) fprintf(stderr, "cooperative launch failed: %s (grid %d)\n", hipGetErrorString(e), grid_blocks);
}
```

```cpp
#include <hip/hip_runtime.h>
#include <hip/hip_cooperative_groups.h>
#include <cstdio>
#include <cstdint>
namespace cg = cooperative_groups;
namespace pg8 {
#define PG8_LAS __attribute__((address_space(3)))
typedef unsigned short bf16_t;
typedef short bf16x8 __attribute__((ext_vector_type(8)));
typedef float f32x4 __attribute__((ext_vector_type(4)));
typedef unsigned u32x4 __attribute__((ext_vector_type(4)));
constexpr int BM = 256, BK = 64, HALF = 128, HTB = HALF * BK * 2  , STAGE_BYTES = 8 * HTB, NXCD = 8, WGM = 8;

__host__ __device__ __forceinline__ int lds_byte(int r, int c) { const int st = (r >> 4) * 2 + (c >> 5), rr = r & 15, cc = c & 31, ob = rr * 64 + cc * 2; return st * 1024 + (ob ^ (((ob >> 9) & 1) << 5)); }
__host__ __device__ __forceinline__ void stage_rc(int b, int& R, int& C) { const int st = b / 1024, sb = b % 1024, swz = sb ^ (((sb >> 9) & 1) << 5); R = (st >> 1) * 16 + swz / 64; C = (st & 1) * 32 + (swz % 64) / 2; }
__host__ __device__ __forceinline__ int perm32(int rho) { const int n = rho >> 4, i = rho & 15; return 8 * (i >> 2) + 4 * n + (i & 3); }

struct Unit { int pm, pn; };
struct Gemm { const bf16_t* A; const bf16_t* Bt; int M, N, K; };

struct StaticOrder {
    int nM, nN, nwg, G, c;
    __host__ __device__ void init(int M, int N, int G_, int c_) { nM = M / BM; nN = N / BM; nwg = nM * nN; G = G_; c = c_; }
    __host__ __device__ bool next(int i, Unit& u) const {
        const long L = (long)i * G + c; if (L >= nwg) return false;
        int wgid = (int)L; { const int q = nwg / NXCD, r = nwg % NXCD, xcd = wgid % NXCD, off = wgid / NXCD; wgid = (xcd < r ? xcd * (q + 1) : r * (q + 1) + (xcd - r) * q) + off; }
        const int nig = WGM * nN, gid = wgid / nig, fm = gid * WGM, gsz = (nM - fm) < WGM ? (nM - fm) : WGM;
        u.pm = fm + ((wgid % nig) % gsz); u.pn = (wgid % nig) / gsz; return true;
    }
    __device__ __forceinline__ void a_ready(const Unit&) const {}
    __device__ __forceinline__ void done(const Unit&) const {}
};

__device__ __forceinline__ unsigned cvt_pk_bf16(float lo, float hi) { unsigned r; asm volatile("v_cvt_pk_bf16_f32 %0, %1, %2" : "=v"(r) : "v"(lo), "v"(hi)); return r; }
typedef float f32x2 __attribute__((ext_vector_type(2)));
__device__ __forceinline__ f32x2 gelu_pk(f32x2 v) {
    const f32x2 av = __builtin_elementwise_abs(v), d = av * 0.2316418882f + 1.0f;
    f32x2 t; t.x = __builtin_amdgcn_rcpf(d.x); t.y = __builtin_amdgcn_rcpf(d.y);
    f32x2 q = t * 0.5307027145f + (-0.7265760135f); q = q * t + 0.7107068705f; q = q * t + (-0.142248368f); q = q * t + 0.127414796f; q = q * t;
    const f32x2 s = (v * v) * (-0.72134752044f);
    f32x2 e; e.x = __builtin_amdgcn_exp2f(s.x); e.y = __builtin_amdgcn_exp2f(s.y);
    const f32x2 m = v * (q * e), r = v - m;
    f32x2 o; o.x = v.x < 0.f ? m.x : r.x; o.y = v.y < 0.f ? m.y : r.y; return o;
}

template <int ACT  > struct EpiBf16 {
    static constexpr bool PERM = true, AFTER_DRAIN = false; static_assert(ACT == 0 || ACT == 1, "EpiBf16: ACT is 0 (none) or 1 (gelu_pk)");
    bf16_t* O; int ldc; const float* bias; int split_cols; size_t split_stride; float scale0;
    __device__ __forceinline__ void operator()(const f32x4 (&acc)[2][2][4][2], const Unit& u, int wr, int wc, int fr, int fq) const {
        const int row0 = u.pm * BM + wr * 64 + fr; int colt = u.pn * BM; bf16_t* base = O;
        float sc = 1.f; if (split_cols) { const int t = colt / split_cols; base += (size_t)t * split_stride; colt -= t * split_cols; if (t == 0) sc = scale0; }
        const int col0 = colt + wc * 32 + 8 * fq, bcol0 = u.pn * BM + wc * 32 + 8 * fq;
        f32x4 bv[2][2];
#pragma unroll
        for (int bj = 0; bj < 2; ++bj)
#pragma unroll
            for (int n = 0; n < 2; ++n) bv[bj][n] = bias ? *(const f32x4*)(bias + bcol0 + bj * HALF + 4 * n) : (f32x4){0.f, 0.f, 0.f, 0.f};
#pragma unroll
        for (int ai = 0; ai < 2; ++ai)
#pragma unroll
            for (int m = 0; m < 4; ++m) { bf16_t* rowp = base + (size_t)(row0 + ai * HALF + m * 16) * ldc + col0;
#pragma unroll
                for (int bj = 0; bj < 2; ++bj) { f32x4 v0 = acc[ai][bj][m][0] + bv[bj][0], v1 = acc[ai][bj][m][1] + bv[bj][1];
                    if (ACT == 1) { f32x2 a = gelu_pk((f32x2){v0[0], v0[1]}), b = gelu_pk((f32x2){v0[2], v0[3]}), c = gelu_pk((f32x2){v1[0], v1[1]}), d = gelu_pk((f32x2){v1[2], v1[3]});
                        v0 = (f32x4){a.x, a.y, b.x, b.y}; v1 = (f32x4){c.x, c.y, d.x, d.y}; }
                    v0 = v0 * sc; v1 = v1 * sc; u32x4 w; w.x = cvt_pk_bf16(v0[0], v0[1]); w.y = cvt_pk_bf16(v0[2], v0[3]); w.z = cvt_pk_bf16(v1[0], v1[1]); w.w = cvt_pk_bf16(v1[2], v1[3]);
                    *(u32x4*)(rowp + bj * HALF) = w; } }
    }
};
template <class Epi, class Sched, bool ALIGN_EPI = false, bool SP2 = false>
__device__ __forceinline__ void gemm_phase(PG8_LAS unsigned char* lds, const Gemm g, const Sched& S, const Epi& E) {
    int tid_l = threadIdx.x; asm volatile("" : "+v"(tid_l)); const int tid = tid_l, wid = __builtin_amdgcn_readfirstlane(tid >> 6), lane = tid & 63, wr = wid >> 2, wc = wid & 3, fr = lane & 15, fq = lane >> 4;
    const int K = g.K, nt = K / BK;
    unsigned voffA[2], voffB[2];
#pragma unroll
    for (int i = 0; i < 2; ++i) { int R, C; stage_rc(tid * 16 + i * 8192, R, C); const int Rb = Epi::PERM ? ((R & ~31) + perm32(R & 31)) : R;
        voffA[i] = (unsigned)(R * K + C) * 2u; voffB[i] = (unsigned)(Rb * K + C) * 2u; }
    const size_t kstep = (size_t)(BK * 2);
    const size_t hstep = (size_t)HALF * K * 2;
    const size_t tstep = 2 * hstep;
    const unsigned ldsw = (unsigned)wid * 1024u;
    const int aoff = lds_byte(wr * 64 + fr, fq * 8), boff = lds_byte(wc * 32 + fr, fq * 8);
#define PG8_SA(b, h) (((b) * 2 + (h)) * HTB)
#define PG8_SB(b, h) ((4 + (b) * 2 + (h)) * HTB)
#define PG8_STAGE(bufoff, gbase, voff) do { _Pragma("unroll") for (int _i = 0; _i < 2; ++_i) \
        __builtin_amdgcn_global_load_lds((const unsigned*)((const char*)(gbase) + (voff)[_i]), (PG8_LAS unsigned*)(lds + (bufoff) + ldsw + _i * 8192), 16, 0, 0); } while (0)
#define PG8_LDA(dst, b, h) do { _Pragma("unroll") for (int m = 0; m < 4; ++m) _Pragma("unroll") for (int k = 0; k < 2; ++k) dst[m][k] = *(const PG8_LAS bf16x8*)(lds + PG8_SA(b, h) + aoff + m * 2048 + k * 1024); } while (0)
#define PG8_LDB(dst, b, h) do { _Pragma("unroll") for (int n = 0; n < 2; ++n) _Pragma("unroll") for (int k = 0; k < 2; ++k) dst[n][k] = *(const PG8_LAS bf16x8*)(lds + PG8_SB(b, h) + boff + n * 2048 + k * 1024); } while (0)
#define PG8_MMA(ai, bj, At, Bt) do { __builtin_amdgcn_s_setprio(1); _Pragma("unroll") for (int m = 0; m < 4; ++m) _Pragma("unroll") for (int n = 0; n < 2; ++n) _Pragma("unroll") for (int k = 0; k < 2; ++k) \
        acc[ai][bj][m][n] = __builtin_amdgcn_mfma_f32_16x16x32_bf16(Bt[n][k], At[m][k], acc[ai][bj][m][n], 0, 0, 0); __builtin_amdgcn_s_setprio(0); } while (0)
#define PG8_WAIT_V(n) asm volatile("s_waitcnt vmcnt(" #n ")" ::: "memory")
#define PG8_WAIT_L(n) asm volatile("s_waitcnt lgkmcnt(" #n ")" ::: "memory")
#define PG8_BAR __builtin_amdgcn_s_barrier()
#define PG8_SCHED __builtin_amdgcn_sched_barrier(0)
    Unit cur, nxt; int ui = 0;
    if (!S.next(0, cur)) return;
    f32x4 acc[2][2][4][2];
#pragma unroll
    for (int a = 0; a < 2; ++a)
#pragma unroll
        for (int b = 0; b < 2; ++b)
#pragma unroll
            for (int m = 0; m < 4; ++m)
#pragma unroll
                for (int n = 0; n < 2; ++n) acc[a][b][m][n] = (f32x4){0.f, 0.f, 0.f, 0.f};
    bf16x8 At[4][2], B0[2][2], B1[2][2];
    const char* cA = (const char*)g.A + (size_t)cur.pm * tstep; const char* cB = (const char*)g.Bt + (size_t)cur.pn * tstep;
    S.a_ready(cur);
    if constexpr (SP2) {
        PG8_STAGE(PG8_SB(0, 0), cB, voffB); PG8_STAGE(PG8_SB(0, 1), cB + hstep, voffB); PG8_STAGE(PG8_SA(0, 0), cA, voffA); PG8_STAGE(PG8_SA(0, 1), cA + hstep, voffA);
        if (wr == 1) PG8_BAR;
        PG8_WAIT_V(2); PG8_BAR;
        PG8_STAGE(PG8_SB(1, 0), cB + kstep, voffB); PG8_STAGE(PG8_SA(1, 0), cA + kstep, voffA); PG8_STAGE(PG8_SB(1, 1), cB + hstep + kstep, voffB);
        PG8_WAIT_V(6); PG8_BAR;
    } else {
        PG8_STAGE(PG8_SB(0, 0), cB, voffB); PG8_STAGE(PG8_SA(0, 0), cA, voffA); PG8_STAGE(PG8_SB(0, 1), cB + hstep, voffB); PG8_STAGE(PG8_SA(0, 1), cA + hstep, voffA);
        if (wr == 1) PG8_BAR;
        PG8_WAIT_V(4); PG8_BAR;
        PG8_STAGE(PG8_SB(1, 0), cB + kstep, voffB); PG8_STAGE(PG8_SA(1, 0), cA + kstep, voffA); PG8_STAGE(PG8_SB(1, 1), cB + hstep + kstep, voffB);
        PG8_WAIT_V(6); PG8_BAR;
    }
    for (;;) {
        const bool has_next = S.next(ui + 1, nxt);
        const char* nA = has_next ? (const char*)g.A + (size_t)nxt.pm * tstep : cA; const char* nB = has_next ? (const char*)g.Bt + (size_t)nxt.pn * tstep : cB;
        for (int t = 0; t < nt; t += 2) {
            const bool last = (t == nt - 2);
            const char* a1 = cA + (size_t)(t + 1) * kstep;
            const char* a2 = last ? nA : cA + (size_t)(t + 2) * kstep; const char* b2 = last ? nB : cB + (size_t)(t + 2) * kstep;
            const char* a3 = a2 + kstep; const char* b3 = b2 + kstep;
            if (last && has_next) S.a_ready(nxt);
            if constexpr (SP2) {
            PG8_LDB(B0, 0, 0); PG8_LDB(B1, 0, 1); PG8_SCHED; PG8_LDA(At, 0, 0); PG8_STAGE(PG8_SA(1, 1), a1 + hstep, voffA);
            PG8_WAIT_V(8); PG8_WAIT_L(0); PG8_BAR; PG8_MMA(0, 0, At, B0); PG8_MMA(0, 1, At, B1); PG8_BAR; PG8_SCHED;
            PG8_LDA(At, 0, 1); PG8_STAGE(PG8_SB(0, 0), b2, voffB); PG8_STAGE(PG8_SB(0, 1), b2 + hstep, voffB); PG8_STAGE(PG8_SA(0, 0), a2, voffA);
            PG8_WAIT_V(8); PG8_WAIT_L(0); PG8_BAR; PG8_MMA(1, 0, At, B0); PG8_MMA(1, 1, At, B1); PG8_BAR; PG8_SCHED;
            PG8_LDB(B0, 1, 0); PG8_LDB(B1, 1, 1); PG8_SCHED; PG8_LDA(At, 1, 0); PG8_STAGE(PG8_SA(0, 1), a2 + hstep, voffA);
            PG8_WAIT_V(8); PG8_WAIT_L(0); PG8_BAR; PG8_MMA(0, 0, At, B0); PG8_MMA(0, 1, At, B1); PG8_BAR; PG8_SCHED;
            PG8_LDA(At, 1, 1); PG8_STAGE(PG8_SB(1, 0), b3, voffB); PG8_STAGE(PG8_SB(1, 1), b3 + hstep, voffB); PG8_STAGE(PG8_SA(1, 0), a3, voffA);
            PG8_WAIT_V(8); PG8_WAIT_L(0); PG8_BAR; PG8_MMA(1, 0, At, B0); PG8_MMA(1, 1, At, B1); PG8_BAR; PG8_SCHED;
            } else {
            PG8_LDB(B0, 0, 0); PG8_SCHED; PG8_LDA(At, 0, 0); PG8_STAGE(PG8_SA(1, 1), a1 + hstep, voffA);
            PG8_WAIT_L(8); PG8_BAR; PG8_WAIT_L(0); PG8_MMA(0, 0, At, B0); PG8_BAR; PG8_SCHED;
            PG8_LDB(B1, 0, 1); PG8_STAGE(PG8_SB(0, 0), b2, voffB);
            PG8_BAR; PG8_WAIT_L(0); PG8_MMA(0, 1, At, B1); PG8_BAR;
            PG8_LDA(At, 0, 1); PG8_STAGE(PG8_SA(0, 0), a2, voffA);
            PG8_BAR; PG8_WAIT_L(0); PG8_MMA(1, 0, At, B0); PG8_BAR; PG8_SCHED;
            PG8_STAGE(PG8_SB(0, 1), b2 + hstep, voffB);
            PG8_WAIT_V(6); PG8_BAR; PG8_MMA(1, 1, At, B1); PG8_BAR;
            PG8_LDB(B0, 1, 0); PG8_SCHED; PG8_LDA(At, 1, 0); PG8_STAGE(PG8_SA(0, 1), a2 + hstep, voffA);
            PG8_WAIT_L(8); PG8_BAR; PG8_WAIT_L(0); PG8_MMA(0, 0, At, B0); PG8_BAR; PG8_SCHED;
            PG8_LDB(B1, 1, 1); PG8_STAGE(PG8_SB(1, 0), b3, voffB);
            PG8_BAR; PG8_WAIT_L(0); PG8_MMA(0, 1, At, B1); PG8_BAR;
            PG8_LDA(At, 1, 1); PG8_STAGE(PG8_SA(1, 0), a3, voffA);
            PG8_BAR; PG8_WAIT_L(0); PG8_MMA(1, 0, At, B0); PG8_BAR; PG8_SCHED;
            PG8_STAGE(PG8_SB(1, 1), b3 + hstep, voffB);
            PG8_WAIT_V(6); PG8_BAR; PG8_MMA(1, 1, At, B1); PG8_BAR;
            }
        }
        if constexpr (ALIGN_EPI) { if (wr == 0) PG8_BAR; }
        if constexpr (!Epi::AFTER_DRAIN) { E(acc, cur, wr, wc, fr, fq); S.done(cur); }
        if (!has_next) break;
#pragma unroll
        for (int a = 0; a < 2; ++a)
#pragma unroll
            for (int b = 0; b < 2; ++b)
#pragma unroll
                for (int m = 0; m < 4; ++m)
#pragma unroll
                    for (int n = 0; n < 2; ++n) acc[a][b][m][n] = (f32x4){0.f, 0.f, 0.f, 0.f};
        cur = nxt; cA = nA; cB = nB; ++ui;
        if constexpr (ALIGN_EPI) { if (wr == 1) PG8_BAR; }
    }
    PG8_WAIT_V(0);
    if constexpr (!ALIGN_EPI) { if (wr == 0) PG8_BAR; }
    PG8_BAR;
    if constexpr (Epi::AFTER_DRAIN) { E.fused(acc, cur, wr, wc, fr, fq, lds, wid, lane); S.done(cur); }
#undef PG8_SA
#undef PG8_SB
#undef PG8_STAGE
#undef PG8_LDA
#undef PG8_LDB
#undef PG8_MMA
#undef PG8_WAIT_V
#undef PG8_WAIT_L
#undef PG8_BAR
#undef PG8_SCHED
}
}

#define LAS __attribute__((address_space(3)))
typedef unsigned short bf16_t;
typedef short bf16x8 __attribute__((ext_vector_type(8)));
typedef short s16x4 __attribute__((ext_vector_type(4)));
typedef float f32x4 __attribute__((ext_vector_type(4)));
typedef float f32x16 __attribute__((ext_vector_type(16)));
typedef unsigned u32x4 __attribute__((ext_vector_type(4)));
typedef unsigned u32x2 __attribute__((ext_vector_type(2)));

constexpr int NB = 2, T = 8192, M = NB * T, DM = 2048, NZ = 6144, DFF = 5632, NFF2 = 11264, DEPTH = 4;
constexpr int WIN_COLS = 6156;
constexpr int ZC_AX = 0, ZC_AG = 512, ZC_BQ = 1024, ZC_BK = 1536, ZC_BV = 2048, ZC_CQ = 2560, ZC_CZ = 4096, ZC_DQ = 4608, ZC_DK = 5120, ZC_DV = 5632;
constexpr float EPS = 1e-6f;
constexpr int NTHR = 512;

constexpr size_t MiB = 1u << 20;
constexpr size_t WS_CTL = 0, WS_WIN = 1 * MiB, WS_WOUT = 97 * MiB, WS_WUP = 129 * MiB, WS_WDN = 305 * MiB, WS_WG = 393 * MiB, WS_HB = 394 * MiB, WS_ACT = 458 * MiB;
constexpr size_t WS_Z = 634 * MiB, WS_Y = 826 * MiB, WS_GL = 890 * MiB, WS_FOXC = 891 * MiB, WS_LRUA = 892 * MiB, WS_LRUU = 924 * MiB, WS_LAGG = 956 * MiB;
constexpr size_t WS_GREC = 957 * MiB, WS_GU = 1013 * MiB, WS_GLAST = 1045 * MiB, WS_OC = 1046 * MiB, WS_OD = 1078 * MiB, WS_LSE = 1126 * MiB, WS_END = 1127 * MiB;
constexpr size_t WS_U = 634 * MiB;
constexpr int GREC_BYTES = 57344;

constexpr int LDS_BYTES = 147456;
constexpr int LDS_MISC = 140 * 1024;

__device__ __forceinline__ unsigned f2bf(float f) { unsigned u = __builtin_bit_cast(unsigned, f); return (u + 0x7fffu + ((u >> 16) & 1u)) >> 16; }
__device__ __forceinline__ unsigned pk2(float lo, float hi) { return f2bf(lo) | (f2bf(hi) << 16); }
__device__ __forceinline__ float bf2f(unsigned short u) { return __builtin_bit_cast(float, (unsigned)u << 16); }
__device__ __forceinline__ float bflo(unsigned w) { return __builtin_bit_cast(float, w << 16); }
__device__ __forceinline__ float bfhi(unsigned w) { return __builtin_bit_cast(float, w & 0xffff0000u); }
__device__ __forceinline__ float wave_sum(float v) {
#pragma unroll
    for (int o = 1; o < 64; o <<= 1) v += __shfl_xor(v, o);
    return v;
}
__device__ __forceinline__ float sigmoidf_(float x) { return 1.0f / (1.0f + __expf(-x)); }
__device__ __forceinline__ float siluf_(float x) { return x / (1.0f + __expf(-x)); }
__device__ __forceinline__ float softplusf_(float x) { return fmaxf(x, 0.f) + log1pf(__expf(-fabsf(x))); }
__device__ __forceinline__ float gelu_tanh(float x) { const float u = 0.7978845608028654f * (x + 0.044715f * x * x * x); return 0.5f * x * (1.0f + tanhf(u)); }
__device__ __forceinline__ int perm32(int p) { const int g = p >> 3, j = p & 7; return (j < 4) ? (4 * g + j) : (16 + 4 * g + (j - 4)); }
__device__ __forceinline__ int invperm32(int x) { return (x < 16) ? (8 * (x >> 2) + (x & 3)) : (8 * ((x - 16) >> 2) + 4 + (x & 3)); }

struct Params {
    const float* in[25];
    float* out;
    unsigned char* ws;
};
struct Ctx {
    const LAS unsigned* tab;
    __device__ __forceinline__ unsigned long long ld(int i) const {
        const LAS unsigned* t = tab; asm volatile("" : "+v"(t));
        const unsigned lo = __builtin_amdgcn_readfirstlane(t[2 * i]), hi = __builtin_amdgcn_readfirstlane(t[2 * i + 1]);
        return ((unsigned long long)hi << 32) | lo;
    }
    __device__ __forceinline__ const float* in(int i) const { return (const float*)ld(i); }
    __device__ __forceinline__ float* out() const { return (float*)ld(25); }
    __device__ __forceinline__ unsigned char* ws() const { return (unsigned char*)ld(26); }
};

__device__ __forceinline__ void p0_item(const float* W, int ldw, int ncol0, bf16_t* WT, int K, int nrow0, int k0, LAS float* scr, int lane) {
#pragma unroll 8
    for (int i = 0; i < 32; ++i) { const int kk = 2 * i + (lane >> 5); scr[kk * 33 + (lane & 31)] = W[(size_t)(k0 + kk) * ldw + ncol0 + (lane & 31)]; }
    asm volatile("s_waitcnt lgkmcnt(0)" ::: "memory");
    const int c = lane & 7;
#pragma unroll
    for (int j = 0; j < 4; ++j) {
        const int n = (lane >> 3) + 8 * j; const LAS float* s = scr + (8 * c) * 33 + n;
        u32x4 o; o.x = pk2(s[0 * 33], s[1 * 33]); o.y = pk2(s[2 * 33], s[3 * 33]); o.z = pk2(s[4 * 33], s[5 * 33]); o.w = pk2(s[6 * 33], s[7 * 33]);
        *(u32x4*)(WT + (size_t)(nrow0 + n) * K + k0 + 8 * c) = o;
    }
    asm volatile("s_waitcnt lgkmcnt(0)" ::: "memory");
}
__device__ __forceinline__ int win_orig_col(int p) { return p < 2560 ? p : (p < 4096 ? p + 4 : (p < 4608 ? p + 4 : p + 12)); }

__device__ __forceinline__ void p0_prologue(const Ctx& P, LAS unsigned char* lds, int gw, int NGW, int wave, int lane) {
    LAS float* scr = (LAS float*)(lds + wave * 16384);
    constexpr int I_IN = (DM / 64) * (NZ / 32), I_OUT = (DM / 64) * (DM / 32), I_UP = (DM / 64) * (NFF2 / 32), I_DN = (DFF / 64) * (DM / 32);
    constexpr int PER_L = I_IN + I_OUT + I_UP + I_DN;
    unsigned char* ws = P.ws();
    for (int it = gw; it < PER_L * DEPTH; it += NGW) {
        const int l = it / PER_L; int r = it % PER_L;
        if (r < I_IN) { const int nblk = NZ / 32, kb = r / nblk, nb = r % nblk;
            p0_item(P.in(2) + (size_t)l * DM * WIN_COLS, WIN_COLS, win_orig_col(32 * nb), (bf16_t*)(ws + WS_WIN) + (size_t)l * NZ * DM, DM, 32 * nb, 64 * kb, scr, lane); continue; }
        r -= I_IN;
        if (r < I_OUT) { const int nblk = DM / 32, kb = r / nblk, nb = r % nblk;
            p0_item(P.in(18) + (size_t)l * DM * DM, DM, 32 * nb, (bf16_t*)(ws + WS_WOUT) + (size_t)l * DM * DM, DM, 32 * nb, 64 * kb, scr, lane); continue; }
        r -= I_OUT;
        if (r < I_UP) { const int nblk = NFF2 / 32, kb = r / nblk, nb = r % nblk;
            p0_item(P.in(20) + (size_t)l * DM * NFF2, NFF2, 32 * nb, (bf16_t*)(ws + WS_WUP) + (size_t)l * NFF2 * DM, DM, 32 * nb, 64 * kb, scr, lane); continue; }
        r -= I_UP;
        { const int nblk = DM / 32, kb = r / nblk, nb = r % nblk;
            p0_item(P.in(23) + (size_t)l * DFF * DM, DM, 32 * nb, (bf16_t*)(ws + WS_WDN) + (size_t)l * DM * DFF, DFF, 32 * nb, 64 * kb, scr, lane); }
    }
    float* WG = (float*)(ws + WS_WG);
    const int gt = gw * 64 + lane, NGT = NGW * 64;
    for (int i = gt; i < DEPTH * 12 * DM; i += NGT) {
        const int l = i / (12 * DM), j = (i / DM) % 12, k = i % DM;
        const int col = (j < 4) ? (2560 + j) : (j < 8 ? 4612 + (j - 4) : 4616 + (j - 8));
        WG[i] = P.in(2)[(size_t)l * DM * WIN_COLS + (size_t)k * WIN_COLS + col];
    }
}

template <bool GATES>
__device__ __forceinline__ void norm_phase(const float* src, float* copy_dst, const float* gain, bf16_t* HB, const float* WGl, float* GL,
                                           LAS unsigned char* lds, int tid, int wave, int lane, int bid, int nblk) {
    LAS float* wg = (LAS float*)lds;
    if (GATES) {
        for (int i = tid; i < 12 * DM / 4; i += NTHR) ((LAS f32x4*)wg)[i] = ((const f32x4*)WGl)[i];
        __syncthreads();
    }
    f32x4 gv[8];
#pragma unroll
    for (int j = 0; j < 8; ++j) gv[j] = ((const f32x4*)gain)[lane + 64 * j];
    for (int m = bid * 8 + wave; m < M; m += nblk * 8) {
        const f32x4* xr = (const f32x4*)(src + (size_t)m * DM);
        f32x4 v[8]; float ss = 0.f;
#pragma unroll
        for (int j = 0; j < 8; ++j) { v[j] = xr[lane + 64 * j]; ss += (v[j].x * v[j].x + v[j].y * v[j].y) + (v[j].z * v[j].z + v[j].w * v[j].w); }
        if (copy_dst) {
            f32x4* cr = (f32x4*)(copy_dst + (size_t)m * DM);
#pragma unroll
            for (int j = 0; j < 8; ++j) cr[lane + 64 * j] = v[j];
        }
        const float rs = rsqrtf(wave_sum(ss) * (1.0f / DM) + EPS);
        u32x2* o8 = (u32x2*)(HB + (size_t)m * DM);
#pragma unroll
        for (int j = 0; j < 8; ++j) { v[j] = v[j] * rs * gv[j]; u32x2 w; w.x = pk2(v[j].x, v[j].y); w.y = pk2(v[j].z, v[j].w); o8[lane + 64 * j] = w; }
        if (GATES) {
            float myv = 0.f;
#pragma unroll 1
            for (int g = 0; g < 12; ++g) {
                float a = 0.f;
#pragma unroll
                for (int j = 0; j < 8; ++j) { const f32x4 w = ((LAS f32x4*)(wg + g * DM))[lane + 64 * j]; a += (v[j].x * w.x + v[j].y * w.y) + (v[j].z * w.z + v[j].w * w.w); }
                a = wave_sum(a);
                if (lane == g) myv = a;
            }
            if (lane < 12) GL[(size_t)m * 16 + lane] = myv;
        }
    }
    if (GATES) __syncthreads();
}

__device__ __forceinline__ void final_norm_phase(float* X, const float* gain, int wave, int lane, int bid, int nblk) {
    f32x4 gv[8];
#pragma unroll
    for (int j = 0; j < 8; ++j) gv[j] = ((const f32x4*)gain)[lane + 64 * j];
    for (int m = bid * 8 + wave; m < M; m += nblk * 8) {
        f32x4* xr = (f32x4*)(X + (size_t)m * DM);
        f32x4 v[8]; float ss = 0.f;
#pragma unroll
        for (int j = 0; j < 8; ++j) { v[j] = xr[lane + 64 * j]; ss += (v[j].x * v[j].x + v[j].y * v[j].y) + (v[j].z * v[j].z + v[j].w * v[j].w); }
        const float rs = rsqrtf(wave_sum(ss) * (1.0f / DM) + EPS);
#pragma unroll
        for (int j = 0; j < 8; ++j) xr[lane + 64 * j] = v[j] * rs * gv[j];
    }
}

struct EpiResAdd {
    static constexpr bool PERM = false, AFTER_DRAIN = false;
    float* X; int ldc;
    __device__ __forceinline__ void operator()(const pg8::f32x4 (&acc)[2][2][4][2], const pg8::Unit& u, int wr, int wc, int fr, int fq) const {
#pragma unroll
        for (int ai = 0; ai < 2; ++ai)
#pragma unroll
            for (int m = 0; m < 4; ++m) {
                float* rowp = X + (size_t)(u.pm * 256 + ai * 128 + wr * 64 + m * 16 + fr) * ldc + u.pn * 256 + wc * 32 + 4 * fq;
#pragma unroll
                for (int bj = 0; bj < 2; ++bj)
#pragma unroll
                    for (int n = 0; n < 2; ++n) { pg8::f32x4* p = (pg8::f32x4*)(rowp + bj * 128 + n * 16); *p = *p + acc[ai][bj][m][n]; }
            }
    }
};
#define XB_TMO      128
#define XB_XCNT(j)  (256  + 64 * (j))
#define XB_XSUB(j)  (1280 + 64 * (j))
#define XB_XGEN(j)  (2304 + 64 * (j))
#define XB_TOP      3328
#define XB_TOPGEN   3392
#define XCD_BAR_WORDS 3456
#define XB_SPIN_CAP (1u << 18)

__device__ __forceinline__ unsigned xb_ld(unsigned* p)              { return __hip_atomic_load(p, __ATOMIC_RELAXED, __HIP_MEMORY_SCOPE_AGENT); }
__device__ __forceinline__ unsigned xb_add(unsigned* p, unsigned v) { return __hip_atomic_fetch_add(p, v, __ATOMIC_RELAXED, __HIP_MEMORY_SCOPE_AGENT); }
__device__ __forceinline__ unsigned xb_xcc_id() { return (unsigned)__builtin_amdgcn_s_getreg((3 << 11) | 20) & 0xFu; }
#define XB_SPIN(cond, bar) do { unsigned _sp = 0; while (cond) { __builtin_amdgcn_s_sleep(1); \
    if ((++_sp & 255u) == 0u) { if (xb_ld(&(bar)[XB_TMO])) break; if (_sp > XB_SPIN_CAP) { atomicAdd(&(bar)[XB_TMO], 1u); break; } } } } while (0)

struct XcdBarrier {
    unsigned* bar; unsigned x;
    volatile LAS unsigned* st;
};

__device__ __forceinline__ XcdBarrier xcd_barrier_post(unsigned* bar, volatile LAS unsigned* st) {
    XcdBarrier b; b.bar = bar; b.x = xb_xcc_id(); b.st = st;
    if (threadIdx.x == 0) (void)xb_add(&bar[XB_XCNT(b.x)], 1u);
    return b;
}
__device__ __forceinline__ void xcd_barrier_complete(unsigned* bar, unsigned x, unsigned& nloc, unsigned& nx) {
    const unsigned G = gridDim.x * gridDim.y * gridDim.z;
    unsigned sum, cnt, mine, sp = 0u;
    for (;;) {
        sum = 0u; cnt = 0u; mine = 0u;
#pragma unroll
        for (unsigned j = 0; j < 16; ++j) { const unsigned c = xb_ld(&bar[XB_XCNT(j)]); sum += c; cnt += (c > 0u) ? 1u : 0u; mine = (j == x) ? c : mine; }
        if (sum == G) break;
        __builtin_amdgcn_s_sleep(1);
        if ((++sp & 255u) == 0u) { if (xb_ld(&bar[XB_TMO])) break; if (sp > XB_SPIN_CAP) { atomicAdd(&bar[XB_TMO], 1u); break; } }
    }
    nloc = mine > 0u ? mine : 1u; nx = cnt > 0u ? cnt : 1u;
}

__device__ __forceinline__ void xcd_barrier(const XcdBarrier& b) {
    asm volatile("s_waitcnt vmcnt(0)" ::: "memory");
    __syncthreads();
    if (threadIdx.x == 0) {
        unsigned* bar = b.bar;
        __builtin_amdgcn_s_waitcnt(0);
        unsigned nloc = b.st[0], nx = b.st[1];
        if (nloc == 0u) { xcd_barrier_complete(bar, b.x, nloc, nx); b.st[0] = nloc; b.st[1] = nx; }
        const unsigned old = xb_add(&bar[XB_XSUB(b.x)], 1u);
        const unsigned gen = old / nloc;
        if (old + 1u == (gen + 1u) * nloc) {
            __builtin_amdgcn_fence(__ATOMIC_RELEASE, "agent");
            asm volatile("s_waitcnt vmcnt(0)" ::: "memory");
            const unsigned og = xb_add(&bar[XB_TOP], 1u);
            const unsigned tg = og / nx;
            if (og + 1u == (tg + 1u) * nx) xb_add(&bar[XB_TOPGEN], 1u);
            else XB_SPIN(xb_ld(&bar[XB_TOPGEN]) == tg, bar);
            __builtin_amdgcn_fence(__ATOMIC_ACQUIRE, "agent");
            xb_add(&bar[XB_XGEN(b.x)], 1u);
            asm volatile("s_waitcnt vmcnt(0)" ::: "memory");
        } else {
            XB_SPIN(xb_ld(&bar[XB_XGEN(b.x)]) == gen, bar);
            __builtin_amdgcn_fence(__ATOMIC_ACQUIRE, "agent");
            asm volatile("s_waitcnt vmcnt(0)" ::: "memory");
        }
    }
    __syncthreads();
}

__device__ __forceinline__ void lru_chunk_unit(const Ctx& P, int l, int unit, LAS unsigned char* lds, int tid, int wave, int lane) {
    const bf16_t* Z = (const bf16_t*)(P.ws() + WS_Z);
    float* LA = (float*)(P.ws() + WS_LRUA); float* LU = (float*)(P.ws() + WS_LRUU); float* AGG = (float*)(P.ws() + WS_LAGG);
    const int b = unit >> 7, ck = unit & 127, t0 = ck * 64; const size_t m0 = (size_t)b * T + t0;
    const int ch = tid;
    const float* cw = P.in(3) + (size_t)l * 4 * 512; const float cb = P.in(4)[l * 512 + ch];
    const float w0 = cw[ch], w1 = cw[512 + ch], w2 = cw[1024 + ch], w3 = cw[1536 + ch];
    LAS float* xw = (LAS float*)(lds + wave * 16384);
    float x3 = 0.f, x2 = 0.f, x1 = 0.f;
    if (t0 > 0) { x3 = bf2f(Z[(m0 - 3) * NZ + ZC_AX + ch]); x2 = bf2f(Z[(m0 - 2) * NZ + ZC_AX + ch]); x1 = bf2f(Z[(m0 - 1) * NZ + ZC_AX + ch]); }
#pragma unroll 4
    for (int t = 0; t < 64; ++t) {
        const float x0 = bf2f(Z[(m0 + t) * NZ + ZC_AX + ch]);
        xw[t * 64 + lane] = cb + w0 * x3 + w1 * x2 + w2 * x1 + w3 * x0;
        x3 = x2; x2 = x1; x1 = x0;
    }
    asm volatile("s_waitcnt lgkmcnt(0)" ::: "memory");
    const float* wa = P.in(5) + ((size_t)l * 8 + wave) * 4096; const float* wx = P.in(7) + ((size_t)l * 8 + wave) * 4096;
    const float ba = P.in(6)[l * 512 + ch], bx = P.in(8)[l * 512 + ch];
    const float lam = P.in(9)[l * 512 + ch]; const float sp = softplusf_(-lam);
    float h = 0.f, ap = 1.f;
    for (int half = 0; half < 2; ++half) {
        float ra[32], ia[32];
#pragma unroll
        for (int t = 0; t < 32; ++t) { ra[t] = ba; ia[t] = bx; }
        for (int c = 0; c < 64; c += 4) {
            const float a0 = wa[(c + 0) * 64 + lane], a1 = wa[(c + 1) * 64 + lane], a2 = wa[(c + 2) * 64 + lane], a3 = wa[(c + 3) * 64 + lane];
            const float b0 = wx[(c + 0) * 64 + lane], b1 = wx[(c + 1) * 64 + lane], b2 = wx[(c + 2) * 64 + lane], b3 = wx[(c + 3) * 64 + lane];
#pragma unroll
            for (int t = 0; t < 32; ++t) {
                const f32x4 xv = *(const LAS f32x4*)(xw + (half * 32 + t) * 64 + c);
                ra[t] += xv.x * a0 + xv.y * a1 + xv.z * a2 + xv.w * a3;
                ia[t] += xv.x * b0 + xv.y * b1 + xv.z * b2 + xv.w * b3;
            }
        }
#pragma unroll
        for (int t = 0; t < 32; ++t) {
            const int tt = half * 32 + t;
            const float r = sigmoidf_(ra[t]), ig = sigmoidf_(ia[t]);
            const float log_a = -8.0f * r * sp;
            const float a = __expf(log_a);
            const float u = sqrtf(-expm1f(2.0f * log_a)) * (ig * xw[tt * 64 + lane]);
            LA[(m0 + tt) * 512 + ch] = a; LU[(m0 + tt) * 512 + ch] = u;
            h = a * h + u; ap *= a;
        }
    }
    AGG[((size_t)unit * 2 + 0) * 512 + ch] = ap; AGG[((size_t)unit * 2 + 1) * 512 + ch] = h;
}

__device__ __forceinline__ void fox_cumsum_unit(const Ctx& P, int l, int unit, LAS unsigned char* lds, int tid, int wave, int lane) {
    const float* GL = (const float*)(P.ws() + WS_GL); float* FC = (float*)(P.ws() + WS_FOXC);
    const int b = unit >> 2, hh = unit & 3; const float fb = P.in(10)[l * 4 + hh];
    LAS float* wtot = (LAS float*)lds;
    float v[16]; float s = 0.f;
#pragma unroll
    for (int i = 0; i < 16; ++i) { const float x = GL[((size_t)b * T + tid * 16 + i) * 16 + hh] + fb; const float lf = fminf(x, 0.f) - log1pf(__expf(-fabsf(x))); s += lf; v[i] = s; }
    float sc = s;
#pragma unroll
    for (int o = 1; o < 64; o <<= 1) { const float n = __shfl_up(sc, o); if (lane >= o) sc += n; }
    __syncthreads();
    if (lane == 63) wtot[wave] = sc;
    __syncthreads();
    float base = sc - s;
    for (int w = 0; w < wave; ++w) base += wtot[w];
#pragma unroll
    for (int i = 0; i < 16; ++i) FC[((size_t)unit) * T + tid * 16 + i] = base + v[i];
    __syncthreads();
}

__device__ __forceinline__ void gdn_prep_unit(const Ctx& P, int l, int unit, LAS unsigned char* lds, int tid, int wave, int lane) {
    const bf16_t* Z = (const bf16_t*)(P.ws() + WS_Z); const float* GL = (const float*)(P.ws() + WS_GL);
    const int bh = unit >> 7, n = unit & 127, b = bh >> 2, hh = bh & 3; const size_t m0 = (size_t)b * T + n * 64;
    LAS float* Kf = (LAS float*)lds; LAS float* Qf = Kf + 64 * 132; LAS float* Vf = Qf + 64 * 132; LAS float* KK = Vf + 64 * 132; LAS float* QKm = KK + 64 * 68;
    LAS float* gcs = QKm + 64 * 68; LAS float* bet = gcs + 64; LAS float* eg = bet + 64;
    __syncthreads();
    {
        const int ch = tid & 127, tg = tid >> 7, tb = tg * 16;
        const float* cw = P.in(11) + (size_t)l * 4 * 1536;
#pragma unroll
        for (int part = 0; part < 3; ++part) {
            const int cc = part * 512 + hh * 128 + ch; const int zc = ZC_CQ + cc;
            const float w0 = cw[cc], w1 = cw[1536 + cc], w2 = cw[3072 + cc], w3 = cw[4608 + cc];
            float x3 = 0.f, x2 = 0.f, x1 = 0.f;
            if (n * 64 + tb > 0) { x3 = bf2f(Z[(m0 + tb - 3) * NZ + zc]); x2 = bf2f(Z[(m0 + tb - 2) * NZ + zc]); x1 = bf2f(Z[(m0 + tb - 1) * NZ + zc]); }
            LAS float* dst = (part == 0) ? Qf : (part == 1 ? Kf : Vf);
#pragma unroll 4
            for (int t = 0; t < 16; ++t) {
                const float x0 = bf2f(Z[(m0 + tb + t) * NZ + zc]);
                dst[(tb + t) * 132 + ch] = siluf_(w0 * x3 + w1 * x2 + w2 * x1 + w3 * x0);
                x3 = x2; x2 = x1; x1 = x0;
            }
        }
        if (tid < 64) {
            const float bl = GL[(m0 + tid) * 16 + 4 + hh], al = GL[(m0 + tid) * 16 + 8 + hh];
            const float g = -__expf(P.in(12)[l * 4 + hh]) * softplusf_(al + P.in(13)[l * 4 + hh]);
            float sc = g;
#pragma unroll
            for (int o = 1; o < 64; o <<= 1) { const float nn = __shfl_up(sc, o); if (lane >= o) sc += nn; }
            gcs[tid] = sc; eg[tid] = __expf(sc); bet[tid] = sigmoidf_(bl);
        }
    }
    __syncthreads();
    {
        const int row = tid >> 2, j = tid & 3; LAS float* base = (row < 64) ? (Qf + row * 132) : (Kf + (row - 64) * 132);
        float ss = 0.f;
#pragma unroll 8
        for (int e = 0; e < 32; ++e) { const float x = base[4 * e + j]; ss += x * x; }
        ss += __shfl_xor(ss, 1); ss += __shfl_xor(ss, 2);
        const float rn = rsqrtf(ss + EPS) * ((row < 64) ? 0.08838834764831845f : 1.0f);
#pragma unroll 8
        for (int e = 0; e < 32; ++e) base[4 * e + j] *= rn;
    }
    __syncthreads();
    {
        const int ti = tid >> 3, tj = tid & 7;
        float akk[8], aqk[8];
#pragma unroll
        for (int jj = 0; jj < 8; ++jj) { akk[jj] = 0.f; aqk[jj] = 0.f; }
        for (int d = 0; d < 128; d += 4) {
            const f32x4 ki = *(const LAS f32x4*)(Kf + ti * 132 + d), qi = *(const LAS f32x4*)(Qf + ti * 132 + d);
#pragma unroll
            for (int jj = 0; jj < 8; ++jj) {
                const f32x4 kj = *(const LAS f32x4*)(Kf + (8 * jj + tj) * 132 + d);
                akk[jj] += (ki.x * kj.x + ki.y * kj.y) + (ki.z * kj.z + ki.w * kj.w);
                aqk[jj] += (qi.x * kj.x + qi.y * kj.y) + (qi.z * kj.z + qi.w * kj.w);
            }
        }
        const float gi = gcs[ti], bi = bet[ti];
#pragma unroll
        for (int jj = 0; jj < 8; ++jj) {
            const int j = 8 * jj + tj;
            const float dec = (j <= ti) ? __expf(gi - gcs[j]) : 0.f;
            KK[ti * 68 + j] = (j < ti) ? akk[jj] * bi * dec : 0.f;
            QKm[ti * 68 + j] = (j <= ti) ? aqk[jj] * dec : 0.f;
        }
    }
    __syncthreads();
    unsigned char* rec = P.ws() + WS_GREC + (size_t)unit * GREC_BYTES;
    {
#pragma unroll
        for (int it = 0; it < 2; ++it) {
            const int chunk = tid + it * NTHR, c = chunk >> 4, p0 = (chunk & 15) * 8; const float e = eg[c]; float v[8];
#pragma unroll
            for (int j = 0; j < 8; ++j) v[j] = Qf[c * 132 + (p0 & ~31) + perm32((p0 & 31) + j)] * e;
            u32x4 o; o.x = pk2(v[0], v[1]); o.y = pk2(v[2], v[3]); o.z = pk2(v[4], v[5]); o.w = pk2(v[6], v[7]);
            *(u32x4*)(rec + 16384 + (size_t)(c * 128 + p0) * 2) = o;
        }
        {
            const int i = tid >> 3, p0 = (tid & 7) * 8; float v[8];
#pragma unroll
            for (int j = 0; j < 8; ++j) v[j] = QKm[i * 68 + (p0 & ~31) + perm32((p0 & 31) + j)];
            u32x4 o; o.x = pk2(v[0], v[1]); o.y = pk2(v[2], v[3]); o.z = pk2(v[4], v[5]); o.w = pk2(v[6], v[7]);
            *(u32x4*)(rec + 32768 + (size_t)(i * 64 + p0) * 2) = o;
        }
        const float glast = gcs[63];
#pragma unroll
        for (int it = 0; it < 2; ++it) {
            const int chunk = tid + it * NTHR, dk = chunk & 127, p0 = (chunk >> 7) * 8; float v[8];
#pragma unroll
            for (int j = 0; j < 8; ++j) { const int c = (p0 & ~31) + perm32((p0 & 31) + j); v[j] = Kf[c * 132 + dk] * __expf(glast - gcs[c]); }
            u32x4 o; o.x = pk2(v[0], v[1]); o.y = pk2(v[2], v[3]); o.z = pk2(v[4], v[5]); o.w = pk2(v[6], v[7]);
            *(u32x4*)(rec + 40960 + (size_t)(dk * 64 + p0) * 2) = o;
        }
        if (tid == 0) ((float*)(P.ws() + WS_GLAST))[unit] = __expf(glast);
    }
    if (tid < 256) {
        const int col = tid; float sol[64];
        if (col < 128) {
#pragma unroll
            for (int j = 0; j < 64; ++j) sol[j] = Vf[j * 132 + col] * bet[j];
        } else {
#pragma unroll
            for (int j = 0; j < 64; ++j) sol[j] = Kf[j * 132 + (col - 128)] * bet[j] * eg[j];
        }
#pragma unroll
        for (int i = 1; i < 64; ++i) {
            float acc = sol[i];
#pragma unroll
            for (int j4 = 0; j4 < (i + 3) / 4; ++j4) {
                const f32x4 kk = *(const LAS f32x4*)(KK + i * 68 + 4 * j4);
                acc -= kk.x * sol[4 * j4 + 0]; acc -= kk.y * sol[4 * j4 + 1]; acc -= kk.z * sol[4 * j4 + 2]; acc -= kk.w * sol[4 * j4 + 3];
            }
            sol[i] = acc;
        }
        if (col < 128) {
            float* U = (float*)(P.ws() + WS_GU) + (size_t)unit * 8192;
#pragma unroll
            for (int i = 0; i < 64; ++i) U[i * 128 + col] = sol[i];
        } else {
            const int dk = col - 128; const int pos = (dk & ~31) + invperm32(dk & 31);
            bf16_t* Wp = (bf16_t*)rec;
#pragma unroll
            for (int i = 0; i < 64; ++i) Wp[i * 128 + pos] = (bf16_t)f2bf(-sol[i]);
        }
    }
    __syncthreads();
}

constexpr int AT_KSTR = 272, AT_VSTR = 320;
constexpr int AT_KBUF = 64 * AT_KSTR, AT_VBUF = 64 * AT_VSTR;
constexpr int AT_K0 = 0, AT_V0 = 2 * AT_KBUF, AT_C0 = AT_V0 + 2 * AT_VBUF;

__device__ __forceinline__ s16x4 vtr(const LAS unsigned char* p) {
    typedef short v4i16_t __attribute__((ext_vector_type(4)));
    return __builtin_bit_cast(s16x4, __builtin_amdgcn_ds_read_tr16_b64_v4i16((LAS v4i16_t*)p));
}

template <int MODE>
__device__ __forceinline__ void attn_unit(const Ctx& P, int l, LAS unsigned char* lds, int tid, int wave, int lane,
                                          int b, int hh, int dil, int res, int m0, int branch) {
    const bf16_t* Z = (const bf16_t*)(P.ws() + WS_Z);
    const int qcol = (MODE == 0 ? ZC_BQ : ZC_DQ) + hh * 128, kcol = (MODE == 0 ? ZC_BK : ZC_DK) + hh * 128, vcol = (MODE == 0 ? ZC_BV : ZC_DV) + hh * 128;
    const size_t rowbase = (size_t)b * T + res;
    const float* FC = (const float*)(P.ws() + WS_FOXC) + (size_t)(b * 4 + hh) * T;
    const int ql = lane & 31, hi = lane >> 5;
    const int mq_lo = m0 + 32 * wave, mq = mq_lo + ql, mq_hi = mq_lo + 31;
    const int kt_lo = (MODE == 0) ? 0 : ((m0 >= 128 ? m0 - 128 : 0) >> 6), kt_hi = (m0 >> 6) + 3;
    constexpr float SC2 = 0.08838834764831845f * 1.4426950408889634f, L2E = 1.4426950408889634f;

    bf16x8 qf[8];
    {
        const bf16_t* qp = Z + (rowbase + (size_t)mq * dil) * NZ + qcol + 8 * hi;
#pragma unroll
        for (int ks = 0; ks < 8; ++ks) qf[ks] = *(const bf16x8*)(qp + 16 * ks);
    }
    float cq2 = 0.f;
    if (MODE == 0) cq2 = FC[mq] * L2E;

    const int srow = tid >> 3, spart = tid & 7;
    u32x4 kr0, kr1, vr0, vr1; float cr = 0.f;
    auto gload = [&](int kt) {
        const int mk = 64 * kt + srow;
        const bf16_t* rp = Z + (rowbase + (size_t)mk * dil) * NZ;
        kr0 = *(const u32x4*)(rp + kcol + spart * 16); kr1 = *(const u32x4*)(rp + kcol + spart * 16 + 8);
        vr0 = *(const u32x4*)(rp + vcol + spart * 16); vr1 = *(const u32x4*)(rp + vcol + spart * 16 + 8);
        if (MODE == 0 && tid < 64) cr = FC[64 * kt + tid] * L2E;
    };
    auto lstore = [&](int buf) {
        LAS unsigned char* kb = lds + AT_K0 + buf * AT_KBUF + srow * AT_KSTR + spart * 32;
        *(LAS u32x4*)kb = kr0; *(LAS u32x4*)(kb + 16) = kr1;
        LAS unsigned char* vb = lds + AT_V0 + buf * AT_VBUF + srow * AT_VSTR + spart * 32;
        *(LAS u32x4*)vb = vr0; *(LAS u32x4*)(vb + 16) = vr1;
        if (MODE == 0 && tid < 64) ((LAS float*)(lds + AT_C0))[buf * 64 + tid] = cr;
    };

    f32x16 O[4];
#pragma unroll
    for (int mt = 0; mt < 4; ++mt)
#pragma unroll
        for (int r = 0; r < 16; ++r) O[mt][r] = 0.f;
    float m_run = -INFINITY, l_run = 0.f;

    __syncthreads();
    gload(kt_lo); lstore(0);
    __syncthreads();

    const int gq = lane >> 4, li = lane & 15, tq = li >> 2, tp = li & 3;
    const int vbase_lane = (4 * (gq >> 1) + tq) * AT_VSTR + (16 * (gq & 1) + 4 * tp) * 2;

    for (int kt = kt_lo; kt <= kt_hi; ++kt) {
        const int buf = (kt - kt_lo) & 1;
        if (kt < kt_hi) gload(kt + 1);
        const bool need = (MODE == 0) ? (64 * kt <= mq_hi) : ((64 * kt + 63 >= mq_lo - 128) && (64 * kt <= mq_hi));
        if (need) {
            const LAS unsigned char* kb = lds + AT_K0 + buf * AT_KBUF + ql * AT_KSTR + hi * 16;
            f32x16 p0, p1;
#pragma unroll
            for (int r = 0; r < 16; ++r) { p0[r] = 0.f; p1[r] = 0.f; }
#pragma unroll
            for (int ks = 0; ks < 8; ++ks) {
                const bf16x8 a0 = *(const LAS bf16x8*)(kb + ks * 32);
                const bf16x8 a1 = *(const LAS bf16x8*)(kb + 32 * AT_KSTR + ks * 32);
                p0 = __builtin_amdgcn_mfma_f32_32x32x16_bf16(a0, qf[ks], p0, 0, 0, 0);
                p1 = __builtin_amdgcn_mfma_f32_32x32x16_bf16(a1, qf[ks], p1, 0, 0, 0);
            }
            const LAS float* cb = (const LAS float*)(lds + AT_C0) + buf * 64;
            float mx = -INFINITY;
#pragma unroll
            for (int a = 0; a < 4; ++a) {
                f32x4 c0 = {0.f, 0.f, 0.f, 0.f}, c1 = {0.f, 0.f, 0.f, 0.f};
                if (MODE == 0) { c0 = *(const LAS f32x4*)(cb + 8 * a + 4 * hi); c1 = *(const LAS f32x4*)(cb + 32 + 8 * a + 4 * hi); }
#pragma unroll
                for (int e = 0; e < 4; ++e) {
                    const int r = 4 * a + e; const int k0 = 64 * kt + 8 * a + 4 * hi + e, k1 = k0 + 32;
                    float s0 = p0[r] * SC2, s1 = p1[r] * SC2;
                    if (MODE == 0) { s0 += cq2 - c0[e]; s1 += cq2 - c1[e]; }
                    const bool ok0 = (MODE == 0) ? (k0 <= mq) : (k0 <= mq && mq - k0 <= 128);
                    const bool ok1 = (MODE == 0) ? (k1 <= mq) : (k1 <= mq && mq - k1 <= 128);
                    s0 = ok0 ? s0 : -INFINITY; s1 = ok1 ? s1 : -INFINITY;
                    p0[r] = s0; p1[r] = s1; mx = fmaxf(mx, fmaxf(s0, s1));
                }
            }
            mx = fmaxf(mx, __shfl_xor(mx, 32));
            const float m_new = fmaxf(m_run, mx);
            const float m_use = (m_new == -INFINITY) ? 0.f : m_new;
            const float alpha = __builtin_amdgcn_exp2f(m_run - m_use);
            float ls = 0.f;
#pragma unroll
            for (int r = 0; r < 16; ++r) { p0[r] = __builtin_amdgcn_exp2f(p0[r] - m_use); p1[r] = __builtin_amdgcn_exp2f(p1[r] - m_use); ls += p0[r] + p1[r]; }
            l_run = l_run * alpha + ls; m_run = m_new;
#pragma unroll
            for (int mt = 0; mt < 4; ++mt)
#pragma unroll
                for (int r = 0; r < 16; ++r) O[mt][r] *= alpha;
            bf16x8 pf[4];
#pragma unroll
            for (int s = 0; s < 4; ++s) {
                u32x4 w;
                if (s < 2) { w.x = pk2(p0[8 * s + 0], p0[8 * s + 1]); w.y = pk2(p0[8 * s + 2], p0[8 * s + 3]); w.z = pk2(p0[8 * s + 4], p0[8 * s + 5]); w.w = pk2(p0[8 * s + 6], p0[8 * s + 7]); }
                else { const int s2 = s - 2; w.x = pk2(p1[8 * s2 + 0], p1[8 * s2 + 1]); w.y = pk2(p1[8 * s2 + 2], p1[8 * s2 + 3]); w.z = pk2(p1[8 * s2 + 4], p1[8 * s2 + 5]); w.w = pk2(p1[8 * s2 + 6], p1[8 * s2 + 7]); }
                pf[s] = __builtin_bit_cast(bf16x8, w);
            }
            const LAS unsigned char* vb = lds + AT_V0 + buf * AT_VBUF + vbase_lane;
#pragma unroll
            for (int mt = 0; mt < 4; ++mt)
#pragma unroll
                for (int s = 0; s < 4; ++s) {
                    const s16x4 lo = vtr(vb + (16 * s) * AT_VSTR + mt * 64);
                    const s16x4 hi4 = vtr(vb + (16 * s + 8) * AT_VSTR + mt * 64);
                    const bf16x8 vf = {lo[0], lo[1], lo[2], lo[3], hi4[0], hi4[1], hi4[2], hi4[3]};
                    O[mt] = __builtin_amdgcn_mfma_f32_32x32x16_bf16(vf, pf[s], O[mt], 0, 0, 0);
                }
        }
        if (kt < kt_hi) lstore(buf ^ 1);
        __syncthreads();
    }
    const float l_tot = l_run + __shfl_xor(l_run, 32);
    const float inv = 1.0f / l_tot;
    const size_t orow = rowbase + (size_t)mq * dil;
    if (MODE == 0) {
        float ss = 0.f;
#pragma unroll
        for (int mt = 0; mt < 4; ++mt)
#pragma unroll
            for (int r = 0; r < 16; ++r) { O[mt][r] *= inv; ss += O[mt][r] * O[mt][r]; }
        ss += __shfl_xor(ss, 32);
        const float rn = rsqrtf(ss * (1.0f / 128.0f) + EPS);
        const float* nb = P.in(16) + l * 512 + hh * 128;
        bf16_t* yp = (bf16_t*)(P.ws() + WS_Y) + orow * DM + 512 + hh * 128;
#pragma unroll
        for (int mt = 0; mt < 4; ++mt)
#pragma unroll
            for (int a = 0; a < 4; ++a) {
                const int dv = 32 * mt + 8 * a + 4 * hi; const f32x4 g = *(const f32x4*)(nb + dv);
                u32x2 w; w.x = pk2(O[mt][4 * a + 0] * rn * g.x, O[mt][4 * a + 1] * rn * g.y); w.y = pk2(O[mt][4 * a + 2] * rn * g.z, O[mt][4 * a + 3] * rn * g.w);
                *(u32x2*)(yp + dv) = w;
            }
    } else {
        bf16_t* op = (bf16_t*)(P.ws() + WS_OD) + ((size_t)branch * M + orow) * 512 + hh * 128;
#pragma unroll
        for (int mt = 0; mt < 4; ++mt)
#pragma unroll
            for (int a = 0; a < 4; ++a) {
                const int dv = 32 * mt + 8 * a + 4 * hi;
                u32x2 w; w.x = pk2(O[mt][4 * a + 0] * inv, O[mt][4 * a + 1] * inv); w.y = pk2(O[mt][4 * a + 2] * inv, O[mt][4 * a + 3] * inv);
                *(u32x2*)(op + dv) = w;
            }
        if (hi == 0) ((float*)(P.ws() + WS_LSE))[((size_t)branch * M + orow) * 4 + hh] = (m_run + __builtin_amdgcn_logf(l_tot)) * 0.6931471805599453f;
    }
}

constexpr int GS_WP = 0, GS_QP = 64 * 272, GS_QK = 2 * 64 * 272, GS_KT = GS_QK + 64 * 144, GS_BUF = GS_KT + 128 * 144;
__device__ __forceinline__ void gdn_seq_unit(const Ctx& P, int l, int unit, LAS unsigned char* lds, int tid, int wave, int lane) {
    const int bh = unit >> 2, dvb = 32 * (unit & 3) + 16 * wave; const bool active = wave < 2;
    const int b = bh >> 2, hh = bh & 3;
    const unsigned char* recs = P.ws() + WS_GREC + (size_t)bh * 128 * GREC_BYTES;
    const float* Ug = (const float*)(P.ws() + WS_GU) + (size_t)bh * 128 * 8192;
    const float* GLv = (const float*)(P.ws() + WS_GLAST) + bh * 128;
    float* OC = (float*)(P.ws() + WS_OC);
    const int fr = lane & 15, g = lane >> 4;
    int soff[7];
#pragma unroll
    for (int i = 0; i < 7; ++i) {
        const int q = tid + i * NTHR; int off;
        if (q < 1024) off = GS_WP + (q >> 4) * 272 + (q & 15) * 16;
        else if (q < 2048) off = GS_QP + ((q - 1024) >> 4) * 272 + (q & 15) * 16;
        else if (q < 2560) off = GS_QK + ((q - 2048) >> 3) * 144 + (q & 7) * 16;
        else off = GS_KT + ((q - 2560) >> 3) * 144 + (q & 7) * 16;
        soff[i] = off;
    }
    u32x4 stg;
    const unsigned lane_off = (unsigned)tid * 16u;
#define GS_LOAD(n_, i_) stg = *(const u32x4*)((recs + (size_t)(n_) * GREC_BYTES + (size_t)(i_) * 8192) + lane_off)
#define GS_STORE(buf_, i_) *(LAS u32x4*)(lds + (buf_) * GS_BUF + soff[i_]) = stg
#define GS_PF(i_) do { if (n < 127) { if ((i_) > 0) GS_STORE(buf ^ 1, (i_) - 1); GS_LOAD(n + 1, (i_)); } } while (0)
    f32x4 S[8];
#pragma unroll
    for (int i = 0; i < 8; ++i) S[i] = (f32x4){0.f, 0.f, 0.f, 0.f};
    __syncthreads();
#pragma unroll
    for (int i = 0; i < 7; ++i) { GS_LOAD(0, i); GS_STORE(0, i); }
    __syncthreads();
    for (int n = 0; n < 128; ++n) {
        const int buf = n & 1;
        if (active) {
        GS_PF(0);
        const LAS unsigned char* base = lds + buf * GS_BUF;
        const float* U = Ug + (size_t)n * 8192;
        f32x4 vn[4];
#pragma unroll
        for (int mt = 0; mt < 4; ++mt)
#pragma unroll
            for (int i = 0; i < 4; ++i) vn[mt][i] = U[(16 * mt + 4 * g + i) * 128 + dvb + fr];
        const float gl = GLv[n];
        bf16x8 sb[4];
#pragma unroll
        for (int s = 0; s < 4; ++s) {
            u32x4 w; w.x = pk2(S[2 * s][0], S[2 * s][1]); w.y = pk2(S[2 * s][2], S[2 * s][3]); w.z = pk2(S[2 * s + 1][0], S[2 * s + 1][1]); w.w = pk2(S[2 * s + 1][2], S[2 * s + 1][3]);
            sb[s] = __builtin_bit_cast(bf16x8, w);
        }
        f32x4 oa[4];
#pragma unroll
        for (int mt = 0; mt < 4; ++mt) {
            oa[mt] = (f32x4){0.f, 0.f, 0.f, 0.f};
            __builtin_amdgcn_sched_barrier(0);
            if (mt == 1) GS_PF(1);
            if (mt == 3) GS_PF(2);
#pragma unroll
            for (int s = 0; s < 4; ++s) {
                const bf16x8 aw = *(const LAS bf16x8*)(base + GS_WP + (16 * mt + fr) * 272 + (32 * s + 8 * g) * 2);
                const bf16x8 aq = *(const LAS bf16x8*)(base + GS_QP + (16 * mt + fr) * 272 + (32 * s + 8 * g) * 2);
                vn[mt] = __builtin_amdgcn_mfma_f32_16x16x32_bf16(aw, sb[s], vn[mt], 0, 0, 0);
                oa[mt] = __builtin_amdgcn_mfma_f32_16x16x32_bf16(aq, sb[s], oa[mt], 0, 0, 0);
            }
        }
        bf16x8 vb[2];
#pragma unroll
        for (int s = 0; s < 2; ++s) {
            u32x4 w; w.x = pk2(vn[2 * s][0], vn[2 * s][1]); w.y = pk2(vn[2 * s][2], vn[2 * s][3]); w.z = pk2(vn[2 * s + 1][0], vn[2 * s + 1][1]); w.w = pk2(vn[2 * s + 1][2], vn[2 * s + 1][3]);
            vb[s] = __builtin_bit_cast(bf16x8, w);
        }
        GS_PF(3);
        __builtin_amdgcn_sched_barrier(0);
#pragma unroll
        for (int mt = 0; mt < 4; ++mt)
#pragma unroll
            for (int s = 0; s < 2; ++s) {
                const bf16x8 a = *(const LAS bf16x8*)(base + GS_QK + (16 * mt + fr) * 144 + (32 * s + 8 * g) * 2);
                oa[mt] = __builtin_amdgcn_mfma_f32_16x16x32_bf16(a, vb[s], oa[mt], 0, 0, 0);
            }
        {
            float* op = OC + ((size_t)b * T + n * 64) * 512 + hh * 128 + dvb + fr;
#pragma unroll
            for (int mt = 0; mt < 4; ++mt)
#pragma unroll
                for (int i = 0; i < 4; ++i) op[(size_t)(16 * mt + 4 * g + i) * 512] = oa[mt][i];
        }
        GS_PF(4);
#pragma unroll
        for (int dt = 0; dt < 8; ++dt) {
            __builtin_amdgcn_sched_barrier(0);
            if (dt == 3) GS_PF(5);
            if (dt == 6) GS_PF(6);
            S[dt] = S[dt] * gl;
#pragma unroll
            for (int s = 0; s < 2; ++s) {
                const bf16x8 a = *(const LAS bf16x8*)(base + GS_KT + (16 * dt + fr) * 144 + (32 * s + 8 * g) * 2);
                S[dt] = __builtin_amdgcn_mfma_f32_16x16x32_bf16(a, vb[s], S[dt], 0, 0, 0);
            }
        }
        } else {
#pragma unroll
            for (int i = 0; i < 7; ++i) GS_PF(i);
        }
        if (n < 127) GS_STORE(buf ^ 1, 6);
        __syncthreads();
    }
#undef GS_LOAD
#undef GS_STORE
#undef GS_PF
}

__device__ __forceinline__ void lru_final_unit(const Ctx& P, int l, int unit, int tid, int wave, int lane) {
    const bf16_t* Z = (const bf16_t*)(P.ws() + WS_Z);
    const float* LA = (const float*)(P.ws() + WS_LRUA); const float* LU = (const float*)(P.ws() + WS_LRUU); const float* AGG = (const float*)(P.ws() + WS_LAGG);
    bf16_t* Y = (bf16_t*)(P.ws() + WS_Y);
    const int b = unit >> 7, ck = unit & 127; const size_t m0 = (size_t)b * T + ck * 64; const int ch = tid;
    float h = 0.f;
    for (int j = 0; j < ck; ++j) { const float a = AGG[((size_t)(b * 128 + j) * 2 + 0) * 512 + ch], hh2 = AGG[((size_t)(b * 128 + j) * 2 + 1) * 512 + ch]; h = a * h + hh2; }
    const float gn = P.in(15)[l * 512 + ch];
#pragma unroll 4
    for (int t = 0; t < 64; ++t) {
        const float a = LA[(m0 + t) * 512 + ch], u = LU[(m0 + t) * 512 + ch];
        h = a * h + u;
        const float ss = wave_sum(h * h);
        const float gate = bf2f(Z[(m0 + t) * NZ + ZC_AG + ch]);
        const float y = h * rsqrtf(ss * (1.0f / 64.0f) + EPS) * gn * gelu_tanh(gate);
        Y[(m0 + t) * DM + ch] = (bf16_t)f2bf(y);
    }
}

__device__ __forceinline__ void finalize_phase(const Ctx& P, int l, int wave, int lane, int bid, int nblk) {
    const bf16_t* Z = (const bf16_t*)(P.ws() + WS_Z); const float* OC = (const float*)(P.ws() + WS_OC);
    const bf16_t* OD = (const bf16_t*)(P.ws() + WS_OD); const float* LSE = (const float*)(P.ws() + WS_LSE);
    bf16_t* Y = (bf16_t*)(P.ws() + WS_Y);
    const float gc0 = P.in(14)[l * 128 + 2 * lane], gc1 = P.in(14)[l * 128 + 2 * lane + 1];
    for (int task = bid * 8 + wave; task < M * 4; task += nblk * 8) {
        const size_t m = task >> 2; const int hh = task & 3;
        {
            const float o0 = OC[m * 512 + hh * 128 + 2 * lane], o1 = OC[m * 512 + hh * 128 + 2 * lane + 1];
            const float rn = rsqrtf(wave_sum(o0 * o0 + o1 * o1) * (1.0f / 128.0f) + EPS);
            const unsigned zz = *(const unsigned*)(Z + m * NZ + ZC_CZ + hh * 128 + 2 * lane);
            const float z0 = bflo(zz), z1 = bfhi(zz);
            *(unsigned*)(Y + m * DM + 1024 + hh * 128 + 2 * lane) = pk2(o0 * rn * gc0 * siluf_(z0), o1 * rn * gc1 * siluf_(z1));
        }
        {
            const float l0 = LSE[((size_t)0 * M + m) * 4 + hh], l1 = LSE[((size_t)1 * M + m) * 4 + hh], l2 = LSE[((size_t)2 * M + m) * 4 + hh];
            const float mx = fmaxf(l0, fmaxf(l1, l2));
            float w0 = __expf(l0 - mx), w1 = __expf(l1 - mx), w2 = __expf(l2 - mx);
            const float inv = 1.0f / (w0 + w1 + w2); w0 *= inv; w1 *= inv; w2 *= inv;
            const unsigned a0 = *(const unsigned*)(OD + ((size_t)0 * M + m) * 512 + hh * 128 + 2 * lane);
            const unsigned a1 = *(const unsigned*)(OD + ((size_t)1 * M + m) * 512 + hh * 128 + 2 * lane);
            const unsigned a2 = *(const unsigned*)(OD + ((size_t)2 * M + m) * 512 + hh * 128 + 2 * lane);
            const float o0 = w0 * bflo(a0) + w1 * bflo(a1) + w2 * bflo(a2), o1 = w0 * bfhi(a0) + w1 * bfhi(a1) + w2 * bfhi(a2);
            const float rn = rsqrtf(wave_sum(o0 * o0 + o1 * o1) * (1.0f / 128.0f) + EPS);
            const float g0 = P.in(17)[l * 512 + hh * 128 + 2 * lane], g1 = P.in(17)[l * 512 + hh * 128 + 2 * lane + 1];
            *(unsigned*)(Y + m * DM + 1536 + hh * 128 + 2 * lane) = pk2(o0 * rn * g0, o1 * rn * g1);
        }
    }
}

__device__ __forceinline__ void ffn_act_phase(const Ctx& P, int l, int tid, int bid, int nblk) {
    const bf16_t* U = (const bf16_t*)(P.ws() + WS_U); bf16_t* ACT = (bf16_t*)(P.ws() + WS_ACT);
    const float* cw = P.in(21) + (size_t)l * 3 * NFF2; const float* cb = P.in(22) + (size_t)l * NFF2;
    constexpr int CG = DFF / 8, RUN = 32, NRUN = M / RUN;
    for (int item = bid * NTHR + tid; item < CG * NRUN; item += nblk * NTHR) {
        const int cg8 = item % CG, run = item / CG; const int c0 = cg8 * 8; const size_t mstart = (size_t)run * RUN; const int tin = (int)(mstart % T);
        float wu[3][8], wg[3][8], bu[8], bg[8];
#pragma unroll
        for (int k = 0; k < 3; ++k)
#pragma unroll
            for (int e = 0; e < 8; ++e) { wu[k][e] = cw[k * NFF2 + c0 + e]; wg[k][e] = cw[k * NFF2 + DFF + c0 + e]; }
#pragma unroll
        for (int e = 0; e < 8; ++e) { bu[e] = cb[c0 + e]; bg[e] = cb[DFF + c0 + e]; }
        u32x4 u2 = {0, 0, 0, 0}, u1 = {0, 0, 0, 0}, g2 = {0, 0, 0, 0}, g1 = {0, 0, 0, 0};
        if (tin > 0) {
            u2 = *(const u32x4*)(U + (mstart - 2) * NFF2 + c0); u1 = *(const u32x4*)(U + (mstart - 1) * NFF2 + c0);
            g2 = *(const u32x4*)(U + (mstart - 2) * NFF2 + DFF + c0); g1 = *(const u32x4*)(U + (mstart - 1) * NFF2 + DFF + c0);
        }
        for (int t = 0; t < RUN; ++t) {
            const u32x4 u0 = *(const u32x4*)(U + (mstart + t) * NFF2 + c0), g0 = *(const u32x4*)(U + (mstart + t) * NFF2 + DFF + c0);
            float r[8];
#pragma unroll
            for (int q = 0; q < 4; ++q) {
                const float up0 = bu[2 * q] + wu[0][2 * q] * bflo(u2[q]) + wu[1][2 * q] * bflo(u1[q]) + wu[2][2 * q] * bflo(u0[q]);
                const float up1 = bu[2 * q + 1] + wu[0][2 * q + 1] * bfhi(u2[q]) + wu[1][2 * q + 1] * bfhi(u1[q]) + wu[2][2 * q + 1] * bfhi(u0[q]);
                const float ga0 = bg[2 * q] + wg[0][2 * q] * bflo(g2[q]) + wg[1][2 * q] * bflo(g1[q]) + wg[2][2 * q] * bflo(g0[q]);
                const float ga1 = bg[2 * q + 1] + wg[0][2 * q + 1] * bfhi(g2[q]) + wg[1][2 * q + 1] * bfhi(g1[q]) + wg[2][2 * q + 1] * bfhi(g0[q]);
                r[2 * q] = siluf_(ga0) * up0; r[2 * q + 1] = siluf_(ga1) * up1;
            }
            u32x4 o; o.x = pk2(r[0], r[1]); o.y = pk2(r[2], r[3]); o.z = pk2(r[4], r[5]); o.w = pk2(r[6], r[7]);
            *(u32x4*)(ACT + (mstart + t) * DFF + c0) = o;
            u2 = u1; u1 = u0; g2 = g1; g1 = g0;
        }
    }
}

#ifndef N_LAYERS_RUN
#define N_LAYERS_RUN DEPTH
#endif
constexpr int D_NUNITS = 32 + 256 + 768 + 256;

__global__ void __launch_bounds__(NTHR, 2) fwd_megakernel(Params KP) {
    extern __shared__ __attribute__((aligned(16))) unsigned char lds_raw[];
    LAS unsigned char* lds0 = (LAS unsigned char*)lds_raw;
    cg::grid_group grid = cg::this_grid();
    const int tid = threadIdx.x, lane = tid & 63, wave = __builtin_amdgcn_readfirstlane(tid >> 6);
    const int bid = blockIdx.x, nblk = gridDim.x;
    volatile LAS int* misc = (volatile LAS int*)(lds0 + LDS_MISC);
    if (threadIdx.x < 16) misc[threadIdx.x] = 0;
    __syncthreads();
    XcdBarrier xbar = xcd_barrier_post((unsigned*)(KP.ws + WS_CTL) + 4096, (volatile LAS unsigned*)(lds0 + LDS_MISC) + 8);
    {
        LAS unsigned long long* tabw = (LAS unsigned long long*)(lds0 + LDS_MISC + 64);
        if (threadIdx.x == 0) {
#pragma unroll
            for (int i = 0; i < 25; ++i) tabw[i] = (unsigned long long)KP.in[i];
            tabw[25] = (unsigned long long)KP.out; tabw[26] = (unsigned long long)KP.ws;
        }
        __syncthreads();
    }
    Ctx P; P.tab = (const LAS unsigned*)(lds0 + LDS_MISC + 64);
#define WSP (P.ws())
#define XP (P.out())

#ifdef DUP_SYNC
#define GSYNC() do { grid.sync(); grid.sync(); } while (0)
#else
#define GSYNC() xcd_barrier(xbar)
#endif
#ifndef SK_P0
    p0_prologue(P, lds0, bid * 8 + wave, nblk * 8, wave, lane);
#ifdef DUP_P0
    __syncthreads();
    p0_prologue(P, lds0, bid * 8 + wave, nblk * 8, wave, lane);
#endif
#endif
    grid.sync();

    for (int l0 = 0; l0 < N_LAYERS_RUN; ++l0) {
#define FRESH() LAS unsigned char* lds = lds0; asm volatile("" : "+v"(lds)); int l = l0; asm volatile("" : "+s"(l)); int tid = threadIdx.x; asm volatile("" : "+v"(tid)); const int lane = tid & 63, wave = __builtin_amdgcn_readfirstlane(tid >> 6); (void)lane; (void)wave; (void)l;
#ifndef SK_A
        { FRESH()
        norm_phase<true>(l == 0 ? P.in(0) : XP, l == 0 ? XP : nullptr, P.in(1) + l * DM, (bf16_t*)(WSP + WS_HB), (const float*)(WSP + WS_WG) + (size_t)l * 12 * DM,
                         (float*)(WSP + WS_GL), lds, tid, wave, lane, bid, nblk);
#ifdef DUP_A
        norm_phase<true>(l == 0 ? P.in(0) : XP, l == 0 ? XP : nullptr, P.in(1) + l * DM, (bf16_t*)(WSP + WS_HB), (const float*)(WSP + WS_WG) + (size_t)l * 12 * DM, (float*)(WSP + WS_GL), lds, tid, wave, lane, bid, nblk);
#endif
        }
#endif
        GSYNC();
#ifndef SK_B
        { FRESH()
            pg8::Gemm g{(const bf16_t*)(WSP + WS_HB), (const bf16_t*)(WSP + WS_WIN) + (size_t)l * NZ * DM, M, NZ, DM};
            pg8::StaticOrder S; S.init(M, NZ, nblk, bid);
            pg8::EpiBf16<0> E{(bf16_t*)(WSP + WS_Z), NZ, nullptr, 0, 0, 1.f};
            pg8::gemm_phase<pg8::EpiBf16<0>, pg8::StaticOrder, true, true>(lds, g, S, E);
#ifdef DUP_B
            __syncthreads();
            pg8::gemm_phase<pg8::EpiBf16<0>, pg8::StaticOrder, true, true>(lds, g, S, E);
#endif
        }
#endif
        GSYNC();
#ifdef DUP_C
        for (int pass = 0; pass < 2; ++pass)
#endif
        for (int u = bid; u < 1024 + 256 + 8; u += nblk) { FRESH()
#ifndef SK_C3
            if (u < 1024) gdn_prep_unit(P, l, u, lds, tid, wave, lane); else
#endif
#ifndef SK_C1
            if (u >= 1024 && u < 1280) { __syncthreads(); lru_chunk_unit(P, l, u - 1024, lds, tid, wave, lane); __syncthreads(); } else
#endif
#ifndef SK_C2
            if (u >= 1280) fox_cumsum_unit(P, l, u - 1280, lds, tid, wave, lane);
#else
            {}
#endif
        }
        GSYNC();
        {
#ifdef DUP_D
            for (int pass = 0; pass < 2; ++pass) {
            unsigned* ctr = (unsigned*)(WSP + WS_CTL) + 64 * (1 + l0) + 16 * pass;
#else
            {
            unsigned* ctr = (unsigned*)(WSP + WS_CTL) + 64 * (1 + l0);
#endif
            for (;;) {
                __syncthreads();
                if (threadIdx.x == 0) misc[0] = (int)atomicAdd(ctr, 1u);
                __syncthreads();
                const int u = misc[0];
                if (u >= D_NUNITS) break;
                FRESH()
#ifndef SK_D1
                if (u < 32) gdn_seq_unit(P, l, u, lds, tid, wave, lane); else
#endif
#ifndef SK_D2
                if (u >= 32 && u < 288) { const int i = u - 32; attn_unit<0>(P, l, lds, tid, wave, lane, (i & 7) >> 2, i & 3, 1, 0, (31 - (i >> 3)) * 256, 0); } else
#endif
#ifndef SK_D3
                if (u >= 288 && u < 1056) {
                    const int i = u - 288; const int bh = i & 7, j = i >> 3;
                    const int br = j >> 5, k = j & 31;
                    const int dil = (br == 0) ? 1 : (br == 1 ? 4 : 16);
                    const int nqb = 32 / dil;
                    const int res = k / nqb, qb = k % nqb;
                    attn_unit<1>(P, l, lds, tid, wave, lane, bh >> 2, bh & 3, dil, res, qb * 256, br);
                } else
#endif
#ifndef SK_D4
                if (u >= 1056) lru_final_unit(P, l, u - 1056, tid, wave, lane);
#else
                {}
#endif
            }
            }
        }
        GSYNC();
#ifndef SK_E
        { FRESH() finalize_phase(P, l, wave, lane, bid, nblk);
#ifdef DUP_E
          finalize_phase(P, l, wave, lane, bid, nblk);
#endif
        }
#endif
        GSYNC();
#ifndef SK_F
        { FRESH()
            pg8::Gemm g{(const bf16_t*)(WSP + WS_Y), (const bf16_t*)(WSP + WS_WOUT) + (size_t)l * DM * DM, M, DM, DM};
            pg8::StaticOrder S; S.init(M, DM, nblk, bid);
            EpiResAdd E{XP, DM};
            pg8::gemm_phase<EpiResAdd, pg8::StaticOrder, true, true>(lds, g, S, E);
        }
#endif
        GSYNC();
#ifndef SK_G
        { FRESH() norm_phase<false>(XP, nullptr, P.in(19) + l * DM, (bf16_t*)(WSP + WS_HB), nullptr, nullptr, lds, tid, wave, lane, bid, nblk);
#ifdef DUP_G
          norm_phase<false>(XP, nullptr, P.in(19) + l * DM, (bf16_t*)(WSP + WS_HB), nullptr, nullptr, lds, tid, wave, lane, bid, nblk);
#endif
        }
#endif
        GSYNC();
#ifndef SK_H
        { FRESH()
            pg8::Gemm g{(const bf16_t*)(WSP + WS_HB), (const bf16_t*)(WSP + WS_WUP) + (size_t)l * NFF2 * DM, M, NFF2, DM};
            pg8::StaticOrder S; S.init(M, NFF2, nblk, bid);
            pg8::EpiBf16<0> E{(bf16_t*)(WSP + WS_U), NFF2, nullptr, 0, 0, 1.f};
            pg8::gemm_phase<pg8::EpiBf16<0>, pg8::StaticOrder, true, true>(lds, g, S, E);
#ifdef DUP_H
            __syncthreads();
            pg8::gemm_phase<pg8::EpiBf16<0>, pg8::StaticOrder, true, true>(lds, g, S, E);
#endif
        }
#endif
        GSYNC();
#ifndef SK_I
        { FRESH() ffn_act_phase(P, l, tid, bid, nblk);
#ifdef DUP_I
          ffn_act_phase(P, l, tid, bid, nblk);
#endif
        }
#endif
        GSYNC();
#ifndef SK_J
        { FRESH()
            pg8::Gemm g{(const bf16_t*)(WSP + WS_ACT), (const bf16_t*)(WSP + WS_WDN) + (size_t)l * DM * DFF, M, DM, DFF};
            pg8::StaticOrder S; S.init(M, DM, nblk, bid);
            EpiResAdd E{XP, DM};
            pg8::gemm_phase<EpiResAdd, pg8::StaticOrder, true, true>(lds, g, S, E);
        }
#endif
        GSYNC();
    }
#ifndef SK_FN
    { int tid = threadIdx.x; asm volatile("" : "+v"(tid)); const int lane = tid & 63, wave = __builtin_amdgcn_readfirstlane(tid >> 6);
      final_norm_phase(XP, P.in(24), wave, lane, bid, nblk); }
#endif
}

extern "C" void kernel_launch(void* const* d_in, const int* in_sizes, int n_in, void* d_out, int out_size, void* d_ws, size_t ws_size, hipStream_t stream) {
    static int grid_blocks = 0;
    if (grid_blocks == 0) {
        if (n_in != 25 || ws_size < WS_END) { fprintf(stderr, "kernel_launch: unexpected inputs (n_in %d, ws %zu < %zu)\n", n_in, ws_size, (size_t)WS_END); grid_blocks = -1; return; }
        int dev = 0, cus = 0, per_cu = 0;
        (void)hipGetDevice(&dev);
        (void)hipDeviceGetAttribute(&cus, hipDeviceAttributeMultiprocessorCount, dev);
        if (hipFuncSetAttribute((const void*)fwd_megakernel, hipFuncAttributeMaxDynamicSharedMemorySize, LDS_BYTES) != hipSuccess) { fprintf(stderr, "kernel_launch: hipFuncSetAttribute failed\n"); grid_blocks = -1; return; }
        if (hipOccupancyMaxActiveBlocksPerMultiprocessor(&per_cu, (const void*)fwd_megakernel, NTHR, LDS_BYTES) != hipSuccess || per_cu < 1) { fprintf(stderr, "kernel_launch: occupancy query says %d\n", per_cu); per_cu = 1; }
        (void)hipGetLastError();
        grid_blocks = cus * per_cu;
        if (grid_blocks > 256) grid_blocks = 256;
    }
    if (grid_blocks < 0) return;
    (void)hipMemsetAsync((char*)d_ws + WS_CTL, 0, 65536, stream);
    Params p{};
    for (int i = 0; i < 25; ++i) p.in[i] = (const float*)d_in[i];
    p.out = (float*)d_out; p.ws = (unsigned char*)d_ws;
    void* args[] = {&p};
    hipError_t e = hipLaunchCooperativeKernel((const void*)fwd_megakernel, dim3(grid_blocks), dim3(NTHR), args, LDS_BYTES, stream);
    if (e != hipSuccess) fprintf(stderr, "cooperative launch failed: %s (grid %d)\n", hipGetErrorString(e), grid_blocks);
}
```

```cpp
#include <hip/hip_runtime.h>
#include <hip/hip_cooperative_groups.h>
#include <cstdio>
#include <cstdint>
namespace cg = cooperative_groups;
namespace pg8 {
#define PG8_LAS __attribute__((address_space(3)))
typedef unsigned short bf16_t;
typedef short bf16x8 __attribute__((ext_vector_type(8)));
typedef float f32x4 __attribute__((ext_vector_type(4)));
typedef unsigned u32x4 __attribute__((ext_vector_type(4)));
constexpr int BM = 256, BK = 64, HALF = 128, HTB = HALF * BK * 2  , STAGE_BYTES = 8 * HTB, NXCD = 8, WGM = 8;

__host__ __device__ __forceinline__ int lds_byte(int r, int c) { const int st = (r >> 4) * 2 + (c >> 5), rr = r & 15, cc = c & 31, ob = rr * 64 + cc * 2; return st * 1024 + (ob ^ (((ob >> 9) & 1) << 5)); }
__host__ __device__ __forceinline__ void stage_rc(int b, int& R, int& C) { const int st = b / 1024, sb = b % 1024, swz = sb ^ (((sb >> 9) & 1) << 5); R = (st >> 1) * 16 + swz / 64; C = (st & 1) * 32 + (swz % 64) / 2; }
__host__ __device__ __forceinline__ int perm32(int rho) { const int n = rho >> 4, i = rho & 15; return 8 * (i >> 2) + 4 * n + (i & 3); }

struct Unit { int pm, pn; };
struct Gemm { const bf16_t* A; const bf16_t* Bt; int M, N, K; };

struct StaticOrder {
    int nM, nN, nwg, G, c;
    __host__ __device__ void init(int M, int N, int G_, int c_) { nM = M / BM; nN = N / BM; nwg = nM * nN; G = G_; c = c_; }
    __host__ __device__ bool next(int i, Unit& u) const {
        const long L = (long)i * G + c; if (L >= nwg) return false;
        int wgid = (int)L; { const int q = nwg / NXCD, r = nwg % NXCD, xcd = wgid % NXCD, off = wgid / NXCD; wgid = (xcd < r ? xcd * (q + 1) : r * (q + 1) + (xcd - r) * q) + off; }
        const int nig = WGM * nN, gid = wgid / nig, fm = gid * WGM, gsz = (nM - fm) < WGM ? (nM - fm) : WGM;
        u.pm = fm + ((wgid % nig) % gsz); u.pn = (wgid % nig) / gsz; return true;
    }
    __device__ __forceinline__ void a_ready(const Unit&) const {}
    __device__ __forceinline__ void done(const Unit&) const {}
};

__device__ __forceinline__ unsigned cvt_pk_bf16(float lo, float hi) { unsigned r; asm volatile("v_cvt_pk_bf16_f32 %0, %1, %2" : "=v"(r) : "v"(lo), "v"(hi)); return r; }
typedef float f32x2 __attribute__((ext_vector_type(2)));
__device__ __forceinline__ f32x2 gelu_pk(f32x2 v) {
    const f32x2 av = __builtin_elementwise_abs(v), d = av * 0.2316418882f + 1.0f;
    f32x2 t; t.x = __builtin_amdgcn_rcpf(d.x); t.y = __builtin_amdgcn_rcpf(d.y);
    f32x2 q = t * 0.5307027145f + (-0.7265760135f); q = q * t + 0.7107068705f; q = q * t + (-0.142248368f); q = q * t + 0.127414796f; q = q * t;
    const f32x2 s = (v * v) * (-0.72134752044f);
    f32x2 e; e.x = __builtin_amdgcn_exp2f(s.x); e.y = __builtin_amdgcn_exp2f(s.y);
    const f32x2 m = v * (q * e), r = v - m;
    f32x2 o; o.x = v.x < 0.f ? m.x : r.x; o.y = v.y < 0.f ? m.y : r.y; return o;
}

template <int ACT  > struct EpiBf16 {
    static constexpr bool PERM = true, AFTER_DRAIN = false; static_assert(ACT == 0 || ACT == 1, "EpiBf16: ACT is 0 (none) or 1 (gelu_pk)");
    bf16_t* O; int ldc; const float* bias; int split_cols; size_t split_stride; float scale0;
    __device__ __forceinline__ void operator()(const f32x4 (&acc)[2][2][4][2], const Unit& u, int wr, int wc, int fr, int fq) const {
        const int row0 = u.pm * BM + wr * 64 + fr; int colt = u.pn * BM; bf16_t* base = O;
        float sc = 1.f; if (split_cols) { const int t = colt / split_cols; base += (size_t)t * split_stride; colt -= t * split_cols; if (t == 0) sc = scale0; }
        const int col0 = colt + wc * 32 + 8 * fq, bcol0 = u.pn * BM + wc * 32 + 8 * fq;
        f32x4 bv[2][2];
#pragma unroll
        for (int bj = 0; bj < 2; ++bj)
#pragma unroll
            for (int n = 0; n < 2; ++n) bv[bj][n] = bias ? *(const f32x4*)(bias + bcol0 + bj * HALF + 4 * n) : (f32x4){0.f, 0.f, 0.f, 0.f};
#pragma unroll
        for (int ai = 0; ai < 2; ++ai)
#pragma unroll
            for (int m = 0; m < 4; ++m) { bf16_t* rowp = base + (size_t)(row0 + ai * HALF + m * 16) * ldc + col0;
#pragma unroll
                for (int bj = 0; bj < 2; ++bj) { f32x4 v0 = acc[ai][bj][m][0] + bv[bj][0], v1 = acc[ai][bj][m][1] + bv[bj][1];
                    if (ACT == 1) { f32x2 a = gelu_pk((f32x2){v0[0], v0[1]}), b = gelu_pk((f32x2){v0[2], v0[3]}), c = gelu_pk((f32x2){v1[0], v1[1]}), d = gelu_pk((f32x2){v1[2], v1[3]});
                        v0 = (f32x4){a.x, a.y, b.x, b.y}; v1 = (f32x4){c.x, c.y, d.x, d.y}; }
                    v0 = v0 * sc; v1 = v1 * sc; u32x4 w; w.x = cvt_pk_bf16(v0[0], v0[1]); w.y = cvt_pk_bf16(v0[2], v0[3]); w.z = cvt_pk_bf16(v1[0], v1[1]); w.w = cvt_pk_bf16(v1[2], v1[3]);
                    *(u32x4*)(rowp + bj * HALF) = w; } }
    }
};
template <class Epi, class Sched, bool ALIGN_EPI = false, bool SP2 = false>
__device__ __forceinline__ void gemm_phase(PG8_LAS unsigned char* lds, const Gemm g, const Sched& S, const Epi& E) {
    int tid_l = threadIdx.x; asm volatile("" : "+v"(tid_l)); const int tid = tid_l, wid = __builtin_amdgcn_readfirstlane(tid >> 6), lane = tid & 63, wr = wid >> 2, wc = wid & 3, fr = lane & 15, fq = lane >> 4;
    const int K = g.K, nt = K / BK;
    unsigned voffA[2], voffB[2];
#pragma unroll
    for (int i = 0; i < 2; ++i) { int R, C; stage_rc(tid * 16 + i * 8192, R, C); const int Rb = Epi::PERM ? ((R & ~31) + perm32(R & 31)) : R;
        voffA[i] = (unsigned)(R * K + C) * 2u; voffB[i] = (unsigned)(Rb * K + C) * 2u; }
    const size_t kstep = (size_t)(BK * 2);
    const size_t hstep = (size_t)HALF * K * 2;
    const size_t tstep = 2 * hstep;
    const unsigned ldsw = (unsigned)wid * 1024u;
    const int aoff = lds_byte(wr * 64 + fr, fq * 8), boff = lds_byte(wc * 32 + fr, fq * 8);
#define PG8_SA(b, h) (((b) * 2 + (h)) * HTB)
#define PG8_SB(b, h) ((4 + (b) * 2 + (h)) * HTB)
#define PG8_STAGE(bufoff, gbase, voff) do { _Pragma("unroll") for (int _i = 0; _i < 2; ++_i) \
        __builtin_amdgcn_global_load_lds((const unsigned*)((const char*)(gbase) + (voff)[_i]), (PG8_LAS unsigned*)(lds + (bufoff) + ldsw + _i * 8192), 16, 0, 0); } while (0)
#define PG8_LDA(dst, b, h) do { _Pragma("unroll") for (int m = 0; m < 4; ++m) _Pragma("unroll") for (int k = 0; k < 2; ++k) dst[m][k] = *(const PG8_LAS bf16x8*)(lds + PG8_SA(b, h) + aoff + m * 2048 + k * 1024); } while (0)
#define PG8_LDB(dst, b, h) do { _Pragma("unroll") for (int n = 0; n < 2; ++n) _Pragma("unroll") for (int k = 0; k < 2; ++k) dst[n][k] = *(const PG8_LAS bf16x8*)(lds + PG8_SB(b, h) + boff + n * 2048 + k * 1024); } while (0)
#define PG8_MMA(ai, bj, At, Bt) do { __builtin_amdgcn_s_setprio(1); _Pragma("unroll") for (int m = 0; m < 4; ++m) _Pragma("unroll") for (int n = 0; n < 2; ++n) _Pragma("unroll") for (int k = 0; k < 2; ++k) \
        acc[ai][bj][m][n] = __builtin_amdgcn_mfma_f32_16x16x32_bf16(Bt[n][k], At[m][k], acc[ai][bj][m][n], 0, 0, 0); __builtin_amdgcn_s_setprio(0); } while (0)
#define PG8_WAIT_V(n) asm volatile("s_waitcnt vmcnt(" #n ")" ::: "memory")
#define PG8_WAIT_L(n) asm volatile("s_waitcnt lgkmcnt(" #n ")" ::: "memory")
#define PG8_BAR __builtin_amdgcn_s_barrier()
#define PG8_SCHED __builtin_amdgcn_sched_barrier(0)
    Unit cur, nxt; int ui = 0;
    if (!S.next(0, cur)) return;
    f32x4 acc[2][2][4][2];
#pragma unroll
    for (int a = 0; a < 2; ++a)
#pragma unroll
        for (int b = 0; b < 2; ++b)
#pragma unroll
            for (int m = 0; m < 4; ++m)
#pragma unroll
                for (int n = 0; n < 2; ++n) acc[a][b][m][n] = (f32x4){0.f, 0.f, 0.f, 0.f};
    bf16x8 At[4][2], B0[2][2], B1[2][2];
    const char* cA = (const char*)g.A + (size_t)cur.pm * tstep; const char* cB = (const char*)g.Bt + (size_t)cur.pn * tstep;
    S.a_ready(cur);
    if constexpr (SP2) {
        PG8_STAGE(PG8_SB(0, 0), cB, voffB); PG8_STAGE(PG8_SB(0, 1), cB + hstep, voffB); PG8_STAGE(PG8_SA(0, 0), cA, voffA); PG8_STAGE(PG8_SA(0, 1), cA + hstep, voffA);
        if (wr == 1) PG8_BAR;
        PG8_WAIT_V(2); PG8_BAR;
        PG8_STAGE(PG8_SB(1, 0), cB + kstep, voffB); PG8_STAGE(PG8_SA(1, 0), cA + kstep, voffA); PG8_STAGE(PG8_SB(1, 1), cB + hstep + kstep, voffB);
        PG8_WAIT_V(6); PG8_BAR;
    } else {
        PG8_STAGE(PG8_SB(0, 0), cB, voffB); PG8_STAGE(PG8_SA(0, 0), cA, voffA); PG8_STAGE(PG8_SB(0, 1), cB + hstep, voffB); PG8_STAGE(PG8_SA(0, 1), cA + hstep, voffA);
        if (wr == 1) PG8_BAR;
        PG8_WAIT_V(4); PG8_BAR;
        PG8_STAGE(PG8_SB(1, 0), cB + kstep, voffB); PG8_STAGE(PG8_SA(1, 0), cA + kstep, voffA); PG8_STAGE(PG8_SB(1, 1), cB + hstep + kstep, voffB);
        PG8_WAIT_V(6); PG8_BAR;
    }
    for (;;) {
        const bool has_next = S.next(ui + 1, nxt);
        const char* nA = has_next ? (const char*)g.A + (size_t)nxt.pm * tstep : cA; const char* nB = has_next ? (const char*)g.Bt + (size_t)nxt.pn * tstep : cB;
        for (int t = 0; t < nt; t += 2) {
            const bool last = (t == nt - 2);
            const char* a1 = cA + (size_t)(t + 1) * kstep;
            const char* a2 = last ? nA : cA + (size_t)(t + 2) * kstep; const char* b2 = last ? nB : cB + (size_t)(t + 2) * kstep;
            const char* a3 = a2 + kstep; const char* b3 = b2 + kstep;
            if (last && has_next) S.a_ready(nxt);
            if constexpr (SP2) {
            PG8_LDB(B0, 0, 0); PG8_LDB(B1, 0, 1); PG8_SCHED; PG8_LDA(At, 0, 0); PG8_STAGE(PG8_SA(1, 1), a1 + hstep, voffA);
            PG8_WAIT_V(8); PG8_WAIT_L(0); PG8_BAR; PG8_MMA(0, 0, At, B0); PG8_MMA(0, 1, At, B1); PG8_BAR; PG8_SCHED;
            PG8_LDA(At, 0, 1); PG8_STAGE(PG8_SB(0, 0), b2, voffB); PG8_STAGE(PG8_SB(0, 1), b2 + hstep, voffB); PG8_STAGE(PG8_SA(0, 0), a2, voffA);
            PG8_WAIT_V(8); PG8_WAIT_L(0); PG8_BAR; PG8_MMA(1, 0, At, B0); PG8_MMA(1, 1, At, B1); PG8_BAR; PG8_SCHED;
            PG8_LDB(B0, 1, 0); PG8_LDB(B1, 1, 1); PG8_SCHED; PG8_LDA(At, 1, 0); PG8_STAGE(PG8_SA(0, 1), a2 + hstep, voffA);
            PG8_WAIT_V(8); PG8_WAIT_L(0); PG8_BAR; PG8_MMA(0, 0, At, B0); PG8_MMA(0, 1, At, B1); PG8_BAR; PG8_SCHED;
            PG8_LDA(At, 1, 1); PG8_STAGE(PG8_SB(1, 0), b3, voffB); PG8_STAGE(PG8_SB(1, 1), b3 + hstep, voffB); PG8_STAGE(PG8_SA(1, 0), a3, voffA);
            PG8_WAIT_V(8); PG8_WAIT_L(0); PG8_BAR; PG8_MMA(1, 0, At, B0); PG8_MMA(1, 1, At, B1); PG8_BAR; PG8_SCHED;
            } else {
            PG8_LDB(B0, 0, 0); PG8_SCHED; PG8_LDA(At, 0, 0); PG8_STAGE(PG8_SA(1, 1), a1 + hstep, voffA);
            PG8_WAIT_L(8); PG8_BAR; PG8_WAIT_L(0); PG8_MMA(0, 0, At, B0); PG8_BAR; PG8_SCHED;
            PG8_LDB(B1, 0, 1); PG8_STAGE(PG8_SB(0, 0), b2, voffB);
            PG8_BAR; PG8_WAIT_L(0); PG8_MMA(0, 1, At, B1); PG8_BAR;
            PG8_LDA(At, 0, 1); PG8_STAGE(PG8_SA(0, 0), a2, voffA);
            PG8_BAR; PG8_WAIT_L(0); PG8_MMA(1, 0, At, B0); PG8_BAR; PG8_SCHED;
            PG8_STAGE(PG8_SB(0, 1), b2 + hstep, voffB);
            PG8_WAIT_V(6); PG8_BAR; PG8_MMA(1, 1, At, B1); PG8_BAR;
            PG8_LDB(B0, 1, 0); PG8_SCHED; PG8_LDA(At, 1, 0); PG8_STAGE(PG8_SA(0, 1), a2 + hstep, voffA);
            PG8_WAIT_L(8); PG8_BAR; PG8_WAIT_L(0); PG8_MMA(0, 0, At, B0); PG8_BAR; PG8_SCHED;
            PG8_LDB(B1, 1, 1); PG8_STAGE(PG8_SB(1, 0), b3, voffB);
            PG8_BAR; PG8_WAIT_L(0); PG8_MMA(0, 1, At, B1); PG8_BAR;
            PG8_LDA(At, 1, 1); PG8_STAGE(PG8_SA(1, 0), a3, voffA);
            PG8_BAR; PG8_WAIT_L(0); PG8_MMA(1, 0, At, B0); PG8_BAR; PG8_SCHED;
            PG8_STAGE(PG8_SB(1, 1), b3 + hstep, voffB);
            PG8_WAIT_V(6); PG8_BAR; PG8_MMA(1, 1, At, B1); PG8_BAR;
            }
        }
        if constexpr (ALIGN_EPI) { if (wr == 0) PG8_BAR; }
        if constexpr (!Epi::AFTER_DRAIN) { E(acc, cur, wr, wc, fr, fq); S.done(cur); }
        if (!has_next) break;
#pragma unroll
        for (int a = 0; a < 2; ++a)
#pragma unroll
            for (int b = 0; b < 2; ++b)
#pragma unroll
                for (int m = 0; m < 4; ++m)
#pragma unroll
                    for (int n = 0; n < 2; ++n) acc[a][b][m][n] = (f32x4){0.f, 0.f, 0.f, 0.f};
        cur = nxt; cA = nA; cB = nB; ++ui;
        if constexpr (ALIGN_EPI) { if (wr == 1) PG8_BAR; }
    }
    PG8_WAIT_V(0);
    if constexpr (!ALIGN_EPI) { if (wr == 0) PG8_BAR; }
    PG8_BAR;
    if constexpr (Epi::AFTER_DRAIN) { E.fused(acc, cur, wr, wc, fr, fq, lds, wid, lane); S.done(cur); }
#undef PG8_SA
#undef PG8_SB
#undef PG8_STAGE
#undef PG8_LDA
#undef PG8_LDB
#undef PG8_MMA
#undef PG8_WAIT_V
#undef PG8_WAIT_L
#undef PG8_BAR
#undef PG8_SCHED
}
}

#define LAS __attribute__((address_space(3)))
typedef unsigned short bf16_t;
typedef short bf16x8 __attribute__((ext_vector_type(8)));
typedef short s16x4 __attribute__((ext_vector_type(4)));
typedef float f32x4 __attribute__((ext_vector_type(4)));
typedef float f32x16 __attribute__((ext_vector_type(16)));
typedef unsigned u32x4 __attribute__((ext_vector_type(4)));
typedef unsigned u32x2 __attribute__((ext_vector_type(2)));

constexpr int NB = 2, T = 8192, M = NB * T, DM = 2048, NZ = 6144, DFF = 5632, NFF2 = 11264, DEPTH = 4;
constexpr int WIN_COLS = 6156;
constexpr int ZC_AX = 0, ZC_AG = 512, ZC_BQ = 1024, ZC_BK = 1536, ZC_BV = 2048, ZC_CQ = 2560, ZC_CZ = 4096, ZC_DQ = 4608, ZC_DK = 5120, ZC_DV = 5632;
constexpr float EPS = 1e-6f;
constexpr int NTHR = 512;

constexpr size_t MiB = 1u << 20;
constexpr size_t WS_CTL = 0, WS_WIN = 1 * MiB, WS_WOUT = 97 * MiB, WS_WUP = 129 * MiB, WS_WDN = 305 * MiB, WS_WG = 393 * MiB, WS_HB = 394 * MiB, WS_ACT = 458 * MiB;
constexpr size_t WS_Z = 634 * MiB, WS_Y = 826 * MiB, WS_GL = 890 * MiB, WS_FOXC = 891 * MiB, WS_LRUA = 892 * MiB, WS_LRUU = 924 * MiB, WS_LAGG = 956 * MiB;
constexpr size_t WS_GREC = 957 * MiB, WS_GU = 1013 * MiB, WS_GLAST = 1045 * MiB, WS_OC = 1046 * MiB, WS_OD = 1078 * MiB, WS_LSE = 1126 * MiB, WS_END = 1127 * MiB;
constexpr size_t WS_U = 634 * MiB;
constexpr int GREC_BYTES = 57344;

constexpr int LDS_BYTES = 147456;
constexpr int LDS_MISC = 140 * 1024;

__device__ __forceinline__ unsigned f2bf(float f) { unsigned u = __builtin_bit_cast(unsigned, f); return (u + 0x7fffu + ((u >> 16) & 1u)) >> 16; }
typedef float f32x2_t __attribute__((ext_vector_type(2))); typedef __bf16 bf16x2_t __attribute__((ext_vector_type(2)));
__device__ __forceinline__ unsigned pk2(float lo, float hi) { const f32x2_t v = {lo, hi}; const bf16x2_t b = __builtin_convertvector(v, bf16x2_t); return __builtin_bit_cast(unsigned, b); }
__device__ __forceinline__ float bf2f(unsigned short u) { return __builtin_bit_cast(float, (unsigned)u << 16); }
__device__ __forceinline__ float bflo(unsigned w) { return __builtin_bit_cast(float, w << 16); }
__device__ __forceinline__ float bfhi(unsigned w) { return __builtin_bit_cast(float, w & 0xffff0000u); }
__device__ __forceinline__ float wave_sum(float v) {
#pragma unroll
    for (int o = 1; o < 64; o <<= 1) v += __shfl_xor(v, o);
    return v;
}
__device__ __forceinline__ float sigmoidf_(float x) { return 1.0f / (1.0f + __expf(-x)); }
__device__ __forceinline__ float siluf_(float x) { return x / (1.0f + __expf(-x)); }
__device__ __forceinline__ float softplusf_(float x) { return fmaxf(x, 0.f) + log1pf(__expf(-fabsf(x))); }
__device__ __forceinline__ float gelu_tanh(float x) { const float u = 0.7978845608028654f * (x + 0.044715f * x * x * x); return 0.5f * x * (1.0f + tanhf(u)); }
__device__ __forceinline__ int perm32(int p) { const int g = p >> 3, j = p & 7; return (j < 4) ? (4 * g + j) : (16 + 4 * g + (j - 4)); }
__device__ __forceinline__ int invperm32(int x) { return (x < 16) ? (8 * (x >> 2) + (x & 3)) : (8 * ((x - 16) >> 2) + 4 + (x & 3)); }

struct Params {
    const float* in[25];
    float* out;
    unsigned char* ws;
};
struct Ctx {
    const LAS unsigned* tab;
    __device__ __forceinline__ unsigned long long ld(int i) const {
        const LAS unsigned* t = tab; asm volatile("" : "+v"(t));
        const unsigned lo = __builtin_amdgcn_readfirstlane(t[2 * i]), hi = __builtin_amdgcn_readfirstlane(t[2 * i + 1]);
        return ((unsigned long long)hi << 32) | lo;
    }
    __device__ __forceinline__ const float* in(int i) const { return (const float*)ld(i); }
    __device__ __forceinline__ float* out() const { return (float*)ld(25); }
    __device__ __forceinline__ unsigned char* ws() const { return (unsigned char*)ld(26); }
};

__device__ __forceinline__ void p0_item(const float* W, int ldw, int ncol0, bf16_t* WT, int K, int nrow0, int k0, LAS float* scr, int lane) {
    {
        const int row = lane >> 4, c4 = (lane & 15) * 4;
        const float* src = W + (size_t)(k0 + row) * ldw + ncol0 + c4;
#pragma unroll
        for (int i = 0; i < 16; ++i) {
            const f32x4 v = *(const f32x4*)(src + (size_t)(4 * i) * ldw);
            LAS float* d = scr + (4 * i + row) * 65 + c4;
            d[0] = v.x; d[1] = v.y; d[2] = v.z; d[3] = v.w;
        }
    }
    asm volatile("s_waitcnt lgkmcnt(0)" ::: "memory");
    const int c = lane & 7, ns = lane >> 3;
#pragma unroll
    for (int j = 0; j < 8; ++j) {
        const int n = ns + 8 * j; const LAS float* s = scr + (8 * c) * 65 + n;
        u32x4 o; o.x = pk2(s[0 * 65], s[1 * 65]); o.y = pk2(s[2 * 65], s[3 * 65]); o.z = pk2(s[4 * 65], s[5 * 65]); o.w = pk2(s[6 * 65], s[7 * 65]);
        *(u32x4*)(WT + (size_t)(nrow0 + n) * K + k0 + 8 * c) = o;
    }
    asm volatile("s_waitcnt lgkmcnt(0)" ::: "memory");
}
__device__ __forceinline__ int win_orig_col(int p) { return p < 2560 ? p : (p < 4096 ? p + 4 : (p < 4608 ? p + 4 : p + 12)); }

__device__ __forceinline__ void p0_prologue(const Ctx& P, LAS unsigned char* lds, int gw, int NGW, int wave, int lane) {
    LAS float* scr = (LAS float*)(lds + wave * 16640);
    constexpr int I_IN = (DM / 64) * (NZ / 64), I_OUT = (DM / 64) * (DM / 64), I_UP = (DM / 64) * (NFF2 / 64), I_DN = (DFF / 64) * (DM / 64);
    constexpr int PER_L = I_IN + I_OUT + I_UP + I_DN;
    unsigned char* ws = P.ws();
    for (int it = gw; it < PER_L * DEPTH; it += NGW) {
        const int l = it / PER_L; int r = it % PER_L;
        if (r < I_IN) { const int nblk = NZ / 64, kb = r / nblk, nb = r % nblk;
            p0_item(P.in(2) + (size_t)l * DM * WIN_COLS, WIN_COLS, win_orig_col(64 * nb), (bf16_t*)(ws + WS_WIN) + (size_t)l * NZ * DM, DM, 64 * nb, 64 * kb, scr, lane); continue; }
        r -= I_IN;
        if (r < I_OUT) { const int nblk = DM / 64, kb = r / nblk, nb = r % nblk;
            p0_item(P.in(18) + (size_t)l * DM * DM, DM, 64 * nb, (bf16_t*)(ws + WS_WOUT) + (size_t)l * DM * DM, DM, 64 * nb, 64 * kb, scr, lane); continue; }
        r -= I_OUT;
        if (r < I_UP) { const int nblk = NFF2 / 64, kb = r / nblk, nb = r % nblk;
            p0_item(P.in(20) + (size_t)l * DM * NFF2, NFF2, 64 * nb, (bf16_t*)(ws + WS_WUP) + (size_t)l * NFF2 * DM, DM, 64 * nb, 64 * kb, scr, lane); continue; }
        r -= I_UP;
        { const int nblk = DM / 64, kb = r / nblk, nb = r % nblk;
            p0_item(P.in(23) + (size_t)l * DFF * DM, DM, 64 * nb, (bf16_t*)(ws + WS_WDN) + (size_t)l * DM * DFF, DFF, 64 * nb, 64 * kb, scr, lane); }
    }
    float* WG = (float*)(ws + WS_WG);
    const int gt = gw * 64 + lane, NGT = NGW * 64;
    for (int i = gt; i < DEPTH * 12 * DM; i += NGT) {
        const int l = i / (12 * DM), j = (i / DM) % 12, k = i % DM;
        const int col = (j < 4) ? (2560 + j) : (j < 8 ? 4612 + (j - 4) : 4616 + (j - 8));
        WG[i] = P.in(2)[(size_t)l * DM * WIN_COLS + (size_t)k * WIN_COLS + col];
    }
}

template <bool GATES>
__device__ __forceinline__ void norm_phase(const float* src, float* copy_dst, const float* gain, bf16_t* HB, const float* WGl, float* GL,
                                           LAS unsigned char* lds, int tid, int wave, int lane, int bid, int nblk) {
    LAS float* wg = (LAS float*)lds;
    if (GATES) {
        for (int i = tid; i < 12 * DM / 4; i += NTHR) ((LAS f32x4*)wg)[i] = ((const f32x4*)WGl)[i];
        __syncthreads();
    }
    f32x4 gv[8];
#pragma unroll
    for (int j = 0; j < 8; ++j) gv[j] = ((const f32x4*)gain)[lane + 64 * j];
    for (int m = bid * 8 + wave; m < M; m += nblk * 8) {
        const f32x4* xr = (const f32x4*)(src + (size_t)m * DM);
        f32x4 v[8]; float ss = 0.f;
#pragma unroll
        for (int j = 0; j < 8; ++j) { v[j] = xr[lane + 64 * j]; ss += (v[j].x * v[j].x + v[j].y * v[j].y) + (v[j].z * v[j].z + v[j].w * v[j].w); }
        if (copy_dst) {
            f32x4* cr = (f32x4*)(copy_dst + (size_t)m * DM);
#pragma unroll
            for (int j = 0; j < 8; ++j) cr[lane + 64 * j] = v[j];
        }
        const float rs = rsqrtf(wave_sum(ss) * (1.0f / DM) + EPS);
        u32x2* o8 = (u32x2*)(HB + (size_t)m * DM);
#pragma unroll
        for (int j = 0; j < 8; ++j) { v[j] = v[j] * rs * gv[j]; u32x2 w; w.x = pk2(v[j].x, v[j].y); w.y = pk2(v[j].z, v[j].w); o8[lane + 64 * j] = w; }
        if (GATES) {
            float myv = 0.f;
#pragma unroll 1
            for (int g = 0; g < 12; ++g) {
                float a = 0.f;
#pragma unroll
                for (int j = 0; j < 8; ++j) { const f32x4 w = ((LAS f32x4*)(wg + g * DM))[lane + 64 * j]; a += (v[j].x * w.x + v[j].y * w.y) + (v[j].z * w.z + v[j].w * w.w); }
                a = wave_sum(a);
                if (lane == g) myv = a;
            }
            if (lane < 12) GL[(size_t)m * 16 + lane] = myv;
        }
    }
    if (GATES) __syncthreads();
}

__device__ __forceinline__ void final_norm_phase(float* X, const float* gain, int wave, int lane, int bid, int nblk) {
    f32x4 gv[8];
#pragma unroll
    for (int j = 0; j < 8; ++j) gv[j] = ((const f32x4*)gain)[lane + 64 * j];
    for (int m = bid * 8 + wave; m < M; m += nblk * 8) {
        f32x4* xr = (f32x4*)(X + (size_t)m * DM);
        f32x4 v[8]; float ss = 0.f;
#pragma unroll
        for (int j = 0; j < 8; ++j) { v[j] = xr[lane + 64 * j]; ss += (v[j].x * v[j].x + v[j].y * v[j].y) + (v[j].z * v[j].z + v[j].w * v[j].w); }
        const float rs = rsqrtf(wave_sum(ss) * (1.0f / DM) + EPS);
#pragma unroll
        for (int j = 0; j < 8; ++j) xr[lane + 64 * j] = v[j] * rs * gv[j];
    }
}

struct EpiResAdd {
    static constexpr bool PERM = false, AFTER_DRAIN = false;
    float* X; int ldc;
    __device__ __forceinline__ void operator()(const pg8::f32x4 (&acc)[2][2][4][2], const pg8::Unit& u, int wr, int wc, int fr, int fq) const {
#pragma unroll
        for (int ai = 0; ai < 2; ++ai)
#pragma unroll
            for (int m = 0; m < 4; ++m) {
                float* rowp = X + (size_t)(u.pm * 256 + ai * 128 + wr * 64 + m * 16 + fr) * ldc + u.pn * 256 + wc * 32 + 4 * fq;
#pragma unroll
                for (int bj = 0; bj < 2; ++bj)
#pragma unroll
                    for (int n = 0; n < 2; ++n) { pg8::f32x4* p = (pg8::f32x4*)(rowp + bj * 128 + n * 16); *p = *p + acc[ai][bj][m][n]; }
            }
    }
};
#define XB_TMO      128
#define XB_XCNT(j)  (256  + 64 * (j))
#define XB_XSUB(j)  (1280 + 64 * (j))
#define XB_XGEN(j)  (2304 + 64 * (j))
#define XB_TOP      3328
#define XB_TOPGEN   3392
#define XCD_BAR_WORDS 3456
#define XB_SPIN_CAP (1u << 18)

__device__ __forceinline__ unsigned xb_ld(unsigned* p)              { return __hip_atomic_load(p, __ATOMIC_RELAXED, __HIP_MEMORY_SCOPE_AGENT); }
__device__ __forceinline__ unsigned xb_add(unsigned* p, unsigned v) { return __hip_atomic_fetch_add(p, v, __ATOMIC_RELAXED, __HIP_MEMORY_SCOPE_AGENT); }
__device__ __forceinline__ unsigned xb_xcc_id() { return (unsigned)__builtin_amdgcn_s_getreg((3 << 11) | 20) & 0xFu; }
#define XB_SPIN(cond, bar) do { unsigned _sp = 0; while (cond) { __builtin_amdgcn_s_sleep(1); \
    if ((++_sp & 255u) == 0u) { if (xb_ld(&(bar)[XB_TMO])) break; if (_sp > XB_SPIN_CAP) { atomicAdd(&(bar)[XB_TMO], 1u); break; } } } } while (0)

struct XcdBarrier {
    unsigned* bar; unsigned x;
    volatile LAS unsigned* st;
};

__device__ __forceinline__ XcdBarrier xcd_barrier_post(unsigned* bar, volatile LAS unsigned* st) {
    XcdBarrier b; b.bar = bar; b.x = xb_xcc_id(); b.st = st;
    if (threadIdx.x == 0) (void)xb_add(&bar[XB_XCNT(b.x)], 1u);
    return b;
}
__device__ __forceinline__ void xcd_barrier_complete(unsigned* bar, unsigned x, unsigned& nloc, unsigned& nx) {
    const unsigned G = gridDim.x * gridDim.y * gridDim.z;
    unsigned sum, cnt, mine, sp = 0u;
    for (;;) {
        sum = 0u; cnt = 0u; mine = 0u;
#pragma unroll
        for (unsigned j = 0; j < 16; ++j) { const unsigned c = xb_ld(&bar[XB_XCNT(j)]); sum += c; cnt += (c > 0u) ? 1u : 0u; mine = (j == x) ? c : mine; }
        if (sum == G) break;
        __builtin_amdgcn_s_sleep(1);
        if ((++sp & 255u) == 0u) { if (xb_ld(&bar[XB_TMO])) break; if (sp > XB_SPIN_CAP) { atomicAdd(&bar[XB_TMO], 1u); break; } }
    }
    nloc = mine > 0u ? mine : 1u; nx = cnt > 0u ? cnt : 1u;
}

__device__ __forceinline__ void xcd_barrier(const XcdBarrier& b) {
    asm volatile("s_waitcnt vmcnt(0)" ::: "memory");
    __syncthreads();
    if (threadIdx.x == 0) {
        unsigned* bar = b.bar;
        __builtin_amdgcn_s_waitcnt(0);
        unsigned nloc = b.st[0], nx = b.st[1];
        if (nloc == 0u) { xcd_barrier_complete(bar, b.x, nloc, nx); b.st[0] = nloc; b.st[1] = nx; }
        const unsigned old = xb_add(&bar[XB_XSUB(b.x)], 1u);
        const unsigned gen = old / nloc;
        if (old + 1u == (gen + 1u) * nloc) {
            __builtin_amdgcn_fence(__ATOMIC_RELEASE, "agent");
            asm volatile("s_waitcnt vmcnt(0)" ::: "memory");
            const unsigned og = xb_add(&bar[XB_TOP], 1u);
            const unsigned tg = og / nx;
            if (og + 1u == (tg + 1u) * nx) xb_add(&bar[XB_TOPGEN], 1u);
            else XB_SPIN(xb_ld(&bar[XB_TOPGEN]) == tg, bar);
            __builtin_amdgcn_fence(__ATOMIC_ACQUIRE, "agent");
            xb_add(&bar[XB_XGEN(b.x)], 1u);
            asm volatile("s_waitcnt vmcnt(0)" ::: "memory");
        } else {
            XB_SPIN(xb_ld(&bar[XB_XGEN(b.x)]) == gen, bar);
            __builtin_amdgcn_fence(__ATOMIC_ACQUIRE, "agent");
            asm volatile("s_waitcnt vmcnt(0)" ::: "memory");
        }
    }
    __syncthreads();
}

__device__ __forceinline__ void lru_chunk_unit(const Ctx& P, int l, int unit, LAS unsigned char* lds, int tid, int wave, int lane) {
    const bf16_t* Z = (const bf16_t*)(P.ws() + WS_Z);
    float* LA = (float*)(P.ws() + WS_LRUA); float* LU = (float*)(P.ws() + WS_LRUU); float* AGG = (float*)(P.ws() + WS_LAGG);
    const int b = unit >> 7, ck = unit & 127, t0 = ck * 64; const size_t m0 = (size_t)b * T + t0;
    const int ch = tid;
    LAS float* xw = (LAS float*)(lds + wave * 16384);
    {
        const int cg8 = tid & 63, tg = tid >> 6, c0 = 8 * cg8, tb = 8 * tg;
        const float* cw = P.in(3) + (size_t)l * 4 * 512 + c0; const float* cbp = P.in(4) + l * 512 + c0;
        f32x4 w[4][2], bb[2];
#pragma unroll
        for (int k = 0; k < 4; ++k) { w[k][0] = *(const f32x4*)(cw + k * 512); w[k][1] = *(const f32x4*)(cw + k * 512 + 4); }
        bb[0] = *(const f32x4*)cbp; bb[1] = *(const f32x4*)(cbp + 4);
        u32x4 r[11];
#pragma unroll
        for (int j = 0; j < 11; ++j) {
            const int tt = t0 + tb + j - 3;
            if (tt >= 0) r[j] = *(const u32x4*)(Z + (m0 + tb + j - 3) * NZ + ZC_AX + c0); else r[j] = (u32x4){0u, 0u, 0u, 0u};
        }
        LAS float* xt = (LAS float*)(lds + (cg8 >> 3) * 16384) + (c0 & 63);
#pragma unroll
        for (int t = 0; t < 8; ++t) {
            f32x4 o0, o1;
#pragma unroll
            for (int q = 0; q < 4; ++q) {
                const float lo = bb[q >> 1][(2 * q) & 3] + w[0][q >> 1][(2 * q) & 3] * bflo(r[t][q]) + w[1][q >> 1][(2 * q) & 3] * bflo(r[t + 1][q]) + w[2][q >> 1][(2 * q) & 3] * bflo(r[t + 2][q]) + w[3][q >> 1][(2 * q) & 3] * bflo(r[t + 3][q]);
                const float hi = bb[q >> 1][(2 * q + 1) & 3] + w[0][q >> 1][(2 * q + 1) & 3] * bfhi(r[t][q]) + w[1][q >> 1][(2 * q + 1) & 3] * bfhi(r[t + 1][q]) + w[2][q >> 1][(2 * q + 1) & 3] * bfhi(r[t + 2][q]) + w[3][q >> 1][(2 * q + 1) & 3] * bfhi(r[t + 3][q]);
                if (q < 2) { o0[2 * q] = lo; o0[2 * q + 1] = hi; } else { o1[2 * (q - 2)] = lo; o1[2 * (q - 2) + 1] = hi; }
            }
            *(LAS f32x4*)(xt + (tb + t) * 64) = o0; *(LAS f32x4*)(xt + (tb + t) * 64 + 4) = o1;
        }
    }
    __syncthreads();
    const float* wa = P.in(5) + ((size_t)l * 8 + wave) * 4096; const float* wx = P.in(7) + ((size_t)l * 8 + wave) * 4096;
    const float ba = P.in(6)[l * 512 + ch], bx = P.in(8)[l * 512 + ch];
    const float lam = P.in(9)[l * 512 + ch]; const float sp = softplusf_(-lam);
    float h = 0.f, ap = 1.f;
    for (int half = 0; half < 2; ++half) {
        float ra[32], ia[32];
#pragma unroll
        for (int t = 0; t < 32; ++t) { ra[t] = ba; ia[t] = bx; }
        for (int c = 0; c < 64; c += 4) {
            const float a0 = wa[(c + 0) * 64 + lane], a1 = wa[(c + 1) * 64 + lane], a2 = wa[(c + 2) * 64 + lane], a3 = wa[(c + 3) * 64 + lane];
            const float b0 = wx[(c + 0) * 64 + lane], b1 = wx[(c + 1) * 64 + lane], b2 = wx[(c + 2) * 64 + lane], b3 = wx[(c + 3) * 64 + lane];
#pragma unroll
            for (int t = 0; t < 32; ++t) {
                const f32x4 xv = *(const LAS f32x4*)(xw + (half * 32 + t) * 64 + c);
                ra[t] += xv.x * a0 + xv.y * a1 + xv.z * a2 + xv.w * a3;
                ia[t] += xv.x * b0 + xv.y * b1 + xv.z * b2 + xv.w * b3;
            }
        }
#pragma unroll
        for (int t = 0; t < 32; ++t) {
            const int tt = half * 32 + t;
            const float r = sigmoidf_(ra[t]), ig = sigmoidf_(ia[t]);
            const float log_a = -8.0f * r * sp;
            const float a = __expf(log_a);
            const float u = sqrtf(-expm1f(2.0f * log_a)) * (ig * xw[tt * 64 + lane]);
            LA[(m0 + tt) * 512 + ch] = a; LU[(m0 + tt) * 512 + ch] = u;
            h = a * h + u; ap *= a;
        }
    }
    AGG[((size_t)unit * 2 + 0) * 512 + ch] = ap; AGG[((size_t)unit * 2 + 1) * 512 + ch] = h;
}

__device__ __forceinline__ void fox_cumsum_unit(const Ctx& P, int l, int unit, LAS unsigned char* lds, int tid, int wave, int lane) {
    const float* GL = (const float*)(P.ws() + WS_GL); float* FC = (float*)(P.ws() + WS_FOXC);
    const int b = unit >> 2, hh = unit & 3; const float fb = P.in(10)[l * 4 + hh];
    LAS float* wtot = (LAS float*)lds;
    float v[16]; float s = 0.f;
#pragma unroll
    for (int i = 0; i < 16; ++i) { const float x = GL[((size_t)b * T + tid * 16 + i) * 16 + hh] + fb; const float lf = fminf(x, 0.f) - log1pf(__expf(-fabsf(x))); s += lf; v[i] = s; }
    float sc = s;
#pragma unroll
    for (int o = 1; o < 64; o <<= 1) { const float n = __shfl_up(sc, o); if (lane >= o) sc += n; }
    __syncthreads();
    if (lane == 63) wtot[wave] = sc;
    __syncthreads();
    float base = sc - s;
    for (int w = 0; w < wave; ++w) base += wtot[w];
#pragma unroll
    for (int i = 0; i < 16; ++i) FC[((size_t)unit) * T + tid * 16 + i] = base + v[i];
    __syncthreads();
}

__device__ __forceinline__ void gdn_prep_unit(const Ctx& P, int l, int unit, LAS unsigned char* lds, int tid, int wave, int lane) {
    const bf16_t* Z = (const bf16_t*)(P.ws() + WS_Z); const float* GL = (const float*)(P.ws() + WS_GL);
    const int bh = unit >> 7, n = unit & 127, b = bh >> 2, hh = bh & 3; const size_t m0 = (size_t)b * T + n * 64;
    LAS float* Kf = (LAS float*)lds; LAS float* Qf = Kf + 64 * 132; LAS float* Vf = Qf + 64 * 132; LAS float* KK = Vf + 64 * 132; LAS float* QKm = KK + 64 * 68;
    LAS float* gcs = QKm + 64 * 68; LAS float* bet = gcs + 64; LAS float* eg = bet + 64;
    __syncthreads();
    {
        const int cg = tid & 15, tg = tid >> 4, tb = 2 * tg;
        const float* cw = P.in(11) + (size_t)l * 4 * 1536;
#pragma unroll
        for (int part = 0; part < 3; ++part) {
            const int cc = part * 512 + hh * 128 + 8 * cg; const int zc = ZC_CQ + cc;
            f32x4 w[4][2];
#pragma unroll
            for (int k = 0; k < 4; ++k) { w[k][0] = *(const f32x4*)(cw + k * 1536 + cc); w[k][1] = *(const f32x4*)(cw + k * 1536 + cc + 4); }
            u32x4 r[5];
#pragma unroll
            for (int j = 0; j < 5; ++j) {
                const int tt = n * 64 + tb + j - 3;
                if (tt >= 0) r[j] = *(const u32x4*)(Z + (m0 + tb + j - 3) * NZ + zc); else r[j] = (u32x4){0u, 0u, 0u, 0u};
            }
            LAS float* dst = ((part == 0) ? Qf : (part == 1 ? Kf : Vf)) + 8 * cg;
#pragma unroll
            for (int t = 0; t < 2; ++t) {
                f32x4 o0, o1;
#pragma unroll
                for (int q = 0; q < 4; ++q) {
                    const float lo = w[0][q >> 1][(2 * q) & 3] * bflo(r[t][q]) + w[1][q >> 1][(2 * q) & 3] * bflo(r[t + 1][q]) + w[2][q >> 1][(2 * q) & 3] * bflo(r[t + 2][q]) + w[3][q >> 1][(2 * q) & 3] * bflo(r[t + 3][q]);
                    const float hi = w[0][q >> 1][(2 * q + 1) & 3] * bfhi(r[t][q]) + w[1][q >> 1][(2 * q + 1) & 3] * bfhi(r[t + 1][q]) + w[2][q >> 1][(2 * q + 1) & 3] * bfhi(r[t + 2][q]) + w[3][q >> 1][(2 * q + 1) & 3] * bfhi(r[t + 3][q]);
                    if (q < 2) { o0[2 * q] = siluf_(lo); o0[2 * q + 1] = siluf_(hi); } else { o1[2 * (q - 2)] = siluf_(lo); o1[2 * (q - 2) + 1] = siluf_(hi); }
                }
                *(LAS f32x4*)(dst + (tb + t) * 132) = o0; *(LAS f32x4*)(dst + (tb + t) * 132 + 4) = o1;
            }
        }
        if (tid < 64) {
            const float bl = GL[(m0 + tid) * 16 + 4 + hh], al = GL[(m0 + tid) * 16 + 8 + hh];
            const float g = -__expf(P.in(12)[l * 4 + hh]) * softplusf_(al + P.in(13)[l * 4 + hh]);
            float sc = g;
#pragma unroll
            for (int o = 1; o < 64; o <<= 1) { const float nn = __shfl_up(sc, o); if (lane >= o) sc += nn; }
            gcs[tid] = sc; eg[tid] = __expf(sc); bet[tid] = sigmoidf_(bl);
        }
    }
    __syncthreads();
    {
        const int row = tid >> 2, j = tid & 3; LAS float* base = (row < 64) ? (Qf + row * 132) : (Kf + (row - 64) * 132);
        float ss = 0.f;
#pragma unroll 8
        for (int e = 0; e < 32; ++e) { const float x = base[4 * e + j]; ss += x * x; }
        ss += __shfl_xor(ss, 1); ss += __shfl_xor(ss, 2);
        const float rn = rsqrtf(ss + EPS) * ((row < 64) ? 0.08838834764831845f : 1.0f);
#pragma unroll 8
        for (int e = 0; e < 32; ++e) base[4 * e + j] *= rn;
    }
    __syncthreads();
    {
        const int ti = tid >> 3, tj = tid & 7;
        float akk[8], aqk[8];
#pragma unroll
        for (int jj = 0; jj < 8; ++jj) { akk[jj] = 0.f; aqk[jj] = 0.f; }
        for (int d = 0; d < 128; d += 4) {
            const f32x4 ki = *(const LAS f32x4*)(Kf + ti * 132 + d), qi = *(const LAS f32x4*)(Qf + ti * 132 + d);
#pragma unroll
            for (int jj = 0; jj < 8; ++jj) {
                const f32x4 kj = *(const LAS f32x4*)(Kf + (8 * jj + tj) * 132 + d);
                akk[jj] += (ki.x * kj.x + ki.y * kj.y) + (ki.z * kj.z + ki.w * kj.w);
                aqk[jj] += (qi.x * kj.x + qi.y * kj.y) + (qi.z * kj.z + qi.w * kj.w);
            }
        }
        const float gi = gcs[ti], bi = bet[ti];
#pragma unroll
        for (int jj = 0; jj < 8; ++jj) {
            const int j = 8 * jj + tj;
            const float dec = (j <= ti) ? __expf(gi - gcs[j]) : 0.f;
            KK[ti * 68 + j] = (j < ti) ? akk[jj] * bi * dec : 0.f;
            QKm[ti * 68 + j] = (j <= ti) ? aqk[jj] * dec : 0.f;
        }
    }
    __syncthreads();
    unsigned char* rec = P.ws() + WS_GREC + (size_t)unit * GREC_BYTES;
    {
#pragma unroll
        for (int it = 0; it < 2; ++it) {
            const int chunk = tid + it * NTHR, c = chunk >> 4, p0 = (chunk & 15) * 8; const float e = eg[c]; float v[8];
#pragma unroll
            for (int j = 0; j < 8; ++j) v[j] = Qf[c * 132 + (p0 & ~31) + perm32((p0 & 31) + j)] * e;
            u32x4 o; o.x = pk2(v[0], v[1]); o.y = pk2(v[2], v[3]); o.z = pk2(v[4], v[5]); o.w = pk2(v[6], v[7]);
            *(u32x4*)(rec + 16384 + (size_t)(c * 128 + p0) * 2) = o;
        }
        {
            const int i = tid >> 3, p0 = (tid & 7) * 8; float v[8];
#pragma unroll
            for (int j = 0; j < 8; ++j) v[j] = QKm[i * 68 + (p0 & ~31) + perm32((p0 & 31) + j)];
            u32x4 o; o.x = pk2(v[0], v[1]); o.y = pk2(v[2], v[3]); o.z = pk2(v[4], v[5]); o.w = pk2(v[6], v[7]);
            *(u32x4*)(rec + 32768 + (size_t)(i * 64 + p0) * 2) = o;
        }
        const float glast = gcs[63];
#pragma unroll
        for (int it = 0; it < 2; ++it) {
            const int chunk = tid + it * NTHR, dk = chunk & 127, p0 = (chunk >> 7) * 8; float v[8];
#pragma unroll
            for (int j = 0; j < 8; ++j) { const int c = (p0 & ~31) + perm32((p0 & 31) + j); v[j] = Kf[c * 132 + dk] * __expf(glast - gcs[c]); }
            u32x4 o; o.x = pk2(v[0], v[1]); o.y = pk2(v[2], v[3]); o.z = pk2(v[4], v[5]); o.w = pk2(v[6], v[7]);
            *(u32x4*)(rec + 40960 + (size_t)(dk * 64 + p0) * 2) = o;
        }
        if (tid == 0) ((float*)(P.ws() + WS_GLAST))[unit] = __expf(glast);
    }
    if (tid < 256) {
        const int col = tid; float sol[64];
        if (col < 128) {
#pragma unroll
            for (int j = 0; j < 64; ++j) sol[j] = Vf[j * 132 + col] * bet[j];
        } else {
#pragma unroll
            for (int j = 0; j < 64; ++j) sol[j] = Kf[j * 132 + (col - 128)] * bet[j] * eg[j];
        }
#pragma unroll
        for (int i = 1; i < 64; ++i) {
            float acc = sol[i];
#pragma unroll
            for (int j4 = 0; j4 < (i + 3) / 4; ++j4) {
                const f32x4 kk = *(const LAS f32x4*)(KK + i * 68 + 4 * j4);
                acc -= kk.x * sol[4 * j4 + 0]; acc -= kk.y * sol[4 * j4 + 1]; acc -= kk.z * sol[4 * j4 + 2]; acc -= kk.w * sol[4 * j4 + 3];
            }
            sol[i] = acc;
        }
        if (col < 128) {
            float* U = (float*)(P.ws() + WS_GU) + (size_t)unit * 8192;
#pragma unroll
            for (int i = 0; i < 64; ++i) U[i * 128 + col] = sol[i];
        } else {
            const int dk = col - 128; const int pos = (dk & ~31) + invperm32(dk & 31);
            bf16_t* Wp = (bf16_t*)rec;
#pragma unroll
            for (int i = 0; i < 64; ++i) Wp[i * 128 + pos] = (bf16_t)f2bf(-sol[i]);
        }
    }
    __syncthreads();
}

constexpr int AT_KSTR = 272, AT_VSTR = 320;
constexpr int AT_KBUF = 64 * AT_KSTR, AT_VBUF = 64 * AT_VSTR;
constexpr int AT_K0 = 0, AT_V0 = 2 * AT_KBUF, AT_C0 = AT_V0 + 2 * AT_VBUF;

__device__ __forceinline__ s16x4 vtr(const LAS unsigned char* p) {
    typedef short v4i16_t __attribute__((ext_vector_type(4)));
    return __builtin_bit_cast(s16x4, __builtin_amdgcn_ds_read_tr16_b64_v4i16((LAS v4i16_t*)p));
}

template <int MODE>
__device__ __forceinline__ void attn_unit(const Ctx& P, int l, LAS unsigned char* lds, int tid, int wave, int lane,
                                          int b, int hh, int dil, int res, int m0, int branch) {
    const bf16_t* Z = (const bf16_t*)(P.ws() + WS_Z);
    const int qcol = (MODE == 0 ? ZC_BQ : ZC_DQ) + hh * 128, kcol = (MODE == 0 ? ZC_BK : ZC_DK) + hh * 128, vcol = (MODE == 0 ? ZC_BV : ZC_DV) + hh * 128;
    const size_t rowbase = (size_t)b * T + res;
    const float* FC = (const float*)(P.ws() + WS_FOXC) + (size_t)(b * 4 + hh) * T;
    const int ql = lane & 31, hi = lane >> 5;
    const int mq_lo = m0 + 32 * wave, mq = mq_lo + ql, mq_hi = mq_lo + 31;
    const int kt_lo = (MODE == 0) ? 0 : ((m0 >= 128 ? m0 - 128 : 0) >> 6), kt_hi = (m0 >> 6) + 3;
    constexpr float SC2 = 0.08838834764831845f * 1.4426950408889634f, L2E = 1.4426950408889634f;

    bf16x8 qf[8];
    {
        const bf16_t* qp = Z + (rowbase + (size_t)mq * dil) * NZ + qcol + 8 * hi;
#pragma unroll
        for (int ks = 0; ks < 8; ++ks) qf[ks] = *(const bf16x8*)(qp + 16 * ks);
    }
    float cq2 = 0.f;
    if (MODE == 0) cq2 = FC[mq] * L2E;

    const int srow = tid >> 3, spart = tid & 7;
    u32x4 kr0, kr1, vr0, vr1; float cr = 0.f;
    auto gload = [&](int kt) {
        const int mk = 64 * kt + srow;
        const bf16_t* rp = Z + (rowbase + (size_t)mk * dil) * NZ;
        kr0 = *(const u32x4*)(rp + kcol + spart * 16); kr1 = *(const u32x4*)(rp + kcol + spart * 16 + 8);
        vr0 = *(const u32x4*)(rp + vcol + spart * 16); vr1 = *(const u32x4*)(rp + vcol + spart * 16 + 8);
        if (MODE == 0 && tid < 64) cr = FC[64 * kt + tid] * L2E;
    };
    auto lstore = [&](int buf) {
        LAS unsigned char* kb = lds + AT_K0 + buf * AT_KBUF + srow * AT_KSTR + spart * 32;
        *(LAS u32x4*)kb = kr0; *(LAS u32x4*)(kb + 16) = kr1;
        LAS unsigned char* vb = lds + AT_V0 + buf * AT_VBUF + srow * AT_VSTR + spart * 32;
        *(LAS u32x4*)vb = vr0; *(LAS u32x4*)(vb + 16) = vr1;
        if (MODE == 0 && tid < 64) ((LAS float*)(lds + AT_C0))[buf * 64 + tid] = cr;
    };

    f32x16 O[4];
#pragma unroll
    for (int mt = 0; mt < 4; ++mt)
#pragma unroll
        for (int r = 0; r < 16; ++r) O[mt][r] = 0.f;
    float m_run = -INFINITY, l_run = 0.f;

    __syncthreads();
    gload(kt_lo); lstore(0);
    __syncthreads();

    const int gq = lane >> 4, li = lane & 15, tq = li >> 2, tp = li & 3;
    const int vbase_lane = (4 * (gq >> 1) + tq) * AT_VSTR + (16 * (gq & 1) + 4 * tp) * 2;

    for (int kt = kt_lo; kt <= kt_hi; ++kt) {
        const int buf = (kt - kt_lo) & 1;
        if (kt < kt_hi) gload(kt + 1);
        const bool need = (MODE == 0) ? (64 * kt <= mq_hi) : ((64 * kt + 63 >= mq_lo - 128) && (64 * kt <= mq_hi));
        if (need) {
            const LAS unsigned char* kb = lds + AT_K0 + buf * AT_KBUF + ql * AT_KSTR + hi * 16;
            f32x16 p0, p1;
#pragma unroll
            for (int r = 0; r < 16; ++r) { p0[r] = 0.f; p1[r] = 0.f; }
#pragma unroll
            for (int ks = 0; ks < 8; ++ks) {
                const bf16x8 a0 = *(const LAS bf16x8*)(kb + ks * 32);
                const bf16x8 a1 = *(const LAS bf16x8*)(kb + 32 * AT_KSTR + ks * 32);
                p0 = __builtin_amdgcn_mfma_f32_32x32x16_bf16(a0, qf[ks], p0, 0, 0, 0);
                p1 = __builtin_amdgcn_mfma_f32_32x32x16_bf16(a1, qf[ks], p1, 0, 0, 0);
            }
            const LAS float* cb = (const LAS float*)(lds + AT_C0) + buf * 64;
            float mx = -INFINITY;
            const bool interior = (MODE == 0) ? (64 * kt + 63 <= mq_lo) : ((64 * kt + 63 <= mq_lo) && (mq_hi - 64 * kt <= 128));
            if (interior) {
#pragma unroll
                for (int a = 0; a < 4; ++a) {
                    f32x4 c0 = {0.f, 0.f, 0.f, 0.f}, c1 = {0.f, 0.f, 0.f, 0.f};
                    if (MODE == 0) { c0 = *(const LAS f32x4*)(cb + 8 * a + 4 * hi); c1 = *(const LAS f32x4*)(cb + 32 + 8 * a + 4 * hi); }
#pragma unroll
                    for (int e = 0; e < 4; ++e) {
                        const int r = 4 * a + e;
                        float s0 = p0[r] * SC2, s1 = p1[r] * SC2;
                        if (MODE == 0) { s0 += cq2 - c0[e]; s1 += cq2 - c1[e]; }
                        p0[r] = s0; p1[r] = s1; mx = fmaxf(mx, fmaxf(s0, s1));
                    }
                }
            } else
#pragma unroll
            for (int a = 0; a < 4; ++a) {
                f32x4 c0 = {0.f, 0.f, 0.f, 0.f}, c1 = {0.f, 0.f, 0.f, 0.f};
                if (MODE == 0) { c0 = *(const LAS f32x4*)(cb + 8 * a + 4 * hi); c1 = *(const LAS f32x4*)(cb + 32 + 8 * a + 4 * hi); }
#pragma unroll
                for (int e = 0; e < 4; ++e) {
                    const int r = 4 * a + e; const int k0 = 64 * kt + 8 * a + 4 * hi + e, k1 = k0 + 32;
                    float s0 = p0[r] * SC2, s1 = p1[r] * SC2;
                    if (MODE == 0) { s0 += cq2 - c0[e]; s1 += cq2 - c1[e]; }
                    const bool ok0 = (MODE == 0) ? (k0 <= mq) : (k0 <= mq && mq - k0 <= 128);
                    const bool ok1 = (MODE == 0) ? (k1 <= mq) : (k1 <= mq && mq - k1 <= 128);
                    s0 = ok0 ? s0 : -INFINITY; s1 = ok1 ? s1 : -INFINITY;
                    p0[r] = s0; p1[r] = s1; mx = fmaxf(mx, fmaxf(s0, s1));
                }
            }
            mx = fmaxf(mx, __shfl_xor(mx, 32));
            const float m_new = fmaxf(m_run, mx);
            const float m_use = (m_new == -INFINITY) ? 0.f : m_new;
            const float alpha = __builtin_amdgcn_exp2f(m_run - m_use);
            float ls = 0.f;
#pragma unroll
            for (int r = 0; r < 16; ++r) { p0[r] = __builtin_amdgcn_exp2f(p0[r] - m_use); p1[r] = __builtin_amdgcn_exp2f(p1[r] - m_use); ls += p0[r] + p1[r]; }
            const float m_run_prev = m_run;
            l_run = l_run * alpha + ls; m_run = m_new;
            if (!__all(m_new == m_run_prev)) {
#pragma unroll
            for (int mt = 0; mt < 4; ++mt)
#pragma unroll
                for (int r = 0; r < 16; ++r) O[mt][r] *= alpha;
            }
            bf16x8 pf[4];
#pragma unroll
            for (int s = 0; s < 4; ++s) {
                u32x4 w;
                if (s < 2) { w.x = pk2(p0[8 * s + 0], p0[8 * s + 1]); w.y = pk2(p0[8 * s + 2], p0[8 * s + 3]); w.z = pk2(p0[8 * s + 4], p0[8 * s + 5]); w.w = pk2(p0[8 * s + 6], p0[8 * s + 7]); }
                else { const int s2 = s - 2; w.x = pk2(p1[8 * s2 + 0], p1[8 * s2 + 1]); w.y = pk2(p1[8 * s2 + 2], p1[8 * s2 + 3]); w.z = pk2(p1[8 * s2 + 4], p1[8 * s2 + 5]); w.w = pk2(p1[8 * s2 + 6], p1[8 * s2 + 7]); }
                pf[s] = __builtin_bit_cast(bf16x8, w);
            }
            const LAS unsigned char* vb = lds + AT_V0 + buf * AT_VBUF + vbase_lane;
#pragma unroll
            for (int mt = 0; mt < 4; ++mt)
#pragma unroll
                for (int s = 0; s < 4; ++s) {
                    const s16x4 lo = vtr(vb + (16 * s) * AT_VSTR + mt * 64);
                    const s16x4 hi4 = vtr(vb + (16 * s + 8) * AT_VSTR + mt * 64);
                    const bf16x8 vf = {lo[0], lo[1], lo[2], lo[3], hi4[0], hi4[1], hi4[2], hi4[3]};
                    O[mt] = __builtin_amdgcn_mfma_f32_32x32x16_bf16(vf, pf[s], O[mt], 0, 0, 0);
                }
        }
        if (kt < kt_hi) lstore(buf ^ 1);
        __syncthreads();
    }
    const float l_tot = l_run + __shfl_xor(l_run, 32);
    const float inv = 1.0f / l_tot;
    const size_t orow = rowbase + (size_t)mq * dil;
    if (MODE == 0) {
        float ss = 0.f;
#pragma unroll
        for (int mt = 0; mt < 4; ++mt)
#pragma unroll
            for (int r = 0; r < 16; ++r) { O[mt][r] *= inv; ss += O[mt][r] * O[mt][r]; }
        ss += __shfl_xor(ss, 32);
        const float rn = rsqrtf(ss * (1.0f / 128.0f) + EPS);
        const float* nb = P.in(16) + l * 512 + hh * 128;
        bf16_t* yp = (bf16_t*)(P.ws() + WS_Y) + orow * DM + 512 + hh * 128;
#pragma unroll
        for (int mt = 0; mt < 4; ++mt)
#pragma unroll
            for (int a = 0; a < 4; ++a) {
                const int dv = 32 * mt + 8 * a + 4 * hi; const f32x4 g = *(const f32x4*)(nb + dv);
                u32x2 w; w.x = pk2(O[mt][4 * a + 0] * rn * g.x, O[mt][4 * a + 1] * rn * g.y); w.y = pk2(O[mt][4 * a + 2] * rn * g.z, O[mt][4 * a + 3] * rn * g.w);
                *(u32x2*)(yp + dv) = w;
            }
    } else {
        bf16_t* op = (bf16_t*)(P.ws() + WS_OD) + ((size_t)branch * M + orow) * 512 + hh * 128;
#pragma unroll
        for (int mt = 0; mt < 4; ++mt)
#pragma unroll
            for (int a = 0; a < 4; ++a) {
                const int dv = 32 * mt + 8 * a + 4 * hi;
                u32x2 w; w.x = pk2(O[mt][4 * a + 0] * inv, O[mt][4 * a + 1] * inv); w.y = pk2(O[mt][4 * a + 2] * inv, O[mt][4 * a + 3] * inv);
                *(u32x2*)(op + dv) = w;
            }
        if (hi == 0) ((float*)(P.ws() + WS_LSE))[((size_t)branch * M + orow) * 4 + hh] = (m_run + __builtin_amdgcn_logf(l_tot)) * 0.6931471805599453f;
    }
}

constexpr int GS_WP = 0, GS_QP = 64 * 272, GS_QK = 2 * 64 * 272, GS_KT = GS_QK + 64 * 144, GS_BUF = GS_KT + 128 * 144;
__device__ __forceinline__ void gdn_seq_unit(const Ctx& P, int l, int unit, LAS unsigned char* lds, int tid, int wave, int lane) {
    const int bh = unit >> 2, dvb = 32 * (unit & 3) + 16 * wave; const bool active = wave < 2;
    const int b = bh >> 2, hh = bh & 3;
    const unsigned char* recs = P.ws() + WS_GREC + (size_t)bh * 128 * GREC_BYTES;
    const float* Ug = (const float*)(P.ws() + WS_GU) + (size_t)bh * 128 * 8192;
    const float* GLv = (const float*)(P.ws() + WS_GLAST) + bh * 128;
    float* OC = (float*)(P.ws() + WS_OC);
    const int fr = lane & 15, g = lane >> 4;
    int soff[7];
#pragma unroll
    for (int i = 0; i < 7; ++i) {
        const int q = tid + i * NTHR; int off;
        if (q < 1024) off = GS_WP + (q >> 4) * 272 + (q & 15) * 16;
        else if (q < 2048) off = GS_QP + ((q - 1024) >> 4) * 272 + (q & 15) * 16;
        else if (q < 2560) off = GS_QK + ((q - 2048) >> 3) * 144 + (q & 7) * 16;
        else off = GS_KT + ((q - 2560) >> 3) * 144 + (q & 7) * 16;
        soff[i] = off;
    }
    u32x4 stg;
    const unsigned lane_off = (unsigned)tid * 16u;
#define GS_LOAD(n_, i_) stg = *(const u32x4*)((recs + (size_t)(n_) * GREC_BYTES + (size_t)(i_) * 8192) + lane_off)
#define GS_STORE(buf_, i_) *(LAS u32x4*)(lds + (buf_) * GS_BUF + soff[i_]) = stg
#define GS_PF(i_) do { if (n < 127) { if ((i_) > 0) GS_STORE(buf ^ 1, (i_) - 1); GS_LOAD(n + 1, (i_)); } } while (0)
    f32x4 S[8];
#pragma unroll
    for (int i = 0; i < 8; ++i) S[i] = (f32x4){0.f, 0.f, 0.f, 0.f};
    __syncthreads();
#pragma unroll
    for (int i = 0; i < 7; ++i) { GS_LOAD(0, i); GS_STORE(0, i); }
    __syncthreads();
    for (int n = 0; n < 128; ++n) {
        const int buf = n & 1;
        if (active) {
        GS_PF(0);
        const LAS unsigned char* base = lds + buf * GS_BUF;
        const float* U = Ug + (size_t)n * 8192;
        f32x4 vn[4];
#pragma unroll
        for (int mt = 0; mt < 4; ++mt)
#pragma unroll
            for (int i = 0; i < 4; ++i) vn[mt][i] = U[(16 * mt + 4 * g + i) * 128 + dvb + fr];
        const float gl = GLv[n];
        bf16x8 sb[4];
#pragma unroll
        for (int s = 0; s < 4; ++s) {
            u32x4 w; w.x = pk2(S[2 * s][0], S[2 * s][1]); w.y = pk2(S[2 * s][2], S[2 * s][3]); w.z = pk2(S[2 * s + 1][0], S[2 * s + 1][1]); w.w = pk2(S[2 * s + 1][2], S[2 * s + 1][3]);
            sb[s] = __builtin_bit_cast(bf16x8, w);
        }
        f32x4 oa[4];
#pragma unroll
        for (int mt = 0; mt < 4; ++mt) {
            oa[mt] = (f32x4){0.f, 0.f, 0.f, 0.f};
            __builtin_amdgcn_sched_barrier(0);
            if (mt == 1) GS_PF(1);
            if (mt == 3) GS_PF(2);
#pragma unroll
            for (int s = 0; s < 4; ++s) {
                const bf16x8 aw = *(const LAS bf16x8*)(base + GS_WP + (16 * mt + fr) * 272 + (32 * s + 8 * g) * 2);
                const bf16x8 aq = *(const LAS bf16x8*)(base + GS_QP + (16 * mt + fr) * 272 + (32 * s + 8 * g) * 2);
                vn[mt] = __builtin_amdgcn_mfma_f32_16x16x32_bf16(aw, sb[s], vn[mt], 0, 0, 0);
                oa[mt] = __builtin_amdgcn_mfma_f32_16x16x32_bf16(aq, sb[s], oa[mt], 0, 0, 0);
            }
        }
        bf16x8 vb[2];
#pragma unroll
        for (int s = 0; s < 2; ++s) {
            u32x4 w; w.x = pk2(vn[2 * s][0], vn[2 * s][1]); w.y = pk2(vn[2 * s][2], vn[2 * s][3]); w.z = pk2(vn[2 * s + 1][0], vn[2 * s + 1][1]); w.w = pk2(vn[2 * s + 1][2], vn[2 * s + 1][3]);
            vb[s] = __builtin_bit_cast(bf16x8, w);
        }
        GS_PF(3);
        __builtin_amdgcn_sched_barrier(0);
#pragma unroll
        for (int mt = 0; mt < 4; ++mt)
#pragma unroll
            for (int s = 0; s < 2; ++s) {
                const bf16x8 a = *(const LAS bf16x8*)(base + GS_QK + (16 * mt + fr) * 144 + (32 * s + 8 * g) * 2);
                oa[mt] = __builtin_amdgcn_mfma_f32_16x16x32_bf16(a, vb[s], oa[mt], 0, 0, 0);
            }
        {
            float* op = OC + ((size_t)b * T + n * 64) * 512 + hh * 128 + dvb + fr;
#pragma unroll
            for (int mt = 0; mt < 4; ++mt)
#pragma unroll
                for (int i = 0; i < 4; ++i) op[(size_t)(16 * mt + 4 * g + i) * 512] = oa[mt][i];
        }
        GS_PF(4);
#pragma unroll
        for (int dt = 0; dt < 8; ++dt) {
            __builtin_amdgcn_sched_barrier(0);
            if (dt == 3) GS_PF(5);
            if (dt == 6) GS_PF(6);
            S[dt] = S[dt] * gl;
#pragma unroll
            for (int s = 0; s < 2; ++s) {
                const bf16x8 a = *(const LAS bf16x8*)(base + GS_KT + (16 * dt + fr) * 144 + (32 * s + 8 * g) * 2);
                S[dt] = __builtin_amdgcn_mfma_f32_16x16x32_bf16(a, vb[s], S[dt], 0, 0, 0);
            }
        }
        } else {
#pragma unroll
            for (int i = 0; i < 7; ++i) GS_PF(i);
        }
        if (n < 127) GS_STORE(buf ^ 1, 6);
        __syncthreads();
    }
#undef GS_LOAD
#undef GS_STORE
#undef GS_PF
}

__device__ __forceinline__ void lru_final_unit(const Ctx& P, int l, int unit, int tid, int wave, int lane) {
    const bf16_t* Z = (const bf16_t*)(P.ws() + WS_Z);
    const float* LA = (const float*)(P.ws() + WS_LRUA); const float* LU = (const float*)(P.ws() + WS_LRUU); const float* AGG = (const float*)(P.ws() + WS_LAGG);
    bf16_t* Y = (bf16_t*)(P.ws() + WS_Y);
    const int b = unit >> 7, ck = unit & 127; const size_t m0 = (size_t)b * T + ck * 64; const int ch = tid;
    float h = 0.f;
    for (int j = 0; j < ck; ++j) { const float a = AGG[((size_t)(b * 128 + j) * 2 + 0) * 512 + ch], hh2 = AGG[((size_t)(b * 128 + j) * 2 + 1) * 512 + ch]; h = a * h + hh2; }
    const float gn = P.in(15)[l * 512 + ch];
#pragma unroll 4
    for (int t = 0; t < 64; ++t) {
        const float a = LA[(m0 + t) * 512 + ch], u = LU[(m0 + t) * 512 + ch];
        h = a * h + u;
        const float ss = wave_sum(h * h);
        const float gate = bf2f(Z[(m0 + t) * NZ + ZC_AG + ch]);
        const float y = h * rsqrtf(ss * (1.0f / 64.0f) + EPS) * gn * gelu_tanh(gate);
        Y[(m0 + t) * DM + ch] = (bf16_t)f2bf(y);
    }
}

__device__ __forceinline__ void finalize_phase(const Ctx& P, int l, int wave, int lane, int bid, int nblk) {
    const bf16_t* Z = (const bf16_t*)(P.ws() + WS_Z); const float* OC = (const float*)(P.ws() + WS_OC);
    const bf16_t* OD = (const bf16_t*)(P.ws() + WS_OD); const float* LSE = (const float*)(P.ws() + WS_LSE);
    bf16_t* Y = (bf16_t*)(P.ws() + WS_Y);
    const float gc0 = P.in(14)[l * 128 + 2 * lane], gc1 = P.in(14)[l * 128 + 2 * lane + 1];
    for (int task = bid * 8 + wave; task < M * 4; task += nblk * 8) {
        const size_t m = task >> 2; const int hh = task & 3;
        {
            const float o0 = OC[m * 512 + hh * 128 + 2 * lane], o1 = OC[m * 512 + hh * 128 + 2 * lane + 1];
            const float rn = rsqrtf(wave_sum(o0 * o0 + o1 * o1) * (1.0f / 128.0f) + EPS);
            const unsigned zz = *(const unsigned*)(Z + m * NZ + ZC_CZ + hh * 128 + 2 * lane);
            const float z0 = bflo(zz), z1 = bfhi(zz);
            *(unsigned*)(Y + m * DM + 1024 + hh * 128 + 2 * lane) = pk2(o0 * rn * gc0 * siluf_(z0), o1 * rn * gc1 * siluf_(z1));
        }
        {
            const float l0 = LSE[((size_t)0 * M + m) * 4 + hh], l1 = LSE[((size_t)1 * M + m) * 4 + hh], l2 = LSE[((size_t)2 * M + m) * 4 + hh];
            const float mx = fmaxf(l0, fmaxf(l1, l2));
            float w0 = __expf(l0 - mx), w1 = __expf(l1 - mx), w2 = __expf(l2 - mx);
            const float inv = 1.0f / (w0 + w1 + w2); w0 *= inv; w1 *= inv; w2 *= inv;
            const unsigned a0 = *(const unsigned*)(OD + ((size_t)0 * M + m) * 512 + hh * 128 + 2 * lane);
            const unsigned a1 = *(const unsigned*)(OD + ((size_t)1 * M + m) * 512 + hh * 128 + 2 * lane);
            const unsigned a2 = *(const unsigned*)(OD + ((size_t)2 * M + m) * 512 + hh * 128 + 2 * lane);
            const float o0 = w0 * bflo(a0) + w1 * bflo(a1) + w2 * bflo(a2), o1 = w0 * bfhi(a0) + w1 * bfhi(a1) + w2 * bfhi(a2);
            const float rn = rsqrtf(wave_sum(o0 * o0 + o1 * o1) * (1.0f / 128.0f) + EPS);
            const float g0 = P.in(17)[l * 512 + hh * 128 + 2 * lane], g1 = P.in(17)[l * 512 + hh * 128 + 2 * lane + 1];
            *(unsigned*)(Y + m * DM + 1536 + hh * 128 + 2 * lane) = pk2(o0 * rn * g0, o1 * rn * g1);
        }
    }
}

__device__ __forceinline__ void ffn_act_phase(const Ctx& P, int l, int tid, int bid, int nblk) {
    const bf16_t* U = (const bf16_t*)(P.ws() + WS_U); bf16_t* ACT = (bf16_t*)(P.ws() + WS_ACT);
    const float* cw = P.in(21) + (size_t)l * 3 * NFF2; const float* cb = P.in(22) + (size_t)l * NFF2;
    constexpr int CG = DFF / 8, RUN = 32, NRUN = M / RUN;
    for (int item = bid * NTHR + tid; item < CG * NRUN; item += nblk * NTHR) {
        const int cg8 = item % CG, run = item / CG; const int c0 = cg8 * 8; const size_t mstart = (size_t)run * RUN; const int tin = (int)(mstart % T);
        float wu[3][8], wg[3][8], bu[8], bg[8];
#pragma unroll
        for (int k = 0; k < 3; ++k)
#pragma unroll
            for (int e = 0; e < 8; ++e) { wu[k][e] = cw[k * NFF2 + c0 + e]; wg[k][e] = cw[k * NFF2 + DFF + c0 + e]; }
#pragma unroll
        for (int e = 0; e < 8; ++e) { bu[e] = cb[c0 + e]; bg[e] = cb[DFF + c0 + e]; }
        u32x4 u2 = {0, 0, 0, 0}, u1 = {0, 0, 0, 0}, g2 = {0, 0, 0, 0}, g1 = {0, 0, 0, 0};
        if (tin > 0) {
            u2 = *(const u32x4*)(U + (mstart - 2) * NFF2 + c0); u1 = *(const u32x4*)(U + (mstart - 1) * NFF2 + c0);
            g2 = *(const u32x4*)(U + (mstart - 2) * NFF2 + DFF + c0); g1 = *(const u32x4*)(U + (mstart - 1) * NFF2 + DFF + c0);
        }
        for (int t = 0; t < RUN; ++t) {
            const u32x4 u0 = *(const u32x4*)(U + (mstart + t) * NFF2 + c0), g0 = *(const u32x4*)(U + (mstart + t) * NFF2 + DFF + c0);
            float r[8];
#pragma unroll
            for (int q = 0; q < 4; ++q) {
                const float up0 = bu[2 * q] + wu[0][2 * q] * bflo(u2[q]) + wu[1][2 * q] * bflo(u1[q]) + wu[2][2 * q] * bflo(u0[q]);
                const float up1 = bu[2 * q + 1] + wu[0][2 * q + 1] * bfhi(u2[q]) + wu[1][2 * q + 1] * bfhi(u1[q]) + wu[2][2 * q + 1] * bfhi(u0[q]);
                const float ga0 = bg[2 * q] + wg[0][2 * q] * bflo(g2[q]) + wg[1][2 * q] * bflo(g1[q]) + wg[2][2 * q] * bflo(g0[q]);
                const float ga1 = bg[2 * q + 1] + wg[0][2 * q + 1] * bfhi(g2[q]) + wg[1][2 * q + 1] * bfhi(g1[q]) + wg[2][2 * q + 1] * bfhi(g0[q]);
                r[2 * q] = siluf_(ga0) * up0; r[2 * q + 1] = siluf_(ga1) * up1;
            }
            u32x4 o; o.x = pk2(r[0], r[1]); o.y = pk2(r[2], r[3]); o.z = pk2(r[4], r[5]); o.w = pk2(r[6], r[7]);
            *(u32x4*)(ACT + (mstart + t) * DFF + c0) = o;
            u2 = u1; u1 = u0; g2 = g1; g1 = g0;
        }
    }
}

#ifndef N_LAYERS_RUN
#define N_LAYERS_RUN DEPTH
#endif
constexpr int D_NUNITS = 32 + 256 + 768 + 256;

__global__ void __launch_bounds__(NTHR, 2) fwd_megakernel(Params KP) {
    extern __shared__ __attribute__((aligned(16))) unsigned char lds_raw[];
    LAS unsigned char* lds0 = (LAS unsigned char*)lds_raw;
    cg::grid_group grid = cg::this_grid();
    const int tid = threadIdx.x, lane = tid & 63, wave = __builtin_amdgcn_readfirstlane(tid >> 6);
    const int bid = blockIdx.x, nblk = gridDim.x;
    volatile LAS int* misc = (volatile LAS int*)(lds0 + LDS_MISC);
    if (threadIdx.x < 16) misc[threadIdx.x] = 0;
    __syncthreads();
    XcdBarrier xbar = xcd_barrier_post((unsigned*)(KP.ws + WS_CTL) + 4096, (volatile LAS unsigned*)(lds0 + LDS_MISC) + 8);
    {
        LAS unsigned long long* tabw = (LAS unsigned long long*)(lds0 + LDS_MISC + 64);
        if (threadIdx.x == 0) {
#pragma unroll
            for (int i = 0; i < 25; ++i) tabw[i] = (unsigned long long)KP.in[i];
            tabw[25] = (unsigned long long)KP.out; tabw[26] = (unsigned long long)KP.ws;
        }
        __syncthreads();
    }
    Ctx P; P.tab = (const LAS unsigned*)(lds0 + LDS_MISC + 64);
#define WSP (P.ws())
#define XP (P.out())

#ifdef DUP_SYNC
#define GSYNC() do { grid.sync(); grid.sync(); } while (0)
#else
#define GSYNC() xcd_barrier(xbar)
#endif
#ifndef SK_P0
    p0_prologue(P, lds0, bid * 8 + wave, nblk * 8, wave, lane);
#ifdef DUP_P0
    __syncthreads();
    p0_prologue(P, lds0, bid * 8 + wave, nblk * 8, wave, lane);
#endif
#endif
    grid.sync();

    for (int l0 = 0; l0 < N_LAYERS_RUN; ++l0) {
#define FRESH() LAS unsigned char* lds = lds0; asm volatile("" : "+v"(lds)); int l = l0; asm volatile("" : "+s"(l)); int tid = threadIdx.x; asm volatile("" : "+v"(tid)); const int lane = tid & 63, wave = __builtin_amdgcn_readfirstlane(tid >> 6); (void)lane; (void)wave; (void)l;
#ifndef SK_A
        { FRESH()
        norm_phase<true>(l == 0 ? P.in(0) : XP, l == 0 ? XP : nullptr, P.in(1) + l * DM, (bf16_t*)(WSP + WS_HB), (const float*)(WSP + WS_WG) + (size_t)l * 12 * DM,
                         (float*)(WSP + WS_GL), lds, tid, wave, lane, bid, nblk);
#ifdef DUP_A
        norm_phase<true>(l == 0 ? P.in(0) : XP, l == 0 ? XP : nullptr, P.in(1) + l * DM, (bf16_t*)(WSP + WS_HB), (const float*)(WSP + WS_WG) + (size_t)l * 12 * DM, (float*)(WSP + WS_GL), lds, tid, wave, lane, bid, nblk);
#endif
        }
#endif
        GSYNC();
#ifndef SK_B
        { FRESH()
            pg8::Gemm g{(const bf16_t*)(WSP + WS_HB), (const bf16_t*)(WSP + WS_WIN) + (size_t)l * NZ * DM, M, NZ, DM};
            pg8::StaticOrder S; S.init(M, NZ, nblk, bid);
            pg8::EpiBf16<0> E{(bf16_t*)(WSP + WS_Z), NZ, nullptr, 0, 0, 1.f};
            pg8::gemm_phase<pg8::EpiBf16<0>, pg8::StaticOrder, true, true>(lds, g, S, E);
#ifdef DUP_B
            __syncthreads();
            pg8::gemm_phase<pg8::EpiBf16<0>, pg8::StaticOrder, true, true>(lds, g, S, E);
#endif
        }
#endif
        GSYNC();
#ifdef DUP_C
        for (int pass = 0; pass < 2; ++pass)
#endif
        for (int u = bid; u < 1024 + 256 + 8; u += nblk) { FRESH()
#ifndef SK_C3
            if (u < 1024) gdn_prep_unit(P, l, u, lds, tid, wave, lane); else
#endif
#ifndef SK_C1
            if (u >= 1024 && u < 1280) { __syncthreads(); lru_chunk_unit(P, l, u - 1024, lds, tid, wave, lane); __syncthreads(); } else
#endif
#ifndef SK_C2
            if (u >= 1280) fox_cumsum_unit(P, l, u - 1280, lds, tid, wave, lane);
#else
            {}
#endif
        }
        GSYNC();
        {
#ifdef DUP_D
            for (int pass = 0; pass < 2; ++pass) {
            unsigned* ctr = (unsigned*)(WSP + WS_CTL) + 64 * (1 + l0) + 16 * pass;
#else
            {
            unsigned* ctr = (unsigned*)(WSP + WS_CTL) + 64 * (1 + l0);
#endif
            for (;;) {
                __syncthreads();
                if (threadIdx.x == 0) misc[0] = (int)atomicAdd(ctr, 1u);
                __syncthreads();
                const int u = misc[0];
                if (u >= D_NUNITS) break;
                FRESH()
#ifndef SK_D1
                if (u < 32) gdn_seq_unit(P, l, u, lds, tid, wave, lane); else
#endif
#ifndef SK_D2
                if (u >= 32 && u < 288) { const int i = u - 32; attn_unit<0>(P, l, lds, tid, wave, lane, (i & 7) >> 2, i & 3, 1, 0, (31 - (i >> 3)) * 256, 0); } else
#endif
#ifndef SK_D3
                if (u >= 288 && u < 1056) {
                    const int i = u - 288; const int bh = i & 7, j = i >> 3;
                    const int br = j >> 5, k = j & 31;
                    const int dil = (br == 0) ? 1 : (br == 1 ? 4 : 16);
                    const int nqb = 32 / dil;
                    const int res = k / nqb, qb = k % nqb;
                    attn_unit<1>(P, l, lds, tid, wave, lane, bh >> 2, bh & 3, dil, res, qb * 256, br);
                } else
#endif
#ifndef SK_D4
                if (u >= 1056) lru_final_unit(P, l, u - 1056, tid, wave, lane);
#else
                {}
#endif
            }
            }
        }
        GSYNC();
#ifndef SK_E
        { FRESH() finalize_phase(P, l, wave, lane, bid, nblk);
#ifdef DUP_E
          finalize_phase(P, l, wave, lane, bid, nblk);
#endif
        }
#endif
        GSYNC();
#ifndef SK_F
        { FRESH()
            pg8::Gemm g{(const bf16_t*)(WSP + WS_Y), (const bf16_t*)(WSP + WS_WOUT) + (size_t)l * DM * DM, M, DM, DM};
            pg8::StaticOrder S; S.init(M, DM, nblk, bid);
            EpiResAdd E{XP, DM};
            pg8::gemm_phase<EpiResAdd, pg8::StaticOrder, true, true>(lds, g, S, E);
#ifdef DUP_F
            __syncthreads();
            EpiResAdd E2{(float*)(WSP + WS_ACT), DM};
            pg8::gemm_phase<EpiResAdd, pg8::StaticOrder, true, true>(lds, g, S, E2);
#endif
        }
#endif
        GSYNC();
#ifndef SK_G
        { FRESH() norm_phase<false>(XP, nullptr, P.in(19) + l * DM, (bf16_t*)(WSP + WS_HB), nullptr, nullptr, lds, tid, wave, lane, bid, nblk);
#ifdef DUP_G
          norm_phase<false>(XP, nullptr, P.in(19) + l * DM, (bf16_t*)(WSP + WS_HB), nullptr, nullptr, lds, tid, wave, lane, bid, nblk);
#endif
        }
#endif
        GSYNC();
#ifndef SK_H
        { FRESH()
            pg8::Gemm g{(const bf16_t*)(WSP + WS_HB), (const bf16_t*)(WSP + WS_WUP) + (size_t)l * NFF2 * DM, M, NFF2, DM};
            pg8::StaticOrder S; S.init(M, NFF2, nblk, bid);
            pg8::EpiBf16<0> E{(bf16_t*)(WSP + WS_U), NFF2, nullptr, 0, 0, 1.f};
            pg8::gemm_phase<pg8::EpiBf16<0>, pg8::StaticOrder, true, true>(lds, g, S, E);
#ifdef DUP_H
            __syncthreads();
            pg8::gemm_phase<pg8::EpiBf16<0>, pg8::StaticOrder, true, true>(lds, g, S, E);
#endif
        }
#endif
        GSYNC();
#ifndef SK_I
        { FRESH() ffn_act_phase(P, l, tid, bid, nblk);
#ifdef DUP_I
          ffn_act_phase(P, l, tid, bid, nblk);
#endif
        }
#endif
        GSYNC();
#ifndef SK_J
        { FRESH()
            pg8::Gemm g{(const bf16_t*)(WSP + WS_ACT), (const bf16_t*)(WSP + WS_WDN) + (size_t)l * DM * DFF, M, DM, DFF};
            pg8::StaticOrder S; S.init(M, DM, nblk, bid);
            EpiResAdd E{XP, DM};
            pg8::gemm_phase<EpiResAdd, pg8::StaticOrder, true, true>(lds, g, S, E);
#ifdef DUP_J
            __syncthreads();
            EpiResAdd E2{(float*)(WSP + WS_Z), DM};
            pg8::gemm_phase<EpiResAdd, pg8::StaticOrder, true, true>(lds, g, S, E2);
#endif
        }
#endif
        GSYNC();
    }
#ifndef SK_FN
    { int tid = threadIdx.x; asm volatile("" : "+v"(tid)); const int lane = tid & 63, wave = __builtin_amdgcn_readfirstlane(tid >> 6);
      final_norm_phase(XP, P.in(24), wave, lane, bid, nblk); }
#endif
}

extern "C" void kernel_launch(void* const* d_in, const int* in_sizes, int n_in, void* d_out, int out_size, void* d_ws, size_t ws_size, hipStream_t stream) {
    static int grid_blocks = 0;
    if (grid_blocks == 0) {
        if (n_in != 25 || ws_size < WS_END) { fprintf(stderr, "kernel_launch: unexpected inputs (n_in %d, ws %zu < %zu)\n", n_in, ws_size, (size_t)WS_END); grid_blocks = -1; return; }
        int dev = 0, cus = 0, per_cu = 0;
        (void)hipGetDevice(&dev);
        (void)hipDeviceGetAttribute(&cus, hipDeviceAttributeMultiprocessorCount, dev);
        if (hipFuncSetAttribute((const void*)fwd_megakernel, hipFuncAttributeMaxDynamicSharedMemorySize, LDS_BYTES) != hipSuccess) { fprintf(stderr, "kernel_launch: hipFuncSetAttribute failed\n"); grid_blocks = -1; return; }
        if (hipOccupancyMaxActiveBlocksPerMultiprocessor(&per_cu, (const void*)fwd_megakernel, NTHR, LDS_BYTES) != hipSuccess || per_cu < 1) { fprintf(stderr, "kernel_launch: occupancy query says %d\n", per_cu); per_cu = 1; }
        (void)hipGetLastError();
        grid_blocks = cus * per_cu;
        if (grid_blocks > 256) grid_blocks = 256;
    }
    if (grid_blocks < 0) return;
    (void)hipMemsetAsync((char*)d_ws + WS_CTL, 0, 65536, stream);
    Params p{};
    for (int i = 0; i < 25; ++i) p.in[i] = (const float*)d_in[i];
    p.out = (float*)d_out; p.ws = (unsigned char*)d_ws;
    void* args[] = {&p};
    hipError_t e = hipLaunchCooperativeKernel((const void*)fwd_megakernel, dim3(grid_blocks), dim3(NTHR), args, LDS_BYTES, stream);
    if (e != hipSuccess) fprintf(stderr, "cooperative launch failed: %s (grid %d)\n", hipGetErrorString(e), grid_blocks);
}
```

```cpp
#include <hip/hip_runtime.h>
#include <hip/hip_cooperative_groups.h>
#include <cstdio>
#include <cstdint>
namespace cg = cooperative_groups;
namespace pg8 {
#define PG8_LAS __attribute__((address_space(3)))
typedef unsigned short bf16_t;
typedef short bf16x8 __attribute__((ext_vector_type(8)));
typedef float f32x4 __attribute__((ext_vector_type(4)));
typedef unsigned u32x4 __attribute__((ext_vector_type(4)));
constexpr int BM = 256, BK = 64, HALF = 128, HTB = HALF * BK * 2  , STAGE_BYTES = 8 * HTB, NXCD = 8, WGM = 8;

__host__ __device__ __forceinline__ int lds_byte(int r, int c) { const int st = (r >> 4) * 2 + (c >> 5), rr = r & 15, cc = c & 31, ob = rr * 64 + cc * 2; return st * 1024 + (ob ^ (((ob >> 9) & 1) << 5)); }
__host__ __device__ __forceinline__ void stage_rc(int b, int& R, int& C) { const int st = b / 1024, sb = b % 1024, swz = sb ^ (((sb >> 9) & 1) << 5); R = (st >> 1) * 16 + swz / 64; C = (st & 1) * 32 + (swz % 64) / 2; }
__host__ __device__ __forceinline__ int perm32(int rho) { const int n = rho >> 4, i = rho & 15; return 8 * (i >> 2) + 4 * n + (i & 3); }

struct Unit { int pm, pn; };
struct Gemm { const bf16_t* A; const bf16_t* Bt; int M, N, K; };

struct StaticOrder {
    int nM, nN, nwg, G, c;
    __host__ __device__ void init(int M, int N, int G_, int c_) { nM = M / BM; nN = N / BM; nwg = nM * nN; G = G_; c = c_; }
    __host__ __device__ bool next(int i, Unit& u) const {
        const long L = (long)i * G + c; if (L >= nwg) return false;
        int wgid = (int)L; { const int q = nwg / NXCD, r = nwg % NXCD, xcd = wgid % NXCD, off = wgid / NXCD; wgid = (xcd < r ? xcd * (q + 1) : r * (q + 1) + (xcd - r) * q) + off; }
        const int nig = WGM * nN, gid = wgid / nig, fm = gid * WGM, gsz = (nM - fm) < WGM ? (nM - fm) : WGM;
        u.pm = fm + ((wgid % nig) % gsz); u.pn = (wgid % nig) / gsz; return true;
    }
    __device__ __forceinline__ void a_ready(const Unit&) const {}
    __device__ __forceinline__ void done(const Unit&) const {}
};

__device__ __forceinline__ unsigned cvt_pk_bf16(float lo, float hi) { unsigned r; asm volatile("v_cvt_pk_bf16_f32 %0, %1, %2" : "=v"(r) : "v"(lo), "v"(hi)); return r; }
typedef float f32x2 __attribute__((ext_vector_type(2)));
__device__ __forceinline__ f32x2 gelu_pk(f32x2 v) {
    const f32x2 av = __builtin_elementwise_abs(v), d = av * 0.2316418882f + 1.0f;
    f32x2 t; t.x = __builtin_amdgcn_rcpf(d.x); t.y = __builtin_amdgcn_rcpf(d.y);
    f32x2 q = t * 0.5307027145f + (-0.7265760135f); q = q * t + 0.7107068705f; q = q * t + (-0.142248368f); q = q * t + 0.127414796f; q = q * t;
    const f32x2 s = (v * v) * (-0.72134752044f);
    f32x2 e; e.x = __builtin_amdgcn_exp2f(s.x); e.y = __builtin_amdgcn_exp2f(s.y);
    const f32x2 m = v * (q * e), r = v - m;
    f32x2 o; o.x = v.x < 0.f ? m.x : r.x; o.y = v.y < 0.f ? m.y : r.y; return o;
}

template <int ACT  > struct EpiBf16 {
    static constexpr bool PERM = true, AFTER_DRAIN = false; static_assert(ACT == 0 || ACT == 1, "EpiBf16: ACT is 0 (none) or 1 (gelu_pk)");
    bf16_t* O; int ldc; const float* bias; int split_cols; size_t split_stride; float scale0;
    __device__ __forceinline__ void operator()(const f32x4 (&acc)[2][2][4][2], const Unit& u, int wr, int wc, int fr, int fq) const {
        const int row0 = u.pm * BM + wr * 64 + fr; int colt = u.pn * BM; bf16_t* base = O;
        float sc = 1.f; if (split_cols) { const int t = colt / split_cols; base += (size_t)t * split_stride; colt -= t * split_cols; if (t == 0) sc = scale0; }
        const int col0 = colt + wc * 32 + 8 * fq, bcol0 = u.pn * BM + wc * 32 + 8 * fq;
        f32x4 bv[2][2];
#pragma unroll
        for (int bj = 0; bj < 2; ++bj)
#pragma unroll
            for (int n = 0; n < 2; ++n) bv[bj][n] = bias ? *(const f32x4*)(bias + bcol0 + bj * HALF + 4 * n) : (f32x4){0.f, 0.f, 0.f, 0.f};
#pragma unroll
        for (int ai = 0; ai < 2; ++ai)
#pragma unroll
            for (int m = 0; m < 4; ++m) { bf16_t* rowp = base + (size_t)(row0 + ai * HALF + m * 16) * ldc + col0;
#pragma unroll
                for (int bj = 0; bj < 2; ++bj) { f32x4 v0 = acc[ai][bj][m][0] + bv[bj][0], v1 = acc[ai][bj][m][1] + bv[bj][1];
                    if (ACT == 1) { f32x2 a = gelu_pk((f32x2){v0[0], v0[1]}), b = gelu_pk((f32x2){v0[2], v0[3]}), c = gelu_pk((f32x2){v1[0], v1[1]}), d = gelu_pk((f32x2){v1[2], v1[3]});
                        v0 = (f32x4){a.x, a.y, b.x, b.y}; v1 = (f32x4){c.x, c.y, d.x, d.y}; }
                    v0 = v0 * sc; v1 = v1 * sc; u32x4 w; w.x = cvt_pk_bf16(v0[0], v0[1]); w.y = cvt_pk_bf16(v0[2], v0[3]); w.z = cvt_pk_bf16(v1[0], v1[1]); w.w = cvt_pk_bf16(v1[2], v1[3]);
                    *(u32x4*)(rowp + bj * HALF) = w; } }
    }
};
template <class Epi, class Sched, bool ALIGN_EPI = false, bool SP2 = false>
__device__ __forceinline__ void gemm_phase(PG8_LAS unsigned char* lds, const Gemm g, const Sched& S, const Epi& E) {
    int tid_l = threadIdx.x; asm volatile("" : "+v"(tid_l)); const int tid = tid_l, wid = __builtin_amdgcn_readfirstlane(tid >> 6), lane = tid & 63, wr = wid >> 2, wc = wid & 3, fr = lane & 15, fq = lane >> 4;
    const int K = g.K, nt = K / BK;
    unsigned voffA[2], voffB[2];
#pragma unroll
    for (int i = 0; i < 2; ++i) { int R, C; stage_rc(tid * 16 + i * 8192, R, C); const int Rb = Epi::PERM ? ((R & ~31) + perm32(R & 31)) : R;
        voffA[i] = (unsigned)(R * K + C) * 2u; voffB[i] = (unsigned)(Rb * K + C) * 2u; }
    const size_t kstep = (size_t)(BK * 2);
    const size_t hstep = (size_t)HALF * K * 2;
    const size_t tstep = 2 * hstep;
    const unsigned ldsw = (unsigned)wid * 1024u;
    const int aoff = lds_byte(wr * 64 + fr, fq * 8), boff = lds_byte(wc * 32 + fr, fq * 8);
#define PG8_SA(b, h) (((b) * 2 + (h)) * HTB)
#define PG8_SB(b, h) ((4 + (b) * 2 + (h)) * HTB)
#define PG8_STAGE(bufoff, gbase, voff) do { _Pragma("unroll") for (int _i = 0; _i < 2; ++_i) \
        __builtin_amdgcn_global_load_lds((const unsigned*)((const char*)(gbase) + (voff)[_i]), (PG8_LAS unsigned*)(lds + (bufoff) + ldsw + _i * 8192), 16, 0, 0); } while (0)
#define PG8_LDA(dst, b, h) do { _Pragma("unroll") for (int m = 0; m < 4; ++m) _Pragma("unroll") for (int k = 0; k < 2; ++k) dst[m][k] = *(const PG8_LAS bf16x8*)(lds + PG8_SA(b, h) + aoff + m * 2048 + k * 1024); } while (0)
#define PG8_LDB(dst, b, h) do { _Pragma("unroll") for (int n = 0; n < 2; ++n) _Pragma("unroll") for (int k = 0; k < 2; ++k) dst[n][k] = *(const PG8_LAS bf16x8*)(lds + PG8_SB(b, h) + boff + n * 2048 + k * 1024); } while (0)
#define PG8_MMA(ai, bj, At, Bt) do { __builtin_amdgcn_s_setprio(1); _Pragma("unroll") for (int m = 0; m < 4; ++m) _Pragma("unroll") for (int n = 0; n < 2; ++n) _Pragma("unroll") for (int k = 0; k < 2; ++k) \
        acc[ai][bj][m][n] = __builtin_amdgcn_mfma_f32_16x16x32_bf16(Bt[n][k], At[m][k], acc[ai][bj][m][n], 0, 0, 0); __builtin_amdgcn_s_setprio(0); } while (0)
#define PG8_WAIT_V(n) asm volatile("s_waitcnt vmcnt(" #n ")" ::: "memory")
#define PG8_WAIT_L(n) asm volatile("s_waitcnt lgkmcnt(" #n ")" ::: "memory")
#define PG8_BAR __builtin_amdgcn_s_barrier()
#define PG8_SCHED __builtin_amdgcn_sched_barrier(0)
    Unit cur, nxt; int ui = 0;
    if (!S.next(0, cur)) return;
    f32x4 acc[2][2][4][2];
#pragma unroll
    for (int a = 0; a < 2; ++a)
#pragma unroll
        for (int b = 0; b < 2; ++b)
#pragma unroll
            for (int m = 0; m < 4; ++m)
#pragma unroll
                for (int n = 0; n < 2; ++n) acc[a][b][m][n] = (f32x4){0.f, 0.f, 0.f, 0.f};
    bf16x8 At[4][2], B0[2][2], B1[2][2];
    const char* cA = (const char*)g.A + (size_t)cur.pm * tstep; const char* cB = (const char*)g.Bt + (size_t)cur.pn * tstep;
    S.a_ready(cur);
    if constexpr (SP2) {
        PG8_STAGE(PG8_SB(0, 0), cB, voffB); PG8_STAGE(PG8_SB(0, 1), cB + hstep, voffB); PG8_STAGE(PG8_SA(0, 0), cA, voffA); PG8_STAGE(PG8_SA(0, 1), cA + hstep, voffA);
        if (wr == 1) PG8_BAR;
        PG8_WAIT_V(2); PG8_BAR;
        PG8_STAGE(PG8_SB(1, 0), cB + kstep, voffB); PG8_STAGE(PG8_SA(1, 0), cA + kstep, voffA); PG8_STAGE(PG8_SB(1, 1), cB + hstep + kstep, voffB);
        PG8_WAIT_V(6); PG8_BAR;
    } else {
        PG8_STAGE(PG8_SB(0, 0), cB, voffB); PG8_STAGE(PG8_SA(0, 0), cA, voffA); PG8_STAGE(PG8_SB(0, 1), cB + hstep, voffB); PG8_STAGE(PG8_SA(0, 1), cA + hstep, voffA);
        if (wr == 1) PG8_BAR;
        PG8_WAIT_V(4); PG8_BAR;
        PG8_STAGE(PG8_SB(1, 0), cB + kstep, voffB); PG8_STAGE(PG8_SA(1, 0), cA + kstep, voffA); PG8_STAGE(PG8_SB(1, 1), cB + hstep + kstep, voffB);
        PG8_WAIT_V(6); PG8_BAR;
    }
    for (;;) {
        const bool has_next = S.next(ui + 1, nxt);
        const char* nA = has_next ? (const char*)g.A + (size_t)nxt.pm * tstep : cA; const char* nB = has_next ? (const char*)g.Bt + (size_t)nxt.pn * tstep : cB;
        for (int t = 0; t < nt; t += 2) {
            const bool last = (t == nt - 2);
            const char* a1 = cA + (size_t)(t + 1) * kstep;
            const char* a2 = last ? nA : cA + (size_t)(t + 2) * kstep; const char* b2 = last ? nB : cB + (size_t)(t + 2) * kstep;
            const char* a3 = a2 + kstep; const char* b3 = b2 + kstep;
            if (last && has_next) S.a_ready(nxt);
            if constexpr (SP2) {
            PG8_LDB(B0, 0, 0); PG8_LDB(B1, 0, 1); PG8_SCHED; PG8_LDA(At, 0, 0); PG8_STAGE(PG8_SA(1, 1), a1 + hstep, voffA);
            PG8_WAIT_V(8); PG8_WAIT_L(0); PG8_BAR; PG8_MMA(0, 0, At, B0); PG8_MMA(0, 1, At, B1); PG8_BAR; PG8_SCHED;
            PG8_LDA(At, 0, 1); PG8_STAGE(PG8_SB(0, 0), b2, voffB); PG8_STAGE(PG8_SB(0, 1), b2 + hstep, voffB); PG8_STAGE(PG8_SA(0, 0), a2, voffA);
            PG8_WAIT_V(8); PG8_WAIT_L(0); PG8_BAR; PG8_MMA(1, 0, At, B0); PG8_MMA(1, 1, At, B1); PG8_BAR; PG8_SCHED;
            PG8_LDB(B0, 1, 0); PG8_LDB(B1, 1, 1); PG8_SCHED; PG8_LDA(At, 1, 0); PG8_STAGE(PG8_SA(0, 1), a2 + hstep, voffA);
            PG8_WAIT_V(8); PG8_WAIT_L(0); PG8_BAR; PG8_MMA(0, 0, At, B0); PG8_MMA(0, 1, At, B1); PG8_BAR; PG8_SCHED;
            PG8_LDA(At, 1, 1); PG8_STAGE(PG8_SB(1, 0), b3, voffB); PG8_STAGE(PG8_SB(1, 1), b3 + hstep, voffB); PG8_STAGE(PG8_SA(1, 0), a3, voffA);
            PG8_WAIT_V(8); PG8_WAIT_L(0); PG8_BAR; PG8_MMA(1, 0, At, B0); PG8_MMA(1, 1, At, B1); PG8_BAR; PG8_SCHED;
            } else {
            PG8_LDB(B0, 0, 0); PG8_SCHED; PG8_LDA(At, 0, 0); PG8_STAGE(PG8_SA(1, 1), a1 + hstep, voffA);
            PG8_WAIT_L(8); PG8_BAR; PG8_WAIT_L(0); PG8_MMA(0, 0, At, B0); PG8_BAR; PG8_SCHED;
            PG8_LDB(B1, 0, 1); PG8_STAGE(PG8_SB(0, 0), b2, voffB);
            PG8_BAR; PG8_WAIT_L(0); PG8_MMA(0, 1, At, B1); PG8_BAR;
            PG8_LDA(At, 0, 1); PG8_STAGE(PG8_SA(0, 0), a2, voffA);
            PG8_BAR; PG8_WAIT_L(0); PG8_MMA(1, 0, At, B0); PG8_BAR; PG8_SCHED;
            PG8_STAGE(PG8_SB(0, 1), b2 + hstep, voffB);
            PG8_WAIT_V(6); PG8_BAR; PG8_MMA(1, 1, At, B1); PG8_BAR;
            PG8_LDB(B0, 1, 0); PG8_SCHED; PG8_LDA(At, 1, 0); PG8_STAGE(PG8_SA(0, 1), a2 + hstep, voffA);
            PG8_WAIT_L(8); PG8_BAR; PG8_WAIT_L(0); PG8_MMA(0, 0, At, B0); PG8_BAR; PG8_SCHED;
            PG8_LDB(B1, 1, 1); PG8_STAGE(PG8_SB(1, 0), b3, voffB);
            PG8_BAR; PG8_WAIT_L(0); PG8_MMA(0, 1, At, B1); PG8_BAR;
            PG8_LDA(At, 1, 1); PG8_STAGE(PG8_SA(1, 0), a3, voffA);
            PG8_BAR; PG8_WAIT_L(0); PG8_MMA(1, 0, At, B0); PG8_BAR; PG8_SCHED;
            PG8_STAGE(PG8_SB(1, 1), b3 + hstep, voffB);
            PG8_WAIT_V(6); PG8_BAR; PG8_MMA(1, 1, At, B1); PG8_BAR;
            }
        }
        if constexpr (ALIGN_EPI) { if (wr == 0) PG8_BAR; }
        if constexpr (!Epi::AFTER_DRAIN) { E(acc, cur, wr, wc, fr, fq); S.done(cur); }
        if (!has_next) break;
#pragma unroll
        for (int a = 0; a < 2; ++a)
#pragma unroll
            for (int b = 0; b < 2; ++b)
#pragma unroll
                for (int m = 0; m < 4; ++m)
#pragma unroll
                    for (int n = 0; n < 2; ++n) acc[a][b][m][n] = (f32x4){0.f, 0.f, 0.f, 0.f};
        cur = nxt; cA = nA; cB = nB; ++ui;
        if constexpr (ALIGN_EPI) { if (wr == 1) PG8_BAR; }
    }
    PG8_WAIT_V(0);
    if constexpr (!ALIGN_EPI) { if (wr == 0) PG8_BAR; }
    PG8_BAR;
    if constexpr (Epi::AFTER_DRAIN) { E.fused(acc, cur, wr, wc, fr, fq, lds, wid, lane); S.done(cur); }
#undef PG8_SA
#undef PG8_SB
#undef PG8_STAGE
#undef PG8_LDA
#undef PG8_LDB
#undef PG8_MMA
#undef PG8_WAIT_V
#undef PG8_WAIT_L
#undef PG8_BAR
#undef PG8_SCHED
}
}

#define LAS __attribute__((address_space(3)))
typedef unsigned short bf16_t;
typedef short bf16x8 __attribute__((ext_vector_type(8)));
typedef short s16x4 __attribute__((ext_vector_type(4)));
typedef float f32x4 __attribute__((ext_vector_type(4)));
typedef float f32x16 __attribute__((ext_vector_type(16)));
typedef unsigned u32x4 __attribute__((ext_vector_type(4)));
typedef unsigned u32x2 __attribute__((ext_vector_type(2)));

constexpr int NB = 2, T = 8192, M = NB * T, DM = 2048, NZ = 6144, DFF = 5632, NFF2 = 11264, DEPTH = 4;
constexpr int WIN_COLS = 6156;
constexpr int ZC_AX = 0, ZC_AG = 512, ZC_BQ = 1024, ZC_BK = 1536, ZC_BV = 2048, ZC_CQ = 2560, ZC_CZ = 4096, ZC_DQ = 4608, ZC_DK = 5120, ZC_DV = 5632;
constexpr float EPS = 1e-6f;
constexpr int NTHR = 512;

constexpr size_t MiB = 1u << 20;
constexpr size_t WS_CTL = 0, WS_WIN = 1 * MiB, WS_WOUT = 97 * MiB, WS_WUP = 129 * MiB, WS_WDN = 305 * MiB, WS_WG = 393 * MiB, WS_HB = 394 * MiB, WS_ACT = 458 * MiB;
constexpr size_t WS_Z = 634 * MiB, WS_Y = 826 * MiB, WS_GL = 890 * MiB, WS_FOXC = 891 * MiB, WS_LRUA = 892 * MiB, WS_LRUU = 924 * MiB, WS_LAGG = 956 * MiB;
constexpr size_t WS_GREC = 957 * MiB, WS_GU = 1013 * MiB, WS_GLAST = 1045 * MiB, WS_OC = 1046 * MiB, WS_OD = 1078 * MiB, WS_LSE = 1126 * MiB, WS_END = 1127 * MiB;
constexpr size_t WS_U = 634 * MiB;
constexpr int GREC_BYTES = 57344;

constexpr int LDS_BYTES = 147456;
constexpr int LDS_MISC = 140 * 1024;

__device__ __forceinline__ unsigned f2bf(float f) { unsigned u = __builtin_bit_cast(unsigned, f); return (u + 0x7fffu + ((u >> 16) & 1u)) >> 16; }
typedef float f32x2_t __attribute__((ext_vector_type(2))); typedef __bf16 bf16x2_t __attribute__((ext_vector_type(2)));
__device__ __forceinline__ unsigned pk2(float lo, float hi) { const f32x2_t v = {lo, hi}; const bf16x2_t b = __builtin_convertvector(v, bf16x2_t); return __builtin_bit_cast(unsigned, b); }
__device__ __forceinline__ float bf2f(unsigned short u) { return __builtin_bit_cast(float, (unsigned)u << 16); }
__device__ __forceinline__ float bflo(unsigned w) { return __builtin_bit_cast(float, w << 16); }
__device__ __forceinline__ float bfhi(unsigned w) { return __builtin_bit_cast(float, w & 0xffff0000u); }
__device__ __forceinline__ float wave_sum(float v) {
#pragma unroll
    for (int o = 1; o < 64; o <<= 1) v += __shfl_xor(v, o);
    return v;
}
__device__ __forceinline__ float sigmoidf_(float x) { return 1.0f / (1.0f + __expf(-x)); }
__device__ __forceinline__ float siluf_(float x) { return x / (1.0f + __expf(-x)); }
__device__ __forceinline__ float softplusf_(float x) { return fmaxf(x, 0.f) + log1pf(__expf(-fabsf(x))); }
__device__ __forceinline__ float gelu_tanh(float x) { const float u = 0.7978845608028654f * (x + 0.044715f * x * x * x); return 0.5f * x * (1.0f + tanhf(u)); }
__device__ __forceinline__ int perm32(int p) { const int g = p >> 3, j = p & 7; return (j < 4) ? (4 * g + j) : (16 + 4 * g + (j - 4)); }
__device__ __forceinline__ int invperm32(int x) { return (x < 16) ? (8 * (x >> 2) + (x & 3)) : (8 * ((x - 16) >> 2) + 4 + (x & 3)); }

struct Params {
    const float* in[25];
    float* out;
    unsigned char* ws;
};
struct Ctx {
    const LAS unsigned* tab;
    __device__ __forceinline__ unsigned long long ld(int i) const {
        const LAS unsigned* t = tab; asm volatile("" : "+v"(t));
        const unsigned lo = __builtin_amdgcn_readfirstlane(t[2 * i]), hi = __builtin_amdgcn_readfirstlane(t[2 * i + 1]);
        return ((unsigned long long)hi << 32) | lo;
    }
    __device__ __forceinline__ const float* in(int i) const { return (const float*)ld(i); }
    __device__ __forceinline__ float* out() const { return (float*)ld(25); }
    __device__ __forceinline__ unsigned char* ws() const { return (unsigned char*)ld(26); }
};

__device__ __forceinline__ void p0_item(const float* W, int ldw, int ncol0, bf16_t* WT, int K, int nrow0, int k0, LAS float* scr, int lane) {
    {
        const int row = lane >> 4, c4 = (lane & 15) * 4;
        const float* src = W + (size_t)(k0 + row) * ldw + ncol0 + c4;
#pragma unroll
        for (int i = 0; i < 16; ++i) {
            const f32x4 v = *(const f32x4*)(src + (size_t)(4 * i) * ldw);
            LAS float* d = scr + (4 * i + row) * 65 + c4;
            d[0] = v.x; d[1] = v.y; d[2] = v.z; d[3] = v.w;
        }
    }
    asm volatile("s_waitcnt lgkmcnt(0)" ::: "memory");
    const int c = lane & 7, ns = lane >> 3;
#pragma unroll
    for (int j = 0; j < 8; ++j) {
        const int n = ns + 8 * j; const LAS float* s = scr + (8 * c) * 65 + n;
        u32x4 o; o.x = pk2(s[0 * 65], s[1 * 65]); o.y = pk2(s[2 * 65], s[3 * 65]); o.z = pk2(s[4 * 65], s[5 * 65]); o.w = pk2(s[6 * 65], s[7 * 65]);
        *(u32x4*)(WT + (size_t)(nrow0 + n) * K + k0 + 8 * c) = o;
    }
    asm volatile("s_waitcnt lgkmcnt(0)" ::: "memory");
}
__device__ __forceinline__ int win_orig_col(int p) { return p < 2560 ? p : (p < 4096 ? p + 4 : (p < 4608 ? p + 4 : p + 12)); }

__device__ __forceinline__ void p0_prologue(const Ctx& P, LAS unsigned char* lds, int gw, int NGW, int wave, int lane) {
    LAS float* scr = (LAS float*)(lds + wave * 16640);
    constexpr int I_IN = (DM / 64) * (NZ / 64), I_OUT = (DM / 64) * (DM / 64), I_UP = (DM / 64) * (NFF2 / 64), I_DN = (DFF / 64) * (DM / 64);
    constexpr int PER_L = I_IN + I_OUT + I_UP + I_DN;
    unsigned char* ws = P.ws();
    for (int it = gw; it < PER_L * DEPTH; it += NGW) {
        const int l = it / PER_L; int r = it % PER_L;
        if (r < I_IN) { const int nblk = NZ / 64, kb = r / nblk, nb = r % nblk;
            p0_item(P.in(2) + (size_t)l * DM * WIN_COLS, WIN_COLS, win_orig_col(64 * nb), (bf16_t*)(ws + WS_WIN) + (size_t)l * NZ * DM, DM, 64 * nb, 64 * kb, scr, lane); continue; }
        r -= I_IN;
        if (r < I_OUT) { const int nblk = DM / 64, kb = r / nblk, nb = r % nblk;
            p0_item(P.in(18) + (size_t)l * DM * DM, DM, 64 * nb, (bf16_t*)(ws + WS_WOUT) + (size_t)l * DM * DM, DM, 64 * nb, 64 * kb, scr, lane); continue; }
        r -= I_OUT;
        if (r < I_UP) { const int nblk = NFF2 / 64, kb = r / nblk, nb = r % nblk;
            p0_item(P.in(20) + (size_t)l * DM * NFF2, NFF2, 64 * nb, (bf16_t*)(ws + WS_WUP) + (size_t)l * NFF2 * DM, DM, 64 * nb, 64 * kb, scr, lane); continue; }
        r -= I_UP;
        { const int nblk = DM / 64, kb = r / nblk, nb = r % nblk;
            p0_item(P.in(23) + (size_t)l * DFF * DM, DM, 64 * nb, (bf16_t*)(ws + WS_WDN) + (size_t)l * DM * DFF, DFF, 64 * nb, 64 * kb, scr, lane); }
    }
    float* WG = (float*)(ws + WS_WG);
    const int gt = gw * 64 + lane, NGT = NGW * 64;
    for (int i = gt; i < DEPTH * 12 * DM; i += NGT) {
        const int l = i / (12 * DM), j = (i / DM) % 12, k = i % DM;
        const int col = (j < 4) ? (2560 + j) : (j < 8 ? 4612 + (j - 4) : 4616 + (j - 8));
        WG[i] = P.in(2)[(size_t)l * DM * WIN_COLS + (size_t)k * WIN_COLS + col];
    }
}

template <bool GATES>
__device__ __forceinline__ void norm_phase(const float* src, float* copy_dst, const float* gain, bf16_t* HB, const float* WGl, float* GL,
                                           LAS unsigned char* lds, int tid, int wave, int lane, int bid, int nblk) {
    LAS float* wg = (LAS float*)lds;
    if (GATES) {
        for (int i = tid; i < 12 * DM / 4; i += NTHR) ((LAS f32x4*)wg)[i] = ((const f32x4*)WGl)[i];
        __syncthreads();
    }
    f32x4 gv[8];
#pragma unroll
    for (int j = 0; j < 8; ++j) gv[j] = ((const f32x4*)gain)[lane + 64 * j];
    for (int m = bid * 8 + wave; m < M; m += nblk * 8) {
        const f32x4* xr = (const f32x4*)(src + (size_t)m * DM);
        f32x4 v[8]; float ss = 0.f;
#pragma unroll
        for (int j = 0; j < 8; ++j) { v[j] = xr[lane + 64 * j]; ss += (v[j].x * v[j].x + v[j].y * v[j].y) + (v[j].z * v[j].z + v[j].w * v[j].w); }
        if (copy_dst) {
            f32x4* cr = (f32x4*)(copy_dst + (size_t)m * DM);
#pragma unroll
            for (int j = 0; j < 8; ++j) cr[lane + 64 * j] = v[j];
        }
        const float rs = rsqrtf(wave_sum(ss) * (1.0f / DM) + EPS);
        u32x2* o8 = (u32x2*)(HB + (size_t)m * DM);
#pragma unroll
        for (int j = 0; j < 8; ++j) { v[j] = v[j] * rs * gv[j]; u32x2 w; w.x = pk2(v[j].x, v[j].y); w.y = pk2(v[j].z, v[j].w); o8[lane + 64 * j] = w; }
        if (GATES) {
            float myv = 0.f;
#pragma unroll 1
            for (int g = 0; g < 12; ++g) {
                float a = 0.f;
#pragma unroll
                for (int j = 0; j < 8; ++j) { const f32x4 w = ((LAS f32x4*)(wg + g * DM))[lane + 64 * j]; a += (v[j].x * w.x + v[j].y * w.y) + (v[j].z * w.z + v[j].w * w.w); }
                a = wave_sum(a);
                if (lane == g) myv = a;
            }
            if (lane < 12) GL[(size_t)m * 16 + lane] = myv;
        }
    }
    if (GATES) __syncthreads();
}

__device__ __forceinline__ void final_norm_phase(float* X, const float* gain, int wave, int lane, int bid, int nblk) {
    f32x4 gv[8];
#pragma unroll
    for (int j = 0; j < 8; ++j) gv[j] = ((const f32x4*)gain)[lane + 64 * j];
    for (int m = bid * 8 + wave; m < M; m += nblk * 8) {
        f32x4* xr = (f32x4*)(X + (size_t)m * DM);
        f32x4 v[8]; float ss = 0.f;
#pragma unroll
        for (int j = 0; j < 8; ++j) { v[j] = xr[lane + 64 * j]; ss += (v[j].x * v[j].x + v[j].y * v[j].y) + (v[j].z * v[j].z + v[j].w * v[j].w); }
        const float rs = rsqrtf(wave_sum(ss) * (1.0f / DM) + EPS);
#pragma unroll
        for (int j = 0; j < 8; ++j) xr[lane + 64 * j] = v[j] * rs * gv[j];
    }
}

struct EpiResAdd {
    static constexpr bool PERM = false, AFTER_DRAIN = false;
    float* X; int ldc;
    __device__ __forceinline__ void operator()(const pg8::f32x4 (&acc)[2][2][4][2], const pg8::Unit& u, int wr, int wc, int fr, int fq) const {
#pragma unroll
        for (int ai = 0; ai < 2; ++ai)
#pragma unroll
            for (int m = 0; m < 4; ++m) {
                float* rowp = X + (size_t)(u.pm * 256 + ai * 128 + wr * 64 + m * 16 + fr) * ldc + u.pn * 256 + wc * 32 + 4 * fq;
#pragma unroll
                for (int bj = 0; bj < 2; ++bj)
#pragma unroll
                    for (int n = 0; n < 2; ++n) { pg8::f32x4* p = (pg8::f32x4*)(rowp + bj * 128 + n * 16); *p = *p + acc[ai][bj][m][n]; }
            }
    }
};
#define XB_TMO      128
#define XB_XCNT(j)  (256  + 64 * (j))
#define XB_XSUB(j)  (1280 + 64 * (j))
#define XB_XGEN(j)  (2304 + 64 * (j))
#define XB_TOP      3328
#define XB_TOPGEN   3392
#define XCD_BAR_WORDS 3456
#define XB_SPIN_CAP (1u << 18)

__device__ __forceinline__ unsigned xb_ld(unsigned* p)              { return __hip_atomic_load(p, __ATOMIC_RELAXED, __HIP_MEMORY_SCOPE_AGENT); }
__device__ __forceinline__ unsigned xb_add(unsigned* p, unsigned v) { return __hip_atomic_fetch_add(p, v, __ATOMIC_RELAXED, __HIP_MEMORY_SCOPE_AGENT); }
__device__ __forceinline__ unsigned xb_xcc_id() { return (unsigned)__builtin_amdgcn_s_getreg((3 << 11) | 20) & 0xFu; }
#define XB_SPIN(cond, bar) do { unsigned _sp = 0; while (cond) { __builtin_amdgcn_s_sleep(1); \
    if ((++_sp & 255u) == 0u) { if (xb_ld(&(bar)[XB_TMO])) break; if (_sp > XB_SPIN_CAP) { atomicAdd(&(bar)[XB_TMO], 1u); break; } } } } while (0)

struct XcdBarrier {
    unsigned* bar; unsigned x;
    volatile LAS unsigned* st;
};

__device__ __forceinline__ XcdBarrier xcd_barrier_post(unsigned* bar, volatile LAS unsigned* st) {
    XcdBarrier b; b.bar = bar; b.x = xb_xcc_id(); b.st = st;
    if (threadIdx.x == 0) (void)xb_add(&bar[XB_XCNT(b.x)], 1u);
    return b;
}
__device__ __forceinline__ void xcd_barrier_complete(unsigned* bar, unsigned x, unsigned& nloc, unsigned& nx) {
    const unsigned G = gridDim.x * gridDim.y * gridDim.z;
    unsigned sum, cnt, mine, sp = 0u;
    for (;;) {
        sum = 0u; cnt = 0u; mine = 0u;
#pragma unroll
        for (unsigned j = 0; j < 16; ++j) { const unsigned c = xb_ld(&bar[XB_XCNT(j)]); sum += c; cnt += (c > 0u) ? 1u : 0u; mine = (j == x) ? c : mine; }
        if (sum == G) break;
        __builtin_amdgcn_s_sleep(1);
        if ((++sp & 255u) == 0u) { if (xb_ld(&bar[XB_TMO])) break; if (sp > XB_SPIN_CAP) { atomicAdd(&bar[XB_TMO], 1u); break; } }
    }
    nloc = mine > 0u ? mine : 1u; nx = cnt > 0u ? cnt : 1u;
}

__device__ __forceinline__ void xcd_barrier(const XcdBarrier& b) {
    asm volatile("s_waitcnt vmcnt(0)" ::: "memory");
    __syncthreads();
    if (threadIdx.x == 0) {
        unsigned* bar = b.bar;
        __builtin_amdgcn_s_waitcnt(0);
        unsigned nloc = b.st[0], nx = b.st[1];
        if (nloc == 0u) { xcd_barrier_complete(bar, b.x, nloc, nx); b.st[0] = nloc; b.st[1] = nx; }
        const unsigned old = xb_add(&bar[XB_XSUB(b.x)], 1u);
        const unsigned gen = old / nloc;
        if (old + 1u == (gen + 1u) * nloc) {
            __builtin_amdgcn_fence(__ATOMIC_RELEASE, "agent");
            asm volatile("s_waitcnt vmcnt(0)" ::: "memory");
            const unsigned og = xb_add(&bar[XB_TOP], 1u);
            const unsigned tg = og / nx;
            if (og + 1u == (tg + 1u) * nx) xb_add(&bar[XB_TOPGEN], 1u);
            else XB_SPIN(xb_ld(&bar[XB_TOPGEN]) == tg, bar);
            __builtin_amdgcn_fence(__ATOMIC_ACQUIRE, "agent");
            xb_add(&bar[XB_XGEN(b.x)], 1u);
            asm volatile("s_waitcnt vmcnt(0)" ::: "memory");
        } else {
            XB_SPIN(xb_ld(&bar[XB_XGEN(b.x)]) == gen, bar);
            __builtin_amdgcn_fence(__ATOMIC_ACQUIRE, "agent");
            asm volatile("s_waitcnt vmcnt(0)" ::: "memory");
        }
    }
    __syncthreads();
}

__device__ __forceinline__ void lru_chunk_unit(const Ctx& P, int l, int unit, LAS unsigned char* lds, int tid, int wave, int lane) {
    const bf16_t* Z = (const bf16_t*)(P.ws() + WS_Z);
    float* LA = (float*)(P.ws() + WS_LRUA); float* LU = (float*)(P.ws() + WS_LRUU); float* AGG = (float*)(P.ws() + WS_LAGG);
    const int b = unit >> 7, ck = unit & 127, t0 = ck * 64; const size_t m0 = (size_t)b * T + t0;
    const int ch = tid;
    LAS float* xw = (LAS float*)(lds + wave * 16384);
    {
        const int cg8 = tid & 63, tg = tid >> 6, c0 = 8 * cg8, tb = 8 * tg;
        const float* cw = P.in(3) + (size_t)l * 4 * 512 + c0; const float* cbp = P.in(4) + l * 512 + c0;
        f32x4 w[4][2], bb[2];
#pragma unroll
        for (int k = 0; k < 4; ++k) { w[k][0] = *(const f32x4*)(cw + k * 512); w[k][1] = *(const f32x4*)(cw + k * 512 + 4); }
        bb[0] = *(const f32x4*)cbp; bb[1] = *(const f32x4*)(cbp + 4);
        u32x4 r[11];
#pragma unroll
        for (int j = 0; j < 11; ++j) {
            const int tt = t0 + tb + j - 3;
            if (tt >= 0) r[j] = *(const u32x4*)(Z + (m0 + tb + j - 3) * NZ + ZC_AX + c0); else r[j] = (u32x4){0u, 0u, 0u, 0u};
        }
        LAS float* xt = (LAS float*)(lds + (cg8 >> 3) * 16384) + (c0 & 63);
#pragma unroll
        for (int t = 0; t < 8; ++t) {
            f32x4 o0, o1;
#pragma unroll
            for (int q = 0; q < 4; ++q) {
                const float lo = bb[q >> 1][(2 * q) & 3] + w[0][q >> 1][(2 * q) & 3] * bflo(r[t][q]) + w[1][q >> 1][(2 * q) & 3] * bflo(r[t + 1][q]) + w[2][q >> 1][(2 * q) & 3] * bflo(r[t + 2][q]) + w[3][q >> 1][(2 * q) & 3] * bflo(r[t + 3][q]);
                const float hi = bb[q >> 1][(2 * q + 1) & 3] + w[0][q >> 1][(2 * q + 1) & 3] * bfhi(r[t][q]) + w[1][q >> 1][(2 * q + 1) & 3] * bfhi(r[t + 1][q]) + w[2][q >> 1][(2 * q + 1) & 3] * bfhi(r[t + 2][q]) + w[3][q >> 1][(2 * q + 1) & 3] * bfhi(r[t + 3][q]);
                if (q < 2) { o0[2 * q] = lo; o0[2 * q + 1] = hi; } else { o1[2 * (q - 2)] = lo; o1[2 * (q - 2) + 1] = hi; }
            }
            *(LAS f32x4*)(xt + (tb + t) * 64) = o0; *(LAS f32x4*)(xt + (tb + t) * 64 + 4) = o1;
        }
    }
    __syncthreads();
    const float* wa = P.in(5) + ((size_t)l * 8 + wave) * 4096; const float* wx = P.in(7) + ((size_t)l * 8 + wave) * 4096;
    const float ba = P.in(6)[l * 512 + ch], bx = P.in(8)[l * 512 + ch];
    const float lam = P.in(9)[l * 512 + ch]; const float sp = softplusf_(-lam);
    float h = 0.f, ap = 1.f;
    for (int half = 0; half < 2; ++half) {
        float ra[32], ia[32];
#pragma unroll
        for (int t = 0; t < 32; ++t) { ra[t] = ba; ia[t] = bx; }
        for (int c = 0; c < 64; c += 4) {
            const float a0 = wa[(c + 0) * 64 + lane], a1 = wa[(c + 1) * 64 + lane], a2 = wa[(c + 2) * 64 + lane], a3 = wa[(c + 3) * 64 + lane];
            const float b0 = wx[(c + 0) * 64 + lane], b1 = wx[(c + 1) * 64 + lane], b2 = wx[(c + 2) * 64 + lane], b3 = wx[(c + 3) * 64 + lane];
#pragma unroll
            for (int t = 0; t < 32; ++t) {
                const f32x4 xv = *(const LAS f32x4*)(xw + (half * 32 + t) * 64 + c);
                ra[t] += xv.x * a0 + xv.y * a1 + xv.z * a2 + xv.w * a3;
                ia[t] += xv.x * b0 + xv.y * b1 + xv.z * b2 + xv.w * b3;
            }
        }
#pragma unroll
        for (int t = 0; t < 32; ++t) {
            const int tt = half * 32 + t;
            const float r = sigmoidf_(ra[t]), ig = sigmoidf_(ia[t]);
            const float log_a = -8.0f * r * sp;
            const float a = __expf(log_a);
            const float u = sqrtf(-expm1f(2.0f * log_a)) * (ig * xw[tt * 64 + lane]);
            LA[(m0 + tt) * 512 + ch] = a; LU[(m0 + tt) * 512 + ch] = u;
            h = a * h + u; ap *= a;
        }
    }
    AGG[((size_t)unit * 2 + 0) * 512 + ch] = ap; AGG[((size_t)unit * 2 + 1) * 512 + ch] = h;
}

__device__ __forceinline__ void fox_cumsum_unit(const Ctx& P, int l, int unit, LAS unsigned char* lds, int tid, int wave, int lane) {
    const float* GL = (const float*)(P.ws() + WS_GL); float* FC = (float*)(P.ws() + WS_FOXC);
    const int b = unit >> 2, hh = unit & 3; const float fb = P.in(10)[l * 4 + hh];
    LAS float* wtot = (LAS float*)lds;
    float v[16]; float s = 0.f;
#pragma unroll
    for (int i = 0; i < 16; ++i) { const float x = GL[((size_t)b * T + tid * 16 + i) * 16 + hh] + fb; const float lf = fminf(x, 0.f) - log1pf(__expf(-fabsf(x))); s += lf; v[i] = s; }
    float sc = s;
#pragma unroll
    for (int o = 1; o < 64; o <<= 1) { const float n = __shfl_up(sc, o); if (lane >= o) sc += n; }
    __syncthreads();
    if (lane == 63) wtot[wave] = sc;
    __syncthreads();
    float base = sc - s;
    for (int w = 0; w < wave; ++w) base += wtot[w];
#pragma unroll
    for (int i = 0; i < 16; ++i) FC[((size_t)unit) * T + tid * 16 + i] = base + v[i];
    __syncthreads();
}

__device__ __forceinline__ void gdn_prep_unit(const Ctx& P, int l, int unit, LAS unsigned char* lds, int tid, int wave, int lane) {
    const bf16_t* Z = (const bf16_t*)(P.ws() + WS_Z); const float* GL = (const float*)(P.ws() + WS_GL);
    const int bh = unit >> 7, n = unit & 127, b = bh >> 2, hh = bh & 3; const size_t m0 = (size_t)b * T + n * 64;
    LAS float* Kf = (LAS float*)lds; LAS float* Qf = Kf + 64 * 132; LAS float* Vf = Qf + 64 * 132; LAS float* KK = Vf + 64 * 132; LAS float* QKm = KK + 64 * 68;
    LAS float* gcs = QKm + 64 * 68; LAS float* bet = gcs + 64; LAS float* eg = bet + 64;
    __syncthreads();
    {
        const int cg = tid & 15, tg = tid >> 4, tb = 2 * tg;
        const float* cw = P.in(11) + (size_t)l * 4 * 1536;
#pragma unroll
        for (int part = 0; part < 3; ++part) {
            const int cc = part * 512 + hh * 128 + 8 * cg; const int zc = ZC_CQ + cc;
            f32x4 w[4][2];
#pragma unroll
            for (int k = 0; k < 4; ++k) { w[k][0] = *(const f32x4*)(cw + k * 1536 + cc); w[k][1] = *(const f32x4*)(cw + k * 1536 + cc + 4); }
            u32x4 r[5];
#pragma unroll
            for (int j = 0; j < 5; ++j) {
                const int tt = n * 64 + tb + j - 3;
                if (tt >= 0) r[j] = *(const u32x4*)(Z + (m0 + tb + j - 3) * NZ + zc); else r[j] = (u32x4){0u, 0u, 0u, 0u};
            }
            LAS float* dst = ((part == 0) ? Qf : (part == 1 ? Kf : Vf)) + 8 * cg;
#pragma unroll
            for (int t = 0; t < 2; ++t) {
                f32x4 o0, o1;
#pragma unroll
                for (int q = 0; q < 4; ++q) {
                    const float lo = w[0][q >> 1][(2 * q) & 3] * bflo(r[t][q]) + w[1][q >> 1][(2 * q) & 3] * bflo(r[t + 1][q]) + w[2][q >> 1][(2 * q) & 3] * bflo(r[t + 2][q]) + w[3][q >> 1][(2 * q) & 3] * bflo(r[t + 3][q]);
                    const float hi = w[0][q >> 1][(2 * q + 1) & 3] * bfhi(r[t][q]) + w[1][q >> 1][(2 * q + 1) & 3] * bfhi(r[t + 1][q]) + w[2][q >> 1][(2 * q + 1) & 3] * bfhi(r[t + 2][q]) + w[3][q >> 1][(2 * q + 1) & 3] * bfhi(r[t + 3][q]);
                    if (q < 2) { o0[2 * q] = siluf_(lo); o0[2 * q + 1] = siluf_(hi); } else { o1[2 * (q - 2)] = siluf_(lo); o1[2 * (q - 2) + 1] = siluf_(hi); }
                }
                *(LAS f32x4*)(dst + (tb + t) * 132) = o0; *(LAS f32x4*)(dst + (tb + t) * 132 + 4) = o1;
            }
        }
        if (tid < 64) {
            const float bl = GL[(m0 + tid) * 16 + 4 + hh], al = GL[(m0 + tid) * 16 + 8 + hh];
            const float g = -__expf(P.in(12)[l * 4 + hh]) * softplusf_(al + P.in(13)[l * 4 + hh]);
            float sc = g;
#pragma unroll
            for (int o = 1; o < 64; o <<= 1) { const float nn = __shfl_up(sc, o); if (lane >= o) sc += nn; }
            gcs[tid] = sc; eg[tid] = __expf(sc); bet[tid] = sigmoidf_(bl);
        }
    }
    __syncthreads();
    {
        const int row = tid >> 2, j = tid & 3; LAS float* base = (row < 64) ? (Qf + row * 132) : (Kf + (row - 64) * 132);
        float ss = 0.f;
#pragma unroll 8
        for (int e = 0; e < 32; ++e) { const float x = base[4 * e + j]; ss += x * x; }
        ss += __shfl_xor(ss, 1); ss += __shfl_xor(ss, 2);
        const float rn = rsqrtf(ss + EPS) * ((row < 64) ? 0.08838834764831845f : 1.0f);
#pragma unroll 8
        for (int e = 0; e < 32; ++e) base[4 * e + j] *= rn;
    }
    __syncthreads();
    {
        const int ti = tid >> 3, tj = tid & 7;
        float akk[8], aqk[8];
#pragma unroll
        for (int jj = 0; jj < 8; ++jj) { akk[jj] = 0.f; aqk[jj] = 0.f; }
        for (int d = 0; d < 128; d += 4) {
            const f32x4 ki = *(const LAS f32x4*)(Kf + ti * 132 + d), qi = *(const LAS f32x4*)(Qf + ti * 132 + d);
#pragma unroll
            for (int jj = 0; jj < 8; ++jj) {
                const f32x4 kj = *(const LAS f32x4*)(Kf + (8 * jj + tj) * 132 + d);
                akk[jj] += (ki.x * kj.x + ki.y * kj.y) + (ki.z * kj.z + ki.w * kj.w);
                aqk[jj] += (qi.x * kj.x + qi.y * kj.y) + (qi.z * kj.z + qi.w * kj.w);
            }
        }
        const float gi = gcs[ti], bi = bet[ti];
#pragma unroll
        for (int jj = 0; jj < 8; ++jj) {
            const int j = 8 * jj + tj;
            const float dec = (j <= ti) ? __expf(gi - gcs[j]) : 0.f;
            KK[ti * 68 + j] = (j < ti) ? akk[jj] * bi * dec : 0.f;
            QKm[ti * 68 + j] = (j <= ti) ? aqk[jj] * dec : 0.f;
        }
    }
    __syncthreads();
    unsigned char* rec = P.ws() + WS_GREC + (size_t)unit * GREC_BYTES;
    {
#pragma unroll
        for (int it = 0; it < 2; ++it) {
            const int chunk = tid + it * NTHR, c = chunk >> 4, p0 = (chunk & 15) * 8; const float e = eg[c]; float v[8];
#pragma unroll
            for (int j = 0; j < 8; ++j) v[j] = Qf[c * 132 + (p0 & ~31) + perm32((p0 & 31) + j)] * e;
            u32x4 o; o.x = pk2(v[0], v[1]); o.y = pk2(v[2], v[3]); o.z = pk2(v[4], v[5]); o.w = pk2(v[6], v[7]);
            *(u32x4*)(rec + 16384 + (size_t)(c * 128 + p0) * 2) = o;
        }
        {
            const int i = tid >> 3, p0 = (tid & 7) * 8; float v[8];
#pragma unroll
            for (int j = 0; j < 8; ++j) v[j] = QKm[i * 68 + (p0 & ~31) + perm32((p0 & 31) + j)];
            u32x4 o; o.x = pk2(v[0], v[1]); o.y = pk2(v[2], v[3]); o.z = pk2(v[4], v[5]); o.w = pk2(v[6], v[7]);
            *(u32x4*)(rec + 32768 + (size_t)(i * 64 + p0) * 2) = o;
        }
        const float glast = gcs[63];
#pragma unroll
        for (int it = 0; it < 2; ++it) {
            const int chunk = tid + it * NTHR, dk = chunk & 127, p0 = (chunk >> 7) * 8; float v[8];
#pragma unroll
            for (int j = 0; j < 8; ++j) { const int c = (p0 & ~31) + perm32((p0 & 31) + j); v[j] = Kf[c * 132 + dk] * __expf(glast - gcs[c]); }
            u32x4 o; o.x = pk2(v[0], v[1]); o.y = pk2(v[2], v[3]); o.z = pk2(v[4], v[5]); o.w = pk2(v[6], v[7]);
            *(u32x4*)(rec + 40960 + (size_t)(dk * 64 + p0) * 2) = o;
        }
        if (tid == 0) ((float*)(P.ws() + WS_GLAST))[unit] = __expf(glast);
    }
    if (tid < 256) {
        const int col = tid; float sol[64];
        if (col < 128) {
#pragma unroll
            for (int j = 0; j < 64; ++j) sol[j] = Vf[j * 132 + col] * bet[j];
        } else {
#pragma unroll
            for (int j = 0; j < 64; ++j) sol[j] = Kf[j * 132 + (col - 128)] * bet[j] * eg[j];
        }
#pragma unroll
        for (int i = 1; i < 64; ++i) {
            float acc0 = 0.f, acc1 = 0.f, acc2 = 0.f, acc3 = 0.f;
#pragma unroll
            for (int j4 = 0; j4 < (i + 3) / 4; ++j4) {
                const f32x4 kk = *(const LAS f32x4*)(KK + i * 68 + 4 * j4);
                acc0 += kk.x * sol[4 * j4 + 0]; acc1 += kk.y * sol[4 * j4 + 1]; acc2 += kk.z * sol[4 * j4 + 2]; acc3 += kk.w * sol[4 * j4 + 3];
            }
            sol[i] = sol[i] - ((acc0 + acc1) + (acc2 + acc3));
        }
        if (col < 128) {
            float* U = (float*)(P.ws() + WS_GU) + (size_t)unit * 8192;
#pragma unroll
            for (int i = 0; i < 64; ++i) U[i * 128 + col] = sol[i];
        } else {
            const int dk = col - 128; const int pos = (dk & ~31) + invperm32(dk & 31);
            bf16_t* Wp = (bf16_t*)rec;
#pragma unroll
            for (int i = 0; i < 64; ++i) Wp[i * 128 + pos] = (bf16_t)f2bf(-sol[i]);
        }
    }
    __syncthreads();
}

constexpr int AT_KSTR = 272, AT_VSTR = 320;
constexpr int AT_KBUF = 64 * AT_KSTR, AT_VBUF = 64 * AT_VSTR;
constexpr int AT_K0 = 0, AT_V0 = 2 * AT_KBUF, AT_C0 = AT_V0 + 2 * AT_VBUF;

__device__ __forceinline__ s16x4 vtr(const LAS unsigned char* p) {
    typedef short v4i16_t __attribute__((ext_vector_type(4)));
    return __builtin_bit_cast(s16x4, __builtin_amdgcn_ds_read_tr16_b64_v4i16((LAS v4i16_t*)p));
}

template <int MODE>
__device__ __forceinline__ void attn_unit(const Ctx& P, int l, LAS unsigned char* lds, int tid, int wave, int lane,
                                          int b, int hh, int dil, int res, int m0, int branch) {
    const bf16_t* Z = (const bf16_t*)(P.ws() + WS_Z);
    const int qcol = (MODE == 0 ? ZC_BQ : ZC_DQ) + hh * 128, kcol = (MODE == 0 ? ZC_BK : ZC_DK) + hh * 128, vcol = (MODE == 0 ? ZC_BV : ZC_DV) + hh * 128;
    const size_t rowbase = (size_t)b * T + res;
    const float* FC = (const float*)(P.ws() + WS_FOXC) + (size_t)(b * 4 + hh) * T;
    const int ql = lane & 31, hi = lane >> 5;
    const int mq_lo = m0 + 32 * wave, mq = mq_lo + ql, mq_hi = mq_lo + 31;
    const int kt_lo = (MODE == 0) ? 0 : ((m0 >= 128 ? m0 - 128 : 0) >> 6), kt_hi = (m0 >> 6) + 3;
    constexpr float SC2 = 0.08838834764831845f * 1.4426950408889634f, L2E = 1.4426950408889634f;

    bf16x8 qf[8];
    {
        const bf16_t* qp = Z + (rowbase + (size_t)mq * dil) * NZ + qcol + 8 * hi;
#pragma unroll
        for (int ks = 0; ks < 8; ++ks) qf[ks] = *(const bf16x8*)(qp + 16 * ks);
    }
    float cq2 = 0.f;
    if (MODE == 0) cq2 = FC[mq] * L2E;

    const int srow = tid >> 3, spart = tid & 7;
    u32x4 kr0, kr1, vr0, vr1; float cr = 0.f;
    auto gload = [&](int kt) {
        const int mk = 64 * kt + srow;
        const bf16_t* rp = Z + (rowbase + (size_t)mk * dil) * NZ;
        kr0 = *(const u32x4*)(rp + kcol + spart * 16); kr1 = *(const u32x4*)(rp + kcol + spart * 16 + 8);
        vr0 = *(const u32x4*)(rp + vcol + spart * 16); vr1 = *(const u32x4*)(rp + vcol + spart * 16 + 8);
        if (MODE == 0 && tid < 64) cr = FC[64 * kt + tid] * L2E;
    };
    auto lstore = [&](int buf) {
        LAS unsigned char* kb = lds + AT_K0 + buf * AT_KBUF + srow * AT_KSTR + spart * 32;
        *(LAS u32x4*)kb = kr0; *(LAS u32x4*)(kb + 16) = kr1;
        LAS unsigned char* vb = lds + AT_V0 + buf * AT_VBUF + srow * AT_VSTR + spart * 32;
        *(LAS u32x4*)vb = vr0; *(LAS u32x4*)(vb + 16) = vr1;
        if (MODE == 0 && tid < 64) ((LAS float*)(lds + AT_C0))[buf * 64 + tid] = cr;
    };

    f32x16 O[4];
#pragma unroll
    for (int mt = 0; mt < 4; ++mt)
#pragma unroll
        for (int r = 0; r < 16; ++r) O[mt][r] = 0.f;
    float m_run = -INFINITY, l_run = 0.f;

    __syncthreads();
    gload(kt_lo); lstore(0);
    __syncthreads();

    const int gq = lane >> 4, li = lane & 15, tq = li >> 2, tp = li & 3;
    const int vbase_lane = (4 * (gq >> 1) + tq) * AT_VSTR + (16 * (gq & 1) + 4 * tp) * 2;

    for (int kt = kt_lo; kt <= kt_hi; ++kt) {
        const int buf = (kt - kt_lo) & 1;
        if (kt < kt_hi) gload(kt + 1);
        const bool need = (MODE == 0) ? (64 * kt <= mq_hi) : ((64 * kt + 63 >= mq_lo - 128) && (64 * kt <= mq_hi));
        if (need) {
            const LAS unsigned char* kb = lds + AT_K0 + buf * AT_KBUF + ql * AT_KSTR + hi * 16;
            f32x16 p0, p1;
#pragma unroll
            for (int r = 0; r < 16; ++r) { p0[r] = 0.f; p1[r] = 0.f; }
#pragma unroll
            for (int ks = 0; ks < 8; ++ks) {
                const bf16x8 a0 = *(const LAS bf16x8*)(kb + ks * 32);
                const bf16x8 a1 = *(const LAS bf16x8*)(kb + 32 * AT_KSTR + ks * 32);
                p0 = __builtin_amdgcn_mfma_f32_32x32x16_bf16(a0, qf[ks], p0, 0, 0, 0);
                p1 = __builtin_amdgcn_mfma_f32_32x32x16_bf16(a1, qf[ks], p1, 0, 0, 0);
            }
            const LAS float* cb = (const LAS float*)(lds + AT_C0) + buf * 64;
            float mx = -INFINITY;
            const bool interior = (MODE == 0) ? (64 * kt + 63 <= mq_lo) : ((64 * kt + 63 <= mq_lo) && (mq_hi - 64 * kt <= 128));
            if (interior) {
#pragma unroll
                for (int a = 0; a < 4; ++a) {
                    f32x4 c0 = {0.f, 0.f, 0.f, 0.f}, c1 = {0.f, 0.f, 0.f, 0.f};
                    if (MODE == 0) { c0 = *(const LAS f32x4*)(cb + 8 * a + 4 * hi); c1 = *(const LAS f32x4*)(cb + 32 + 8 * a + 4 * hi); }
#pragma unroll
                    for (int e = 0; e < 4; ++e) {
                        const int r = 4 * a + e;
                        float s0 = p0[r] * SC2, s1 = p1[r] * SC2;
                        if (MODE == 0) { s0 += cq2 - c0[e]; s1 += cq2 - c1[e]; }
                        p0[r] = s0; p1[r] = s1; mx = fmaxf(mx, fmaxf(s0, s1));
                    }
                }
            } else
#pragma unroll
            for (int a = 0; a < 4; ++a) {
                f32x4 c0 = {0.f, 0.f, 0.f, 0.f}, c1 = {0.f, 0.f, 0.f, 0.f};
                if (MODE == 0) { c0 = *(const LAS f32x4*)(cb + 8 * a + 4 * hi); c1 = *(const LAS f32x4*)(cb + 32 + 8 * a + 4 * hi); }
#pragma unroll
                for (int e = 0; e < 4; ++e) {
                    const int r = 4 * a + e; const int k0 = 64 * kt + 8 * a + 4 * hi + e, k1 = k0 + 32;
                    float s0 = p0[r] * SC2, s1 = p1[r] * SC2;
                    if (MODE == 0) { s0 += cq2 - c0[e]; s1 += cq2 - c1[e]; }
                    const bool ok0 = (MODE == 0) ? (k0 <= mq) : (k0 <= mq && mq - k0 <= 128);
                    const bool ok1 = (MODE == 0) ? (k1 <= mq) : (k1 <= mq && mq - k1 <= 128);
                    s0 = ok0 ? s0 : -INFINITY; s1 = ok1 ? s1 : -INFINITY;
                    p0[r] = s0; p1[r] = s1; mx = fmaxf(mx, fmaxf(s0, s1));
                }
            }
            mx = fmaxf(mx, __shfl_xor(mx, 32));
            const float m_new = fmaxf(m_run, mx);
            const float m_use = (m_new == -INFINITY) ? 0.f : m_new;
            const float alpha = __builtin_amdgcn_exp2f(m_run - m_use);
            float ls = 0.f;
#pragma unroll
            for (int r = 0; r < 16; ++r) { p0[r] = __builtin_amdgcn_exp2f(p0[r] - m_use); p1[r] = __builtin_amdgcn_exp2f(p1[r] - m_use); ls += p0[r] + p1[r]; }
            const float m_run_prev = m_run;
            l_run = l_run * alpha + ls; m_run = m_new;
            if (!__all(m_new == m_run_prev)) {
#pragma unroll
            for (int mt = 0; mt < 4; ++mt)
#pragma unroll
                for (int r = 0; r < 16; ++r) O[mt][r] *= alpha;
            }
            bf16x8 pf[4];
#pragma unroll
            for (int s = 0; s < 4; ++s) {
                u32x4 w;
                if (s < 2) { w.x = pk2(p0[8 * s + 0], p0[8 * s + 1]); w.y = pk2(p0[8 * s + 2], p0[8 * s + 3]); w.z = pk2(p0[8 * s + 4], p0[8 * s + 5]); w.w = pk2(p0[8 * s + 6], p0[8 * s + 7]); }
                else { const int s2 = s - 2; w.x = pk2(p1[8 * s2 + 0], p1[8 * s2 + 1]); w.y = pk2(p1[8 * s2 + 2], p1[8 * s2 + 3]); w.z = pk2(p1[8 * s2 + 4], p1[8 * s2 + 5]); w.w = pk2(p1[8 * s2 + 6], p1[8 * s2 + 7]); }
                pf[s] = __builtin_bit_cast(bf16x8, w);
            }
            const LAS unsigned char* vb = lds + AT_V0 + buf * AT_VBUF + vbase_lane;
#pragma unroll
            for (int mt = 0; mt < 4; ++mt)
#pragma unroll
                for (int s = 0; s < 4; ++s) {
                    const s16x4 lo = vtr(vb + (16 * s) * AT_VSTR + mt * 64);
                    const s16x4 hi4 = vtr(vb + (16 * s + 8) * AT_VSTR + mt * 64);
                    const bf16x8 vf = {lo[0], lo[1], lo[2], lo[3], hi4[0], hi4[1], hi4[2], hi4[3]};
                    O[mt] = __builtin_amdgcn_mfma_f32_32x32x16_bf16(vf, pf[s], O[mt], 0, 0, 0);
                }
        }
        if (kt < kt_hi) lstore(buf ^ 1);
        __syncthreads();
    }
    const float l_tot = l_run + __shfl_xor(l_run, 32);
    const float inv = 1.0f / l_tot;
    const size_t orow = rowbase + (size_t)mq * dil;
    if (MODE == 0) {
        float ss = 0.f;
#pragma unroll
        for (int mt = 0; mt < 4; ++mt)
#pragma unroll
            for (int r = 0; r < 16; ++r) { O[mt][r] *= inv; ss += O[mt][r] * O[mt][r]; }
        ss += __shfl_xor(ss, 32);
        const float rn = rsqrtf(ss * (1.0f / 128.0f) + EPS);
        const float* nb = P.in(16) + l * 512 + hh * 128;
        bf16_t* yp = (bf16_t*)(P.ws() + WS_Y) + orow * DM + 512 + hh * 128;
#pragma unroll
        for (int mt = 0; mt < 4; ++mt)
#pragma unroll
            for (int a = 0; a < 4; ++a) {
                const int dv = 32 * mt + 8 * a + 4 * hi; const f32x4 g = *(const f32x4*)(nb + dv);
                u32x2 w; w.x = pk2(O[mt][4 * a + 0] * rn * g.x, O[mt][4 * a + 1] * rn * g.y); w.y = pk2(O[mt][4 * a + 2] * rn * g.z, O[mt][4 * a + 3] * rn * g.w);
                *(u32x2*)(yp + dv) = w;
            }
    } else {
        bf16_t* op = (bf16_t*)(P.ws() + WS_OD) + ((size_t)branch * M + orow) * 512 + hh * 128;
#pragma unroll
        for (int mt = 0; mt < 4; ++mt)
#pragma unroll
            for (int a = 0; a < 4; ++a) {
                const int dv = 32 * mt + 8 * a + 4 * hi;
                u32x2 w; w.x = pk2(O[mt][4 * a + 0] * inv, O[mt][4 * a + 1] * inv); w.y = pk2(O[mt][4 * a + 2] * inv, O[mt][4 * a + 3] * inv);
                *(u32x2*)(op + dv) = w;
            }
        if (hi == 0) ((float*)(P.ws() + WS_LSE))[((size_t)branch * M + orow) * 4 + hh] = (m_run + __builtin_amdgcn_logf(l_tot)) * 0.6931471805599453f;
    }
}

constexpr int GS_WP = 0, GS_QP = 64 * 272, GS_QK = 2 * 64 * 272, GS_KT = GS_QK + 64 * 144, GS_BUF = GS_KT + 128 * 144;
__device__ __forceinline__ void gdn_seq_unit(const Ctx& P, int l, int unit, LAS unsigned char* lds, int tid, int wave, int lane) {
    const int bh = unit >> 2, dvb = 32 * (unit & 3) + 16 * wave; const bool active = wave < 2;
    const int b = bh >> 2, hh = bh & 3;
    const unsigned char* recs = P.ws() + WS_GREC + (size_t)bh * 128 * GREC_BYTES;
    const float* Ug = (const float*)(P.ws() + WS_GU) + (size_t)bh * 128 * 8192;
    const float* GLv = (const float*)(P.ws() + WS_GLAST) + bh * 128;
    float* OC = (float*)(P.ws() + WS_OC);
    const int fr = lane & 15, g = lane >> 4;
    const int it = tid - 128;
    u32x4 stg[10];
#define GS_OFF(q_) (((q_) < 1024) ? (GS_WP + ((q_) >> 4) * 272 + ((q_) & 15) * 16) : (((q_) < 2048) ? (GS_QP + (((q_) - 1024) >> 4) * 272 + ((q_) & 15) * 16) : (((q_) < 2560) ? (GS_QK + (((q_) - 2048) >> 3) * 144 + ((q_) & 7) * 16) : (GS_KT + (((q_) - 2560) >> 3) * 144 + ((q_) & 7) * 16))))
#define GS_LOADALL(n_) do { const u32x4* src_ = (const u32x4*)(recs + (size_t)(n_) * GREC_BYTES); _Pragma("unroll") for (int i_ = 0; i_ < 10; ++i_) { const int q_ = it + 384 * i_; if (q_ < 3584) stg[i_] = src_[q_]; } } while (0)
#define GS_STOREALL(buf_) do { _Pragma("unroll") for (int i_ = 0; i_ < 10; ++i_) { const int q_ = it + 384 * i_; if (q_ < 3584) *(LAS u32x4*)(lds + (buf_) * GS_BUF + GS_OFF(q_)) = stg[i_]; } } while (0)
    f32x4 S[8];
#pragma unroll
    for (int i = 0; i < 8; ++i) S[i] = (f32x4){0.f, 0.f, 0.f, 0.f};
    __syncthreads();
    if (!active) { GS_LOADALL(0); GS_STOREALL(0); GS_LOADALL(1); }
    f32x4 un[4]; float gln = 0.f;
    if (active) {
#pragma unroll
        for (int mt = 0; mt < 4; ++mt)
#pragma unroll
            for (int i = 0; i < 4; ++i) un[mt][i] = Ug[(16 * mt + 4 * g + i) * 128 + dvb + fr];
        gln = GLv[0];
    }
    __syncthreads();
    for (int n = 0; n < 128; ++n) {
        const int buf = n & 1;
        if (active) {
        const LAS unsigned char* base = lds + buf * GS_BUF;
        f32x4 vn[4];
#pragma unroll
        for (int mt = 0; mt < 4; ++mt) vn[mt] = un[mt];
        const float gl = gln;
        if (n < 127) {
            const float* U = Ug + (size_t)(n + 1) * 8192;
#pragma unroll
            for (int mt = 0; mt < 4; ++mt)
#pragma unroll
                for (int i = 0; i < 4; ++i) un[mt][i] = U[(16 * mt + 4 * g + i) * 128 + dvb + fr];
            gln = GLv[n + 1];
        }
        bf16x8 sb[4];
#pragma unroll
        for (int s = 0; s < 4; ++s) {
            u32x4 w; w.x = pk2(S[2 * s][0], S[2 * s][1]); w.y = pk2(S[2 * s][2], S[2 * s][3]); w.z = pk2(S[2 * s + 1][0], S[2 * s + 1][1]); w.w = pk2(S[2 * s + 1][2], S[2 * s + 1][3]);
            sb[s] = __builtin_bit_cast(bf16x8, w);
        }
        f32x4 oa[4];
#pragma unroll
        for (int mt = 0; mt < 4; ++mt) oa[mt] = (f32x4){0.f, 0.f, 0.f, 0.f};
#pragma unroll
        for (int s = 0; s < 4; ++s) {
#pragma unroll
            for (int mt = 0; mt < 4; ++mt) {
                const bf16x8 aw = *(const LAS bf16x8*)(base + GS_WP + (16 * mt + fr) * 272 + (32 * s + 8 * g) * 2);
                const bf16x8 aq = *(const LAS bf16x8*)(base + GS_QP + (16 * mt + fr) * 272 + (32 * s + 8 * g) * 2);
                vn[mt] = __builtin_amdgcn_mfma_f32_16x16x32_bf16(aw, sb[s], vn[mt], 0, 0, 0);
                oa[mt] = __builtin_amdgcn_mfma_f32_16x16x32_bf16(aq, sb[s], oa[mt], 0, 0, 0);
            }
        }
        bf16x8 vb[2];
#pragma unroll
        for (int s = 0; s < 2; ++s) {
            u32x4 w; w.x = pk2(vn[2 * s][0], vn[2 * s][1]); w.y = pk2(vn[2 * s][2], vn[2 * s][3]); w.z = pk2(vn[2 * s + 1][0], vn[2 * s + 1][1]); w.w = pk2(vn[2 * s + 1][2], vn[2 * s + 1][3]);
            vb[s] = __builtin_bit_cast(bf16x8, w);
        }
#pragma unroll
        for (int dt = 0; dt < 8; ++dt) S[dt] = S[dt] * gl;
#pragma unroll
        for (int s = 0; s < 2; ++s) {
#pragma unroll
            for (int mt = 0; mt < 4; ++mt) {
                const bf16x8 a = *(const LAS bf16x8*)(base + GS_QK + (16 * mt + fr) * 144 + (32 * s + 8 * g) * 2);
                oa[mt] = __builtin_amdgcn_mfma_f32_16x16x32_bf16(a, vb[s], oa[mt], 0, 0, 0);
            }
#pragma unroll
            for (int dt = 0; dt < 8; ++dt) {
                const bf16x8 a = *(const LAS bf16x8*)(base + GS_KT + (16 * dt + fr) * 144 + (32 * s + 8 * g) * 2);
                S[dt] = __builtin_amdgcn_mfma_f32_16x16x32_bf16(a, vb[s], S[dt], 0, 0, 0);
            }
        }
        {
            float* op = OC + ((size_t)b * T + n * 64) * 512 + hh * 128 + dvb + fr;
#pragma unroll
            for (int mt = 0; mt < 4; ++mt)
#pragma unroll
                for (int i = 0; i < 4; ++i) op[(size_t)(16 * mt + 4 * g + i) * 512] = oa[mt][i];
        }
        } else {
            if (n + 1 < 128) GS_STOREALL(buf ^ 1);
            if (n + 2 < 128) GS_LOADALL(n + 2);
        }
        __syncthreads();
    }
#undef GS_OFF
#undef GS_LOADALL
#undef GS_STOREALL
}

__device__ __forceinline__ void lru_final_unit(const Ctx& P, int l, int unit, int tid, int wave, int lane) {
    const bf16_t* Z = (const bf16_t*)(P.ws() + WS_Z);
    const float* LA = (const float*)(P.ws() + WS_LRUA); const float* LU = (const float*)(P.ws() + WS_LRUU); const float* AGG = (const float*)(P.ws() + WS_LAGG);
    bf16_t* Y = (bf16_t*)(P.ws() + WS_Y);
    const int b = unit >> 7, ck = unit & 127; const size_t m0 = (size_t)b * T + ck * 64; const int ch = tid;
    float h = 0.f;
    {
        const float* ag = AGG + (size_t)(b * 128) * 2 * 512 + ch;
        int j = 0;
        for (; j + 8 <= ck; j += 8) {
            float aa[8], hh2[8];
#pragma unroll
            for (int q = 0; q < 8; ++q) { aa[q] = ag[(size_t)((j + q) * 2 + 0) * 512]; hh2[q] = ag[(size_t)((j + q) * 2 + 1) * 512]; }
#pragma unroll
            for (int q = 0; q < 8; ++q) h = aa[q] * h + hh2[q];
        }
        for (; j < ck; ++j) { const float a = ag[(size_t)(j * 2 + 0) * 512], h2 = ag[(size_t)(j * 2 + 1) * 512]; h = a * h + h2; }
    }
    const float gn = P.in(15)[l * 512 + ch];
    for (int t0 = 0; t0 < 64; t0 += 8) {
        float av[8], uv[8], gv[8], hv[8], sv[8];
#pragma unroll
        for (int q = 0; q < 8; ++q) { av[q] = LA[(m0 + t0 + q) * 512 + ch]; uv[q] = LU[(m0 + t0 + q) * 512 + ch]; gv[q] = bf2f(Z[(m0 + t0 + q) * NZ + ZC_AG + ch]); }
#pragma unroll
        for (int q = 0; q < 8; ++q) { h = av[q] * h + uv[q]; hv[q] = h; sv[q] = h * h; }
#pragma unroll
        for (int o = 1; o < 64; o <<= 1) {
#pragma unroll
            for (int q = 0; q < 8; ++q) sv[q] += __shfl_xor(sv[q], o);
        }
#pragma unroll
        for (int q = 0; q < 8; ++q) {
            const float y = hv[q] * rsqrtf(sv[q] * (1.0f / 64.0f) + EPS) * gn * gelu_tanh(gv[q]);
            Y[(m0 + t0 + q) * DM + ch] = (bf16_t)f2bf(y);
        }
    }
}

__device__ __forceinline__ void finalize_phase(const Ctx& P, int l, int wave, int lane, int bid, int nblk) {
    const bf16_t* Z = (const bf16_t*)(P.ws() + WS_Z); const float* OC = (const float*)(P.ws() + WS_OC);
    const bf16_t* OD = (const bf16_t*)(P.ws() + WS_OD); const float* LSE = (const float*)(P.ws() + WS_LSE);
    bf16_t* Y = (bf16_t*)(P.ws() + WS_Y);
    const float gc0 = P.in(14)[l * 128 + 2 * lane], gc1 = P.in(14)[l * 128 + 2 * lane + 1];
    for (int task = bid * 8 + wave; task < M * 4; task += nblk * 8) {
        const size_t m = task >> 2; const int hh = task & 3;
        {
            const float o0 = OC[m * 512 + hh * 128 + 2 * lane], o1 = OC[m * 512 + hh * 128 + 2 * lane + 1];
            const float rn = rsqrtf(wave_sum(o0 * o0 + o1 * o1) * (1.0f / 128.0f) + EPS);
            const unsigned zz = *(const unsigned*)(Z + m * NZ + ZC_CZ + hh * 128 + 2 * lane);
            const float z0 = bflo(zz), z1 = bfhi(zz);
            *(unsigned*)(Y + m * DM + 1024 + hh * 128 + 2 * lane) = pk2(o0 * rn * gc0 * siluf_(z0), o1 * rn * gc1 * siluf_(z1));
        }
        {
            const float l0 = LSE[((size_t)0 * M + m) * 4 + hh], l1 = LSE[((size_t)1 * M + m) * 4 + hh], l2 = LSE[((size_t)2 * M + m) * 4 + hh];
            const float mx = fmaxf(l0, fmaxf(l1, l2));
            float w0 = __expf(l0 - mx), w1 = __expf(l1 - mx), w2 = __expf(l2 - mx);
            const float inv = 1.0f / (w0 + w1 + w2); w0 *= inv; w1 *= inv; w2 *= inv;
            const unsigned a0 = *(const unsigned*)(OD + ((size_t)0 * M + m) * 512 + hh * 128 + 2 * lane);
            const unsigned a1 = *(const unsigned*)(OD + ((size_t)1 * M + m) * 512 + hh * 128 + 2 * lane);
            const unsigned a2 = *(const unsigned*)(OD + ((size_t)2 * M + m) * 512 + hh * 128 + 2 * lane);
            const float o0 = w0 * bflo(a0) + w1 * bflo(a1) + w2 * bflo(a2), o1 = w0 * bfhi(a0) + w1 * bfhi(a1) + w2 * bfhi(a2);
            const float rn = rsqrtf(wave_sum(o0 * o0 + o1 * o1) * (1.0f / 128.0f) + EPS);
            const float g0 = P.in(17)[l * 512 + hh * 128 + 2 * lane], g1 = P.in(17)[l * 512 + hh * 128 + 2 * lane + 1];
            *(unsigned*)(Y + m * DM + 1536 + hh * 128 + 2 * lane) = pk2(o0 * rn * g0, o1 * rn * g1);
        }
    }
}

__device__ __forceinline__ void ffn_act_phase(const Ctx& P, int l, int tid, int bid, int nblk) {
    const bf16_t* U = (const bf16_t*)(P.ws() + WS_U); bf16_t* ACT = (bf16_t*)(P.ws() + WS_ACT);
    const float* cw = P.in(21) + (size_t)l * 3 * NFF2; const float* cb = P.in(22) + (size_t)l * NFF2;
    constexpr int CG = DFF / 8, RUN = 32, NRUN = M / RUN;
    for (int item = bid * NTHR + tid; item < CG * NRUN; item += nblk * NTHR) {
        const int cg8 = item % CG, run = item / CG; const int c0 = cg8 * 8; const size_t mstart = (size_t)run * RUN; const int tin = (int)(mstart % T);
        float wu[3][8], wg[3][8], bu[8], bg[8];
#pragma unroll
        for (int k = 0; k < 3; ++k)
#pragma unroll
            for (int e = 0; e < 8; ++e) { wu[k][e] = cw[k * NFF2 + c0 + e]; wg[k][e] = cw[k * NFF2 + DFF + c0 + e]; }
#pragma unroll
        for (int e = 0; e < 8; ++e) { bu[e] = cb[c0 + e]; bg[e] = cb[DFF + c0 + e]; }
        u32x4 u2 = {0, 0, 0, 0}, u1 = {0, 0, 0, 0}, g2 = {0, 0, 0, 0}, g1 = {0, 0, 0, 0};
        if (tin > 0) {
            u2 = *(const u32x4*)(U + (mstart - 2) * NFF2 + c0); u1 = *(const u32x4*)(U + (mstart - 1) * NFF2 + c0);
            g2 = *(const u32x4*)(U + (mstart - 2) * NFF2 + DFF + c0); g1 = *(const u32x4*)(U + (mstart - 1) * NFF2 + DFF + c0);
        }
        for (int t = 0; t < RUN; ++t) {
            const u32x4 u0 = *(const u32x4*)(U + (mstart + t) * NFF2 + c0), g0 = *(const u32x4*)(U + (mstart + t) * NFF2 + DFF + c0);
            float r[8];
#pragma unroll
            for (int q = 0; q < 4; ++q) {
                const float up0 = bu[2 * q] + wu[0][2 * q] * bflo(u2[q]) + wu[1][2 * q] * bflo(u1[q]) + wu[2][2 * q] * bflo(u0[q]);
                const float up1 = bu[2 * q + 1] + wu[0][2 * q + 1] * bfhi(u2[q]) + wu[1][2 * q + 1] * bfhi(u1[q]) + wu[2][2 * q + 1] * bfhi(u0[q]);
                const float ga0 = bg[2 * q] + wg[0][2 * q] * bflo(g2[q]) + wg[1][2 * q] * bflo(g1[q]) + wg[2][2 * q] * bflo(g0[q]);
                const float ga1 = bg[2 * q + 1] + wg[0][2 * q + 1] * bfhi(g2[q]) + wg[1][2 * q + 1] * bfhi(g1[q]) + wg[2][2 * q + 1] * bfhi(g0[q]);
                r[2 * q] = siluf_(ga0) * up0; r[2 * q + 1] = siluf_(ga1) * up1;
            }
            u32x4 o; o.x = pk2(r[0], r[1]); o.y = pk2(r[2], r[3]); o.z = pk2(r[4], r[5]); o.w = pk2(r[6], r[7]);
            *(u32x4*)(ACT + (mstart + t) * DFF + c0) = o;
            u2 = u1; u1 = u0; g2 = g1; g1 = g0;
        }
    }
}

#ifndef N_LAYERS_RUN
#define N_LAYERS_RUN DEPTH
#endif
constexpr int D_NUNITS = 32 + 256 + 768 + 256;

__global__ void __launch_bounds__(NTHR, 2) fwd_megakernel(Params KP) {
    extern __shared__ __attribute__((aligned(16))) unsigned char lds_raw[];
    LAS unsigned char* lds0 = (LAS unsigned char*)lds_raw;
    cg::grid_group grid = cg::this_grid();
    const int tid = threadIdx.x, lane = tid & 63, wave = __builtin_amdgcn_readfirstlane(tid >> 6);
    const int bid = blockIdx.x, nblk = gridDim.x;
    volatile LAS int* misc = (volatile LAS int*)(lds0 + LDS_MISC);
    if (threadIdx.x < 16) misc[threadIdx.x] = 0;
    __syncthreads();
    XcdBarrier xbar = xcd_barrier_post((unsigned*)(KP.ws + WS_CTL) + 4096, (volatile LAS unsigned*)(lds0 + LDS_MISC) + 8);
    {
        LAS unsigned long long* tabw = (LAS unsigned long long*)(lds0 + LDS_MISC + 64);
        if (threadIdx.x == 0) {
#pragma unroll
            for (int i = 0; i < 25; ++i) tabw[i] = (unsigned long long)KP.in[i];
            tabw[25] = (unsigned long long)KP.out; tabw[26] = (unsigned long long)KP.ws;
        }
        __syncthreads();
    }
    Ctx P; P.tab = (const LAS unsigned*)(lds0 + LDS_MISC + 64);
#define WSP (P.ws())
#define XP (P.out())

#ifdef DUP_SYNC
#define GSYNC() do { grid.sync(); grid.sync(); } while (0)
#else
#define GSYNC() xcd_barrier(xbar)
#endif
#ifndef SK_P0
    p0_prologue(P, lds0, bid * 8 + wave, nblk * 8, wave, lane);
#ifdef DUP_P0
    __syncthreads();
    p0_prologue(P, lds0, bid * 8 + wave, nblk * 8, wave, lane);
#endif
#endif
    grid.sync();

    for (int l0 = 0; l0 < N_LAYERS_RUN; ++l0) {
#define FRESH() LAS unsigned char* lds = lds0; asm volatile("" : "+v"(lds)); int l = l0; asm volatile("" : "+s"(l)); int tid = threadIdx.x; asm volatile("" : "+v"(tid)); const int lane = tid & 63, wave = __builtin_amdgcn_readfirstlane(tid >> 6); (void)lane; (void)wave; (void)l;
#ifndef SK_A
        { FRESH()
        norm_phase<true>(l == 0 ? P.in(0) : XP, l == 0 ? XP : nullptr, P.in(1) + l * DM, (bf16_t*)(WSP + WS_HB), (const float*)(WSP + WS_WG) + (size_t)l * 12 * DM,
                         (float*)(WSP + WS_GL), lds, tid, wave, lane, bid, nblk);
#ifdef DUP_A
        norm_phase<true>(l == 0 ? P.in(0) : XP, l == 0 ? XP : nullptr, P.in(1) + l * DM, (bf16_t*)(WSP + WS_HB), (const float*)(WSP + WS_WG) + (size_t)l * 12 * DM, (float*)(WSP + WS_GL), lds, tid, wave, lane, bid, nblk);
#endif
        }
#endif
        GSYNC();
#ifndef SK_B
        { FRESH()
            pg8::Gemm g{(const bf16_t*)(WSP + WS_HB), (const bf16_t*)(WSP + WS_WIN) + (size_t)l * NZ * DM, M, NZ, DM};
            pg8::StaticOrder S; S.init(M, NZ, nblk, bid);
            pg8::EpiBf16<0> E{(bf16_t*)(WSP + WS_Z), NZ, nullptr, 0, 0, 1.f};
            pg8::gemm_phase<pg8::EpiBf16<0>, pg8::StaticOrder, true, true>(lds, g, S, E);
#ifdef DUP_B
            __syncthreads();
            pg8::gemm_phase<pg8::EpiBf16<0>, pg8::StaticOrder, true, true>(lds, g, S, E);
#endif
        }
#endif
        GSYNC();
#ifdef DUP_C
        for (int pass = 0; pass < 2; ++pass)
#endif
        for (int u = bid; u < 1024 + 256 + 8; u += nblk) { FRESH()
#ifndef SK_C3
            if (u < 1024) gdn_prep_unit(P, l, u, lds, tid, wave, lane); else
#endif
#ifndef SK_C1
            if (u >= 1024 && u < 1280) { __syncthreads(); lru_chunk_unit(P, l, u - 1024, lds, tid, wave, lane); __syncthreads(); } else
#endif
#ifndef SK_C2
            if (u >= 1280) fox_cumsum_unit(P, l, u - 1280, lds, tid, wave, lane);
#else
            {}
#endif
        }
        GSYNC();
        {
#ifdef DUP_D
            for (int pass = 0; pass < 2; ++pass) {
            unsigned* ctr = (unsigned*)(WSP + WS_CTL) + 64 * (1 + l0) + 16 * pass;
#else
            {
            unsigned* ctr = (unsigned*)(WSP + WS_CTL) + 64 * (1 + l0);
#endif
            for (;;) {
                __syncthreads();
                if (threadIdx.x == 0) misc[0] = (int)atomicAdd(ctr, 1u);
                __syncthreads();
                const int u = misc[0];
                if (u >= D_NUNITS) break;
                FRESH()
#ifndef SK_D1
                if (u < 32) gdn_seq_unit(P, l, u, lds, tid, wave, lane); else
#endif
#ifndef SK_D2
                if (u >= 32 && u < 288) { const int i = u - 32; attn_unit<0>(P, l, lds, tid, wave, lane, (i & 7) >> 2, i & 3, 1, 0, (31 - (i >> 3)) * 256, 0); } else
#endif
#ifndef SK_D3
                if (u >= 288 && u < 1056) {
                    const int i = u - 288; const int bh = i & 7, j = i >> 3;
                    const int br = j >> 5, k = j & 31;
                    const int dil = (br == 0) ? 1 : (br == 1 ? 4 : 16);
                    const int nqb = 32 / dil;
                    const int res = k / nqb, qb = k % nqb;
                    attn_unit<1>(P, l, lds, tid, wave, lane, bh >> 2, bh & 3, dil, res, qb * 256, br);
                } else
#endif
#ifndef SK_D4
                if (u >= 1056) lru_final_unit(P, l, u - 1056, tid, wave, lane);
#else
                {}
#endif
            }
            }
#ifdef DUP_SUB
            {
            unsigned* ctr = (unsigned*)(WSP + WS_CTL) + 64 * (1 + l0) + 32;
            for (;;) {
                __syncthreads();
                if (threadIdx.x == 0) misc[0] = (int)atomicAdd(ctr, 1u);
                __syncthreads();
                const int u = misc[0] + DUP_SUB_LO;
                if (u >= DUP_SUB_HI) break;
                FRESH()
                if (u < 32) gdn_seq_unit(P, l, u, lds, tid, wave, lane);
                else if (u < 288) { const int i = u - 32; attn_unit<0>(P, l, lds, tid, wave, lane, (i & 7) >> 2, i & 3, 1, 0, (31 - (i >> 3)) * 256, 0); }
                else if (u < 1056) {
                    const int i = u - 288; const int bh = i & 7, j = i >> 3;
                    const int br = j >> 5, k = j & 31;
                    const int dil = (br == 0) ? 1 : (br == 1 ? 4 : 16);
                    const int nqb = 32 / dil;
                    const int res = k / nqb, qb = k % nqb;
                    attn_unit<1>(P, l, lds, tid, wave, lane, bh >> 2, bh & 3, dil, res, qb * 256, br);
                }
                else lru_final_unit(P, l, u - 1056, tid, wave, lane);
            }
            }
#endif
        }
        GSYNC();
#ifndef SK_E
        { FRESH() finalize_phase(P, l, wave, lane, bid, nblk);
#ifdef DUP_E
          finalize_phase(P, l, wave, lane, bid, nblk);
#endif
        }
#endif
        GSYNC();
#ifndef SK_F
        { FRESH()
            pg8::Gemm g{(const bf16_t*)(WSP + WS_Y), (const bf16_t*)(WSP + WS_WOUT) + (size_t)l * DM * DM, M, DM, DM};
            pg8::StaticOrder S; S.init(M, DM, nblk, bid);
            EpiResAdd E{XP, DM};
            pg8::gemm_phase<EpiResAdd, pg8::StaticOrder, true, true>(lds, g, S, E);
#ifdef DUP_F
            __syncthreads();
            EpiResAdd E2{(float*)(WSP + WS_ACT), DM};
            pg8::gemm_phase<EpiResAdd, pg8::StaticOrder, true, true>(lds, g, S, E2);
#endif
        }
#endif
        GSYNC();
#ifndef SK_G
        { FRESH() norm_phase<false>(XP, nullptr, P.in(19) + l * DM, (bf16_t*)(WSP + WS_HB), nullptr, nullptr, lds, tid, wave, lane, bid, nblk);
#ifdef DUP_G
          norm_phase<false>(XP, nullptr, P.in(19) + l * DM, (bf16_t*)(WSP + WS_HB), nullptr, nullptr, lds, tid, wave, lane, bid, nblk);
#endif
        }
#endif
        GSYNC();
#ifndef SK_H
        { FRESH()
            pg8::Gemm g{(const bf16_t*)(WSP + WS_HB), (const bf16_t*)(WSP + WS_WUP) + (size_t)l * NFF2 * DM, M, NFF2, DM};
            pg8::StaticOrder S; S.init(M, NFF2, nblk, bid);
            pg8::EpiBf16<0> E{(bf16_t*)(WSP + WS_U), NFF2, nullptr, 0, 0, 1.f};
            pg8::gemm_phase<pg8::EpiBf16<0>, pg8::StaticOrder, true, true>(lds, g, S, E);
#ifdef DUP_H
            __syncthreads();
            pg8::gemm_phase<pg8::EpiBf16<0>, pg8::StaticOrder, true, true>(lds, g, S, E);
#endif
        }
#endif
        GSYNC();
#ifndef SK_I
        { FRESH() ffn_act_phase(P, l, tid, bid, nblk);
#ifdef DUP_I
          ffn_act_phase(P, l, tid, bid, nblk);
#endif
        }
#endif
        GSYNC();
#ifndef SK_J
        { FRESH()
            pg8::Gemm g{(const bf16_t*)(WSP + WS_ACT), (const bf16_t*)(WSP + WS_WDN) + (size_t)l * DM * DFF, M, DM, DFF};
            pg8::StaticOrder S; S.init(M, DM, nblk, bid);
            EpiResAdd E{XP, DM};
            pg8::gemm_phase<EpiResAdd, pg8::StaticOrder, true, true>(lds, g, S, E);
#ifdef DUP_J
            __syncthreads();
            EpiResAdd E2{(float*)(WSP + WS_Z), DM};
            pg8::gemm_phase<EpiResAdd, pg8::StaticOrder, true, true>(lds, g, S, E2);
#endif
        }
#endif
        GSYNC();
    }
#ifndef SK_FN
    { int tid = threadIdx.x; asm volatile("" : "+v"(tid)); const int lane = tid & 63, wave = __builtin_amdgcn_readfirstlane(tid >> 6);
      final_norm_phase(XP, P.in(24), wave, lane, bid, nblk); }
#endif
}

extern "C" void kernel_launch(void* const* d_in, const int* in_sizes, int n_in, void* d_out, int out_size, void* d_ws, size_t ws_size, hipStream_t stream) {
    static int grid_blocks = 0;
    if (grid_blocks == 0) {
        if (n_in != 25 || ws_size < WS_END) { fprintf(stderr, "kernel_launch: unexpected inputs (n_in %d, ws %zu < %zu)\n", n_in, ws_size, (size_t)WS_END); grid_blocks = -1; return; }
        int dev = 0, cus = 0, per_cu = 0;
        (void)hipGetDevice(&dev);
        (void)hipDeviceGetAttribute(&cus, hipDeviceAttributeMultiprocessorCount, dev);
        if (hipFuncSetAttribute((const void*)fwd_megakernel, hipFuncAttributeMaxDynamicSharedMemorySize, LDS_BYTES) != hipSuccess) { fprintf(stderr, "kernel_launch: hipFuncSetAttribute failed\n"); grid_blocks = -1; return; }
        if (hipOccupancyMaxActiveBlocksPerMultiprocessor(&per_cu, (const void*)fwd_megakernel, NTHR, LDS_BYTES) != hipSuccess || per_cu < 1) { fprintf(stderr, "kernel_launch: occupancy query says %d\n", per_cu); per_cu = 1; }
        (void)hipGetLastError();
        grid_blocks = cus * per_cu;
        if (grid_blocks > 256) grid_blocks = 256;
    }
    if (grid_blocks < 0) return;
    (void)hipMemsetAsync((char*)d_ws + WS_CTL, 0, 65536, stream);
    Params p{};
    for (int i = 0; i < 25; ++i) p.in[i] = (const float*)d_in[i];
    p.out = (float*)d_out; p.ws = (unsigned char*)d_ws;
    void* args[] = {&p};
    hipError_t e = hipLaunchCooperativeKernel((const void*)fwd_megakernel, dim3(grid_blocks), dim3(NTHR), args, LDS_BYTES, stream);
    if (e != hipSuccess) fprintf(stderr, "cooperative launch failed: %s (grid %d)\n", hipGetErrorString(e), grid_blocks);
}
```

```cpp
#include <hip/hip_runtime.h>
#include <hip/hip_cooperative_groups.h>
#include <cstdio>
#include <cstdint>
namespace cg = cooperative_groups;
namespace pg8 {
#define PG8_LAS __attribute__((address_space(3)))
typedef unsigned short bf16_t;
typedef short bf16x8 __attribute__((ext_vector_type(8)));
typedef float f32x4 __attribute__((ext_vector_type(4)));
typedef unsigned u32x4 __attribute__((ext_vector_type(4)));
constexpr int BM = 256, BK = 64, HALF = 128, HTB = HALF * BK * 2  , STAGE_BYTES = 8 * HTB, NXCD = 8, WGM = 8;

__host__ __device__ __forceinline__ int lds_byte(int r, int c) { const int st = (r >> 4) * 2 + (c >> 5), rr = r & 15, cc = c & 31, ob = rr * 64 + cc * 2; return st * 1024 + (ob ^ (((ob >> 9) & 1) << 5)); }
__host__ __device__ __forceinline__ void stage_rc(int b, int& R, int& C) { const int st = b / 1024, sb = b % 1024, swz = sb ^ (((sb >> 9) & 1) << 5); R = (st >> 1) * 16 + swz / 64; C = (st & 1) * 32 + (swz % 64) / 2; }
__host__ __device__ __forceinline__ int perm32(int rho) { const int n = rho >> 4, i = rho & 15; return 8 * (i >> 2) + 4 * n + (i & 3); }

struct Unit { int pm, pn; };
struct Gemm { const bf16_t* A; const bf16_t* Bt; int M, N, K; };

struct StaticOrder {
    int nM, nN, nwg, G, c;
    __host__ __device__ void init(int M, int N, int G_, int c_) { nM = M / BM; nN = N / BM; nwg = nM * nN; G = G_; c = c_; }
    __host__ __device__ bool next(int i, Unit& u) const {
        const long L = (long)i * G + c; if (L >= nwg) return false;
        int wgid = (int)L; { const int q = nwg / NXCD, r = nwg % NXCD, xcd = wgid % NXCD, off = wgid / NXCD; wgid = (xcd < r ? xcd * (q + 1) : r * (q + 1) + (xcd - r) * q) + off; }
        const int nig = WGM * nN, gid = wgid / nig, fm = gid * WGM, gsz = (nM - fm) < WGM ? (nM - fm) : WGM;
        u.pm = fm + ((wgid % nig) % gsz); u.pn = (wgid % nig) / gsz; return true;
    }
    __device__ __forceinline__ void a_ready(const Unit&) const {}
    __device__ __forceinline__ void done(const Unit&) const {}
};

__device__ __forceinline__ unsigned cvt_pk_bf16(float lo, float hi) { unsigned r; asm volatile("v_cvt_pk_bf16_f32 %0, %1, %2" : "=v"(r) : "v"(lo), "v"(hi)); return r; }
typedef float f32x2 __attribute__((ext_vector_type(2)));
__device__ __forceinline__ f32x2 gelu_pk(f32x2 v) {
    const f32x2 av = __builtin_elementwise_abs(v), d = av * 0.2316418882f + 1.0f;
    f32x2 t; t.x = __builtin_amdgcn_rcpf(d.x); t.y = __builtin_amdgcn_rcpf(d.y);
    f32x2 q = t * 0.5307027145f + (-0.7265760135f); q = q * t + 0.7107068705f; q = q * t + (-0.142248368f); q = q * t + 0.127414796f; q = q * t;
    const f32x2 s = (v * v) * (-0.72134752044f);
    f32x2 e; e.x = __builtin_amdgcn_exp2f(s.x); e.y = __builtin_amdgcn_exp2f(s.y);
    const f32x2 m = v * (q * e), r = v - m;
    f32x2 o; o.x = v.x < 0.f ? m.x : r.x; o.y = v.y < 0.f ? m.y : r.y; return o;
}

template <int ACT  > struct EpiBf16 {
    static constexpr bool PERM = true, AFTER_DRAIN = false; static_assert(ACT == 0 || ACT == 1, "EpiBf16: ACT is 0 (none) or 1 (gelu_pk)");
    bf16_t* O; int ldc; const float* bias; int split_cols; size_t split_stride; float scale0;
    __device__ __forceinline__ void operator()(const f32x4 (&acc)[2][2][4][2], const Unit& u, int wr, int wc, int fr, int fq) const {
        const int row0 = u.pm * BM + wr * 64 + fr; int colt = u.pn * BM; bf16_t* base = O;
        float sc = 1.f; if (split_cols) { const int t = colt / split_cols; base += (size_t)t * split_stride; colt -= t * split_cols; if (t == 0) sc = scale0; }
        const int col0 = colt + wc * 32 + 8 * fq, bcol0 = u.pn * BM + wc * 32 + 8 * fq;
        f32x4 bv[2][2];
#pragma unroll
        for (int bj = 0; bj < 2; ++bj)
#pragma unroll
            for (int n = 0; n < 2; ++n) bv[bj][n] = bias ? *(const f32x4*)(bias + bcol0 + bj * HALF + 4 * n) : (f32x4){0.f, 0.f, 0.f, 0.f};
#pragma unroll
        for (int ai = 0; ai < 2; ++ai)
#pragma unroll
            for (int m = 0; m < 4; ++m) { bf16_t* rowp = base + (size_t)(row0 + ai * HALF + m * 16) * ldc + col0;
#pragma unroll
                for (int bj = 0; bj < 2; ++bj) { f32x4 v0 = acc[ai][bj][m][0] + bv[bj][0], v1 = acc[ai][bj][m][1] + bv[bj][1];
                    if (ACT == 1) { f32x2 a = gelu_pk((f32x2){v0[0], v0[1]}), b = gelu_pk((f32x2){v0[2], v0[3]}), c = gelu_pk((f32x2){v1[0], v1[1]}), d = gelu_pk((f32x2){v1[2], v1[3]});
                        v0 = (f32x4){a.x, a.y, b.x, b.y}; v1 = (f32x4){c.x, c.y, d.x, d.y}; }
                    v0 = v0 * sc; v1 = v1 * sc; u32x4 w; w.x = cvt_pk_bf16(v0[0], v0[1]); w.y = cvt_pk_bf16(v0[2], v0[3]); w.z = cvt_pk_bf16(v1[0], v1[1]); w.w = cvt_pk_bf16(v1[2], v1[3]);
                    *(u32x4*)(rowp + bj * HALF) = w; } }
    }
};
template <class Epi, class Sched, bool ALIGN_EPI = false, bool SP2 = false>
__device__ __forceinline__ void gemm_phase(PG8_LAS unsigned char* lds, const Gemm g, const Sched& S, const Epi& E) {
    int tid_l = threadIdx.x; asm volatile("" : "+v"(tid_l)); const int tid = tid_l, wid = __builtin_amdgcn_readfirstlane(tid >> 6), lane = tid & 63, wr = wid >> 2, wc = wid & 3, fr = lane & 15, fq = lane >> 4;
    const int K = g.K, nt = K / BK;
    unsigned voffA[2], voffB[2];
#pragma unroll
    for (int i = 0; i < 2; ++i) { int R, C; stage_rc(tid * 16 + i * 8192, R, C); const int Rb = Epi::PERM ? ((R & ~31) + perm32(R & 31)) : R;
        voffA[i] = (unsigned)(R * K + C) * 2u; voffB[i] = (unsigned)(Rb * K + C) * 2u; }
    const size_t kstep = (size_t)(BK * 2);
    const size_t hstep = (size_t)HALF * K * 2;
    const size_t tstep = 2 * hstep;
    const unsigned ldsw = (unsigned)wid * 1024u;
    const int aoff = lds_byte(wr * 64 + fr, fq * 8), boff = lds_byte(wc * 32 + fr, fq * 8);
#define PG8_SA(b, h) (((b) * 2 + (h)) * HTB)
#define PG8_SB(b, h) ((4 + (b) * 2 + (h)) * HTB)
#define PG8_STAGE(bufoff, gbase, voff) do { _Pragma("unroll") for (int _i = 0; _i < 2; ++_i) \
        __builtin_amdgcn_global_load_lds((const unsigned*)((const char*)(gbase) + (voff)[_i]), (PG8_LAS unsigned*)(lds + (bufoff) + ldsw + _i * 8192), 16, 0, 0); } while (0)
#define PG8_LDA(dst, b, h) do { _Pragma("unroll") for (int m = 0; m < 4; ++m) _Pragma("unroll") for (int k = 0; k < 2; ++k) dst[m][k] = *(const PG8_LAS bf16x8*)(lds + PG8_SA(b, h) + aoff + m * 2048 + k * 1024); } while (0)
#define PG8_LDB(dst, b, h) do { _Pragma("unroll") for (int n = 0; n < 2; ++n) _Pragma("unroll") for (int k = 0; k < 2; ++k) dst[n][k] = *(const PG8_LAS bf16x8*)(lds + PG8_SB(b, h) + boff + n * 2048 + k * 1024); } while (0)
#define PG8_MMA(ai, bj, At, Bt) do { __builtin_amdgcn_s_setprio(1); _Pragma("unroll") for (int m = 0; m < 4; ++m) _Pragma("unroll") for (int n = 0; n < 2; ++n) _Pragma("unroll") for (int k = 0; k < 2; ++k) \
        acc[ai][bj][m][n] = __builtin_amdgcn_mfma_f32_16x16x32_bf16(Bt[n][k], At[m][k], acc[ai][bj][m][n], 0, 0, 0); __builtin_amdgcn_s_setprio(0); } while (0)
#define PG8_WAIT_V(n) asm volatile("s_waitcnt vmcnt(" #n ")" ::: "memory")
#define PG8_WAIT_L(n) asm volatile("s_waitcnt lgkmcnt(" #n ")" ::: "memory")
#define PG8_BAR __builtin_amdgcn_s_barrier()
#define PG8_SCHED __builtin_amdgcn_sched_barrier(0)
    Unit cur, nxt; int ui = 0;
    if (!S.next(0, cur)) return;
    f32x4 acc[2][2][4][2];
#pragma unroll
    for (int a = 0; a < 2; ++a)
#pragma unroll
        for (int b = 0; b < 2; ++b)
#pragma unroll
            for (int m = 0; m < 4; ++m)
#pragma unroll
                for (int n = 0; n < 2; ++n) acc[a][b][m][n] = (f32x4){0.f, 0.f, 0.f, 0.f};
    bf16x8 At[4][2], B0[2][2], B1[2][2];
    const char* cA = (const char*)g.A + (size_t)cur.pm * tstep; const char* cB = (const char*)g.Bt + (size_t)cur.pn * tstep;
    S.a_ready(cur);
    if constexpr (SP2) {
        PG8_STAGE(PG8_SB(0, 0), cB, voffB); PG8_STAGE(PG8_SB(0, 1), cB + hstep, voffB); PG8_STAGE(PG8_SA(0, 0), cA, voffA); PG8_STAGE(PG8_SA(0, 1), cA + hstep, voffA);
        if (wr == 1) PG8_BAR;
        PG8_WAIT_V(2); PG8_BAR;
        PG8_STAGE(PG8_SB(1, 0), cB + kstep, voffB); PG8_STAGE(PG8_SA(1, 0), cA + kstep, voffA); PG8_STAGE(PG8_SB(1, 1), cB + hstep + kstep, voffB);
        PG8_WAIT_V(6); PG8_BAR;
    } else {
        PG8_STAGE(PG8_SB(0, 0), cB, voffB); PG8_STAGE(PG8_SA(0, 0), cA, voffA); PG8_STAGE(PG8_SB(0, 1), cB + hstep, voffB); PG8_STAGE(PG8_SA(0, 1), cA + hstep, voffA);
        if (wr == 1) PG8_BAR;
        PG8_WAIT_V(4); PG8_BAR;
        PG8_STAGE(PG8_SB(1, 0), cB + kstep, voffB); PG8_STAGE(PG8_SA(1, 0), cA + kstep, voffA); PG8_STAGE(PG8_SB(1, 1), cB + hstep + kstep, voffB);
        PG8_WAIT_V(6); PG8_BAR;
    }
    for (;;) {
        const bool has_next = S.next(ui + 1, nxt);
        const char* nA = has_next ? (const char*)g.A + (size_t)nxt.pm * tstep : cA; const char* nB = has_next ? (const char*)g.Bt + (size_t)nxt.pn * tstep : cB;
        for (int t = 0; t < nt; t += 2) {
            const bool last = (t == nt - 2);
            const char* a1 = cA + (size_t)(t + 1) * kstep;
            const char* a2 = last ? nA : cA + (size_t)(t + 2) * kstep; const char* b2 = last ? nB : cB + (size_t)(t + 2) * kstep;
            const char* a3 = a2 + kstep; const char* b3 = b2 + kstep;
            if (last && has_next) S.a_ready(nxt);
            if constexpr (SP2) {
            PG8_LDB(B0, 0, 0); PG8_LDB(B1, 0, 1); PG8_SCHED; PG8_LDA(At, 0, 0); PG8_STAGE(PG8_SA(1, 1), a1 + hstep, voffA);
            PG8_WAIT_V(8); PG8_WAIT_L(0); PG8_BAR; PG8_MMA(0, 0, At, B0); PG8_MMA(0, 1, At, B1); PG8_BAR; PG8_SCHED;
            PG8_LDA(At, 0, 1); PG8_STAGE(PG8_SB(0, 0), b2, voffB); PG8_STAGE(PG8_SB(0, 1), b2 + hstep, voffB); PG8_STAGE(PG8_SA(0, 0), a2, voffA);
            PG8_WAIT_V(8); PG8_WAIT_L(0); PG8_BAR; PG8_MMA(1, 0, At, B0); PG8_MMA(1, 1, At, B1); PG8_BAR; PG8_SCHED;
            PG8_LDB(B0, 1, 0); PG8_LDB(B1, 1, 1); PG8_SCHED; PG8_LDA(At, 1, 0); PG8_STAGE(PG8_SA(0, 1), a2 + hstep, voffA);
            PG8_WAIT_V(8); PG8_WAIT_L(0); PG8_BAR; PG8_MMA(0, 0, At, B0); PG8_MMA(0, 1, At, B1); PG8_BAR; PG8_SCHED;
            PG8_LDA(At, 1, 1); PG8_STAGE(PG8_SB(1, 0), b3, voffB); PG8_STAGE(PG8_SB(1, 1), b3 + hstep, voffB); PG8_STAGE(PG8_SA(1, 0), a3, voffA);
            PG8_WAIT_V(8); PG8_WAIT_L(0); PG8_BAR; PG8_MMA(1, 0, At, B0); PG8_MMA(1, 1, At, B1); PG8_BAR; PG8_SCHED;
            } else {
            PG8_LDB(B0, 0, 0); PG8_SCHED; PG8_LDA(At, 0, 0); PG8_STAGE(PG8_SA(1, 1), a1 + hstep, voffA);
            PG8_WAIT_L(8); PG8_BAR; PG8_WAIT_L(0); PG8_MMA(0, 0, At, B0); PG8_BAR; PG8_SCHED;
            PG8_LDB(B1, 0, 1); PG8_STAGE(PG8_SB(0, 0), b2, voffB);
            PG8_BAR; PG8_WAIT_L(0); PG8_MMA(0, 1, At, B1); PG8_BAR;
            PG8_LDA(At, 0, 1); PG8_STAGE(PG8_SA(0, 0), a2, voffA);
            PG8_BAR; PG8_WAIT_L(0); PG8_MMA(1, 0, At, B0); PG8_BAR; PG8_SCHED;
            PG8_STAGE(PG8_SB(0, 1), b2 + hstep, voffB);
            PG8_WAIT_V(6); PG8_BAR; PG8_MMA(1, 1, At, B1); PG8_BAR;
            PG8_LDB(B0, 1, 0); PG8_SCHED; PG8_LDA(At, 1, 0); PG8_STAGE(PG8_SA(0, 1), a2 + hstep, voffA);
            PG8_WAIT_L(8); PG8_BAR; PG8_WAIT_L(0); PG8_MMA(0, 0, At, B0); PG8_BAR; PG8_SCHED;
            PG8_LDB(B1, 1, 1); PG8_STAGE(PG8_SB(1, 0), b3, voffB);
            PG8_BAR; PG8_WAIT_L(0); PG8_MMA(0, 1, At, B1); PG8_BAR;
            PG8_LDA(At, 1, 1); PG8_STAGE(PG8_SA(1, 0), a3, voffA);
            PG8_BAR; PG8_WAIT_L(0); PG8_MMA(1, 0, At, B0); PG8_BAR; PG8_SCHED;
            PG8_STAGE(PG8_SB(1, 1), b3 + hstep, voffB);
            PG8_WAIT_V(6); PG8_BAR; PG8_MMA(1, 1, At, B1); PG8_BAR;
            }
        }
        if constexpr (ALIGN_EPI) { if (wr == 0) PG8_BAR; }
        if constexpr (!Epi::AFTER_DRAIN) { E(acc, cur, wr, wc, fr, fq); S.done(cur); }
        if (!has_next) break;
#pragma unroll
        for (int a = 0; a < 2; ++a)
#pragma unroll
            for (int b = 0; b < 2; ++b)
#pragma unroll
                for (int m = 0; m < 4; ++m)
#pragma unroll
                    for (int n = 0; n < 2; ++n) acc[a][b][m][n] = (f32x4){0.f, 0.f, 0.f, 0.f};
        cur = nxt; cA = nA; cB = nB; ++ui;
        if constexpr (ALIGN_EPI) { if (wr == 1) PG8_BAR; }
    }
    PG8_WAIT_V(0);
    if constexpr (!ALIGN_EPI) { if (wr == 0) PG8_BAR; }
    PG8_BAR;
    if constexpr (Epi::AFTER_DRAIN) { E.fused(acc, cur, wr, wc, fr, fq, lds, wid, lane); S.done(cur); }
#undef PG8_SA
#undef PG8_SB
#undef PG8_STAGE
#undef PG8_LDA
#undef PG8_LDB
#undef PG8_MMA
#undef PG8_WAIT_V
#undef PG8_WAIT_L
#undef PG8_BAR
#undef PG8_SCHED
}
}

#define LAS __attribute__((address_space(3)))
typedef unsigned short bf16_t;
typedef short bf16x8 __attribute__((ext_vector_type(8)));
typedef short s16x4 __attribute__((ext_vector_type(4)));
typedef float f32x4 __attribute__((ext_vector_type(4)));
typedef float f32x16 __attribute__((ext_vector_type(16)));
typedef unsigned u32x4 __attribute__((ext_vector_type(4)));
typedef unsigned u32x2 __attribute__((ext_vector_type(2)));

constexpr int NB = 2, T = 8192, M = NB * T, DM = 2048, NZ = 6144, DFF = 5632, NFF2 = 11264, DEPTH = 4;
constexpr int WIN_COLS = 6156;
constexpr int ZC_AX = 0, ZC_AG = 512, ZC_BQ = 1024, ZC_BK = 1536, ZC_BV = 2048, ZC_CQ = 2560, ZC_CZ = 4096, ZC_DQ = 4608, ZC_DK = 5120, ZC_DV = 5632;
constexpr float EPS = 1e-6f;
constexpr int NTHR = 512;

constexpr size_t MiB = 1u << 20;
constexpr size_t WS_CTL = 0, WS_WIN = 1 * MiB, WS_WOUT = 97 * MiB, WS_WUP = 129 * MiB, WS_WDN = 305 * MiB, WS_WG = 393 * MiB, WS_HB = 394 * MiB, WS_ACT = 458 * MiB;
constexpr size_t WS_Z = 634 * MiB, WS_Y = 826 * MiB, WS_GL = 890 * MiB, WS_FOXC = 891 * MiB, WS_LRUA = 892 * MiB, WS_LRUU = 924 * MiB, WS_LAGG = 956 * MiB;
constexpr size_t WS_GREC = 957 * MiB, WS_GU = 1013 * MiB, WS_GLAST = 1045 * MiB, WS_OC = 1046 * MiB, WS_OD = 1078 * MiB, WS_LSE = 1126 * MiB, WS_KP = 1127 * MiB, WS_VP = 1143 * MiB, WS_END = 1159 * MiB;
constexpr size_t WS_U = 634 * MiB;
constexpr int GREC_BYTES = 57344;

constexpr int LDS_BYTES = 147456;
constexpr int LDS_MISC = 140 * 1024;

__device__ __forceinline__ unsigned f2bf(float f) { unsigned u = __builtin_bit_cast(unsigned, f); return (u + 0x7fffu + ((u >> 16) & 1u)) >> 16; }
typedef float f32x2_t __attribute__((ext_vector_type(2))); typedef __bf16 bf16x2_t __attribute__((ext_vector_type(2)));
__device__ __forceinline__ unsigned pk2(float lo, float hi) { const f32x2_t v = {lo, hi}; const bf16x2_t b = __builtin_convertvector(v, bf16x2_t); return __builtin_bit_cast(unsigned, b); }
__device__ __forceinline__ float bf2f(unsigned short u) { return __builtin_bit_cast(float, (unsigned)u << 16); }
__device__ __forceinline__ float bflo(unsigned w) { return __builtin_bit_cast(float, w << 16); }
__device__ __forceinline__ float bfhi(unsigned w) { return __builtin_bit_cast(float, w & 0xffff0000u); }
__device__ __forceinline__ float wave_sum(float v) {
#pragma unroll
    for (int o = 1; o < 64; o <<= 1) v += __shfl_xor(v, o);
    return v;
}
__device__ __forceinline__ float sigmoidf_(float x) { return 1.0f / (1.0f + __expf(-x)); }
__device__ __forceinline__ float siluf_(float x) { return x / (1.0f + __expf(-x)); }
__device__ __forceinline__ float softplusf_(float x) { return fmaxf(x, 0.f) + log1pf(__expf(-fabsf(x))); }
__device__ __forceinline__ float gelu_tanh(float x) { const float u = 0.7978845608028654f * (x + 0.044715f * x * x * x); return x * __builtin_amdgcn_rcpf(1.0f + __expf(-2.0f * u)); }
__device__ __forceinline__ int perm32(int p) { const int g = p >> 3, j = p & 7; return (j < 4) ? (4 * g + j) : (16 + 4 * g + (j - 4)); }
__device__ __forceinline__ int invperm32(int x) { return (x < 16) ? (8 * (x >> 2) + (x & 3)) : (8 * ((x - 16) >> 2) + 4 + (x & 3)); }

struct Params {
    const float* in[25];
    float* out;
    unsigned char* ws;
};
struct Ctx {
    const LAS unsigned* tab;
    __device__ __forceinline__ unsigned long long ld(int i) const {
        const LAS unsigned* t = tab; asm volatile("" : "+v"(t));
        const unsigned lo = __builtin_amdgcn_readfirstlane(t[2 * i]), hi = __builtin_amdgcn_readfirstlane(t[2 * i + 1]);
        return ((unsigned long long)hi << 32) | lo;
    }
    __device__ __forceinline__ const float* in(int i) const { return (const float*)ld(i); }
    __device__ __forceinline__ float* out() const { return (float*)ld(25); }
    __device__ __forceinline__ unsigned char* ws() const { return (unsigned char*)ld(26); }
};

__device__ __forceinline__ void p0_item(const float* W, int ldw, int ncol0, bf16_t* WT, int K, int nrow0, int k0, LAS float* scr, int lane) {
    {
        const int row = lane >> 4, c4 = (lane & 15) * 4;
        const float* src = W + (size_t)(k0 + row) * ldw + ncol0 + c4;
#pragma unroll
        for (int i = 0; i < 16; ++i) {
            const f32x4 v = *(const f32x4*)(src + (size_t)(4 * i) * ldw);
            LAS float* d = scr + (4 * i + row) * 65 + c4;
            d[0] = v.x; d[1] = v.y; d[2] = v.z; d[3] = v.w;
        }
    }
    asm volatile("s_waitcnt lgkmcnt(0)" ::: "memory");
    const int c = lane & 7, ns = lane >> 3;
#pragma unroll
    for (int j = 0; j < 8; ++j) {
        const int n = ns + 8 * j; const LAS float* s = scr + (8 * c) * 65 + n;
        u32x4 o; o.x = pk2(s[0 * 65], s[1 * 65]); o.y = pk2(s[2 * 65], s[3 * 65]); o.z = pk2(s[4 * 65], s[5 * 65]); o.w = pk2(s[6 * 65], s[7 * 65]);
        *(u32x4*)(WT + (size_t)(nrow0 + n) * K + k0 + 8 * c) = o;
    }
    asm volatile("s_waitcnt lgkmcnt(0)" ::: "memory");
}
__device__ __forceinline__ int win_orig_col(int p) { return p < 2560 ? p : (p < 4096 ? p + 4 : (p < 4608 ? p + 4 : p + 12)); }

constexpr int P0_I_IN = (DM / 64) * (NZ / 64), P0_I_OUT = (DM / 64) * (DM / 64), P0_I_UP = (DM / 64) * (NFF2 / 64), P0_I_DN = (DFF / 64) * (DM / 64);
constexpr int P0_PER_L = P0_I_IN + P0_I_OUT + P0_I_UP + P0_I_DN;
__device__ __forceinline__ void p0_do_item(const Ctx& P, int l, int r, LAS float* scr, int lane) {
    unsigned char* ws = P.ws();
    if (r < P0_I_IN) { const int nblk = NZ / 64, kb = r / nblk, nb = r % nblk;
        p0_item(P.in(2) + (size_t)l * DM * WIN_COLS, WIN_COLS, win_orig_col(64 * nb), (bf16_t*)(ws + WS_WIN) + (size_t)l * NZ * DM, DM, 64 * nb, 64 * kb, scr, lane); return; }
    r -= P0_I_IN;
    if (r < P0_I_OUT) { const int nblk = DM / 64, kb = r / nblk, nb = r % nblk;
        p0_item(P.in(18) + (size_t)l * DM * DM, DM, 64 * nb, (bf16_t*)(ws + WS_WOUT) + (size_t)l * DM * DM, DM, 64 * nb, 64 * kb, scr, lane); return; }
    r -= P0_I_OUT;
    if (r < P0_I_UP) { const int nblk = NFF2 / 64, kb = r / nblk, nb = r % nblk;
        p0_item(P.in(20) + (size_t)l * DM * NFF2, NFF2, 64 * nb, (bf16_t*)(ws + WS_WUP) + (size_t)l * NFF2 * DM, DM, 64 * nb, 64 * kb, scr, lane); return; }
    r -= P0_I_UP;
    { const int nblk = DM / 64, kb = r / nblk, nb = r % nblk;
        p0_item(P.in(23) + (size_t)l * DFF * DM, DM, 64 * nb, (bf16_t*)(ws + WS_WDN) + (size_t)l * DM * DFF, DFF, 64 * nb, 64 * kb, scr, lane); }
}
__device__ __forceinline__ void p0_prologue(const Ctx& P, LAS unsigned char* lds, int gw, int NGW, int wave, int lane) {
    LAS float* scr = (LAS float*)(lds + wave * 16640);
    for (int it = gw; it < P0_PER_L; it += NGW) p0_do_item(P, 0, it, scr, lane);
    float* WG = (float*)(P.ws() + WS_WG);
    const int gt = gw * 64 + lane, NGT = NGW * 64;
    for (int i = gt; i < DEPTH * 12 * DM; i += NGT) {
        const int l = i / (12 * DM), j = (i / DM) % 12, k = i % DM;
        const int col = (j < 4) ? (2560 + j) : (j < 8 ? 4612 + (j - 4) : 4616 + (j - 8));
        WG[i] = P.in(2)[(size_t)l * DM * WIN_COLS + (size_t)k * WIN_COLS + col];
    }
}
__device__ __forceinline__ void p0_unit(const Ctx& P, int l, int idx, LAS unsigned char* lds, int wave, int lane) {
    __syncthreads();
    const int r = idx * 8 + wave;
    if (r < P0_PER_L) p0_do_item(P, l, r, (LAS float*)(lds + wave * 16640), lane);
    __syncthreads();
}

template <bool GATES>
__device__ __forceinline__ void norm_phase(const float* src, float* copy_dst, const float* gain, bf16_t* HB, const float* WGl, float* GL,
                                           LAS unsigned char* lds, int tid, int wave, int lane, int bid, int nblk) {
    LAS float* wg = (LAS float*)lds;
    if (GATES) {
        for (int i = tid; i < 12 * DM / 4; i += NTHR) ((LAS f32x4*)wg)[i] = ((const f32x4*)WGl)[i];
        __syncthreads();
    }
    f32x4 gv[8];
#pragma unroll
    for (int j = 0; j < 8; ++j) gv[j] = ((const f32x4*)gain)[lane + 64 * j];
    f32x4 vn[8];
    {
        const f32x4* xr0 = (const f32x4*)(src + (size_t)(bid * 8 + wave) * DM);
#pragma unroll
        for (int j = 0; j < 8; ++j) vn[j] = xr0[lane + 64 * j];
    }
    for (int m = bid * 8 + wave; m < M; m += nblk * 8) {
        f32x4 v[8]; float ss = 0.f;
#pragma unroll
        for (int j = 0; j < 8; ++j) { v[j] = vn[j]; ss += (v[j].x * v[j].x + v[j].y * v[j].y) + (v[j].z * v[j].z + v[j].w * v[j].w); }
        if (m + nblk * 8 < M) {
            const f32x4* xr = (const f32x4*)(src + (size_t)(m + nblk * 8) * DM);
#pragma unroll
            for (int j = 0; j < 8; ++j) vn[j] = xr[lane + 64 * j];
        }
        if (copy_dst) {
            f32x4* cr = (f32x4*)(copy_dst + (size_t)m * DM);
#pragma unroll
            for (int j = 0; j < 8; ++j) cr[lane + 64 * j] = v[j];
        }
        const float rs = rsqrtf(wave_sum(ss) * (1.0f / DM) + EPS);
        u32x2* o8 = (u32x2*)(HB + (size_t)m * DM);
#pragma unroll
        for (int j = 0; j < 8; ++j) { v[j] = v[j] * rs * gv[j]; u32x2 w; w.x = pk2(v[j].x, v[j].y); w.y = pk2(v[j].z, v[j].w); o8[lane + 64 * j] = w; }
        if (GATES) {
            float myv = 0.f;
#pragma unroll 1
            for (int g = 0; g < 12; ++g) {
                float a = 0.f;
#pragma unroll
                for (int j = 0; j < 8; ++j) { const f32x4 w = ((LAS f32x4*)(wg + g * DM))[lane + 64 * j]; a += (v[j].x * w.x + v[j].y * w.y) + (v[j].z * w.z + v[j].w * w.w); }
                a = wave_sum(a);
                if (lane == g) myv = a;
            }
            if (lane < 12) GL[(size_t)m * 16 + lane] = myv;
        }
    }
    if (GATES) __syncthreads();
}

__device__ __forceinline__ void norm_gates_phase(const float* src, float* copy_dst, const float* gain, bf16_t* HB, const float* WGl, float* GL,
                                                 LAS unsigned char* lds, int tid, int wave, int lane, int bid, int nblk) {
    constexpr int NR = 2;
    LAS float* wg = (LAS float*)lds;
    for (int i = tid; i < 12 * DM / 4; i += NTHR) ((LAS f32x4*)wg)[i] = ((const f32x4*)WGl)[i];
    __syncthreads();
    const int stride = nblk * 8;
    for (int m = bid * 8 + wave; m < M; m += NR * stride) {
        int mr[NR];
#pragma unroll
        for (int r = 0; r < NR; ++r) mr[r] = (m + r * stride < M) ? m + r * stride : m;
        f32x4 v[NR][8]; float ss[NR];
#pragma unroll
        for (int r = 0; r < NR; ++r) { const f32x4* xr = (const f32x4*)(src + (size_t)mr[r] * DM);
#pragma unroll
            for (int j = 0; j < 8; ++j) v[r][j] = xr[lane + 64 * j]; }
#pragma unroll
        for (int r = 0; r < NR; ++r) { float s = 0.f;
#pragma unroll
            for (int j = 0; j < 8; ++j) s += (v[r][j].x * v[r][j].x + v[r][j].y * v[r][j].y) + (v[r][j].z * v[r][j].z + v[r][j].w * v[r][j].w);
            ss[r] = s; }
        if (copy_dst) {
#pragma unroll
            for (int r = 0; r < NR; ++r) { f32x4* cr = (f32x4*)(copy_dst + (size_t)mr[r] * DM);
#pragma unroll
                for (int j = 0; j < 8; ++j) cr[lane + 64 * j] = v[r][j]; }
        }
#pragma unroll
        for (int o = 1; o < 64; o <<= 1) {
#pragma unroll
            for (int r = 0; r < NR; ++r) ss[r] += __shfl_xor(ss[r], o);
        }
#pragma unroll
        for (int r = 0; r < NR; ++r) {
            const float rs = rsqrtf(ss[r] * (1.0f / DM) + EPS);
            u32x2* o8 = (u32x2*)(HB + (size_t)mr[r] * DM);
#pragma unroll
            for (int j = 0; j < 8; ++j) { const f32x4 g = ((const f32x4*)gain)[lane + 64 * j]; v[r][j] = v[r][j] * rs * g;
                u32x2 w; w.x = pk2(v[r][j].x, v[r][j].y); w.y = pk2(v[r][j].z, v[r][j].w); o8[lane + 64 * j] = w; }
        }
        float y[NR];
#pragma unroll
        for (int r = 0; r < NR; ++r) y[r] = 0.f;
#pragma unroll 1
        for (int g = 0; g < 12; ++g) {
            float a[NR];
#pragma unroll
            for (int r = 0; r < NR; ++r) a[r] = 0.f;
#pragma unroll
            for (int j = 0; j < 8; ++j) { const f32x4 w = ((LAS f32x4*)(wg + g * DM))[lane + 64 * j];
#pragma unroll
                for (int r = 0; r < NR; ++r) a[r] += (v[r][j].x * w.x + v[r][j].y * w.y) + (v[r][j].z * w.z + v[r][j].w * w.w); }
#pragma unroll
            for (int o = 1; o < 64; o <<= 1) {
#pragma unroll
                for (int r = 0; r < NR; ++r) a[r] += __shfl_xor(a[r], o);
            }
            if (lane == g) {
#pragma unroll
                for (int r = 0; r < NR; ++r) y[r] = a[r];
            }
        }
        if (lane < 12) {
#pragma unroll
            for (int r = 0; r < NR; ++r) GL[(size_t)mr[r] * 16 + lane] = y[r];
        }
    }
    __syncthreads();
}

__device__ __forceinline__ void final_norm_phase(float* X, const float* gain, int wave, int lane, int bid, int nblk) {
    f32x4 gv[8];
#pragma unroll
    for (int j = 0; j < 8; ++j) gv[j] = ((const f32x4*)gain)[lane + 64 * j];
    for (int m = bid * 8 + wave; m < M; m += nblk * 8) {
        f32x4* xr = (f32x4*)(X + (size_t)m * DM);
        f32x4 v[8]; float ss = 0.f;
#pragma unroll
        for (int j = 0; j < 8; ++j) { v[j] = xr[lane + 64 * j]; ss += (v[j].x * v[j].x + v[j].y * v[j].y) + (v[j].z * v[j].z + v[j].w * v[j].w); }
        const float rs = rsqrtf(wave_sum(ss) * (1.0f / DM) + EPS);
#pragma unroll
        for (int j = 0; j < 8; ++j) xr[lane + 64 * j] = v[j] * rs * gv[j];
    }
}

struct EpiBf16NT {
    static constexpr bool PERM = true, AFTER_DRAIN = false;
    bf16_t* O; int ldc;
    __device__ __forceinline__ void operator()(const pg8::f32x4 (&acc)[2][2][4][2], const pg8::Unit& u, int wr, int wc, int fr, int fq) const {
        const int row0 = u.pm * 256 + wr * 64 + fr; const int col0 = u.pn * 256 + wc * 32 + 8 * fq;
#pragma unroll
        for (int ai = 0; ai < 2; ++ai)
#pragma unroll
            for (int m = 0; m < 4; ++m) {
                bf16_t* rowp = O + (size_t)(row0 + ai * 128 + m * 16) * ldc + col0;
#pragma unroll
                for (int bj = 0; bj < 2; ++bj) {
                    const pg8::f32x4 v0 = acc[ai][bj][m][0], v1 = acc[ai][bj][m][1];
                    u32x4 w; w.x = pk2(v0[0], v0[1]); w.y = pk2(v0[2], v0[3]); w.z = pk2(v1[0], v1[1]); w.w = pk2(v1[2], v1[3]);
                    __builtin_nontemporal_store(w, (u32x4*)(rowp + bj * 128));
                }
            }
    }
};
struct EpiResAdd {
    static constexpr bool PERM = true, AFTER_DRAIN = false;
    float* X; int ldc;
    __device__ __forceinline__ void operator()(const pg8::f32x4 (&acc)[2][2][4][2], const pg8::Unit& u, int wr, int wc, int fr, int fq) const {
#pragma unroll
        for (int ai = 0; ai < 2; ++ai)
#pragma unroll
            for (int m = 0; m < 4; ++m) {
                float* rowp = X + (size_t)(u.pm * 256 + ai * 128 + wr * 64 + m * 16 + fr) * ldc + u.pn * 256 + wc * 32 + 8 * fq;
                pg8::f32x4 v[2][2];
#pragma unroll
                for (int bj = 0; bj < 2; ++bj)
#pragma unroll
                    for (int n = 0; n < 2; ++n) v[bj][n] = *(const pg8::f32x4*)(rowp + bj * 128 + n * 4);
#pragma unroll
                for (int bj = 0; bj < 2; ++bj)
#pragma unroll
                    for (int n = 0; n < 2; ++n) *(pg8::f32x4*)(rowp + bj * 128 + n * 4) = v[bj][n] + acc[ai][bj][m][n];
            }
    }
};
#define XB_TMO      128
#define XB_XCNT(j)  (256  + 64 * (j))
#define XB_XSUB(j)  (1280 + 64 * (j))
#define XB_XGEN(j)  (2304 + 64 * (j))
#define XB_TOP      3328
#define XB_TOPGEN   3392
#define XCD_BAR_WORDS 3456
#define XB_SPIN_CAP (1u << 18)

__device__ __forceinline__ unsigned xb_ld(unsigned* p)              { return __hip_atomic_load(p, __ATOMIC_RELAXED, __HIP_MEMORY_SCOPE_AGENT); }
__device__ __forceinline__ unsigned xb_add(unsigned* p, unsigned v) { return __hip_atomic_fetch_add(p, v, __ATOMIC_RELAXED, __HIP_MEMORY_SCOPE_AGENT); }
__device__ __forceinline__ unsigned xb_xcc_id() { return (unsigned)__builtin_amdgcn_s_getreg((3 << 11) | 20) & 0xFu; }
#define XB_SPIN(cond, bar) do { unsigned _sp = 0; while (cond) { __builtin_amdgcn_s_sleep(1); \
    if ((++_sp & 255u) == 0u) { if (xb_ld(&(bar)[XB_TMO])) break; if (_sp > XB_SPIN_CAP) { atomicAdd(&(bar)[XB_TMO], 1u); break; } } } } while (0)

struct XcdBarrier {
    unsigned* bar; unsigned x;
    volatile LAS unsigned* st;
};

__device__ __forceinline__ XcdBarrier xcd_barrier_post(unsigned* bar, volatile LAS unsigned* st) {
    XcdBarrier b; b.bar = bar; b.x = xb_xcc_id(); b.st = st;
    if (threadIdx.x == 0) (void)xb_add(&bar[XB_XCNT(b.x)], 1u);
    return b;
}
__device__ __forceinline__ void xcd_barrier_complete(unsigned* bar, unsigned x, unsigned& nloc, unsigned& nx) {
    const unsigned G = gridDim.x * gridDim.y * gridDim.z;
    unsigned sum, cnt, mine, sp = 0u;
    for (;;) {
        sum = 0u; cnt = 0u; mine = 0u;
#pragma unroll
        for (unsigned j = 0; j < 16; ++j) { const unsigned c = xb_ld(&bar[XB_XCNT(j)]); sum += c; cnt += (c > 0u) ? 1u : 0u; mine = (j == x) ? c : mine; }
        if (sum == G) break;
        __builtin_amdgcn_s_sleep(1);
        if ((++sp & 255u) == 0u) { if (xb_ld(&bar[XB_TMO])) break; if (sp > XB_SPIN_CAP) { atomicAdd(&bar[XB_TMO], 1u); break; } }
    }
    nloc = mine > 0u ? mine : 1u; nx = cnt > 0u ? cnt : 1u;
}

__device__ __forceinline__ void xcd_barrier(const XcdBarrier& b) {
    asm volatile("s_waitcnt vmcnt(0)" ::: "memory");
    __syncthreads();
    if (threadIdx.x == 0) {
        unsigned* bar = b.bar;
        __builtin_amdgcn_s_waitcnt(0);
        unsigned nloc = b.st[0], nx = b.st[1];
        if (nloc == 0u) { xcd_barrier_complete(bar, b.x, nloc, nx); b.st[0] = nloc; b.st[1] = nx; }
        const unsigned old = xb_add(&bar[XB_XSUB(b.x)], 1u);
        const unsigned gen = old / nloc;
        if (old + 1u == (gen + 1u) * nloc) {
            __builtin_amdgcn_fence(__ATOMIC_RELEASE, "agent");
            asm volatile("s_waitcnt vmcnt(0)" ::: "memory");
            const unsigned og = xb_add(&bar[XB_TOP], 1u);
            const unsigned tg = og / nx;
            if (og + 1u == (tg + 1u) * nx) xb_add(&bar[XB_TOPGEN], 1u);
            else XB_SPIN(xb_ld(&bar[XB_TOPGEN]) == tg, bar);
            __builtin_amdgcn_fence(__ATOMIC_ACQUIRE, "agent");
            xb_add(&bar[XB_XGEN(b.x)], 1u);
            asm volatile("s_waitcnt vmcnt(0)" ::: "memory");
        } else {
            XB_SPIN(xb_ld(&bar[XB_XGEN(b.x)]) == gen, bar);
            __builtin_amdgcn_fence(__ATOMIC_ACQUIRE, "agent");
            asm volatile("s_waitcnt vmcnt(0)" ::: "memory");
        }
    }
    __syncthreads();
}

__device__ __forceinline__ void lru_chunk_unit(const Ctx& P, int l, int unit, LAS unsigned char* lds, int tid, int wave, int lane) {
    const bf16_t* Z = (const bf16_t*)(P.ws() + WS_Z);
    float* LA = (float*)(P.ws() + WS_LRUA); float* LU = (float*)(P.ws() + WS_LRUU); float* AGG = (float*)(P.ws() + WS_LAGG);
    const int b = unit >> 7, ck = unit & 127, t0 = ck * 64; const size_t m0 = (size_t)b * T + t0;
    const int ch = tid;
    LAS float* xw = (LAS float*)(lds + wave * 16384);
    {
        const int cg8 = tid & 63, tg = tid >> 6, c0 = 8 * cg8, tb = 8 * tg;
        const float* cw = P.in(3) + (size_t)l * 4 * 512 + c0; const float* cbp = P.in(4) + l * 512 + c0;
        f32x4 w[4][2], bb[2];
#pragma unroll
        for (int k = 0; k < 4; ++k) { w[k][0] = *(const f32x4*)(cw + k * 512); w[k][1] = *(const f32x4*)(cw + k * 512 + 4); }
        bb[0] = *(const f32x4*)cbp; bb[1] = *(const f32x4*)(cbp + 4);
        u32x4 r[11];
#pragma unroll
        for (int j = 0; j < 11; ++j) {
            const int tt = t0 + tb + j - 3;
            if (tt >= 0) r[j] = *(const u32x4*)(Z + (m0 + tb + j - 3) * NZ + ZC_AX + c0); else r[j] = (u32x4){0u, 0u, 0u, 0u};
        }
        LAS float* xt = (LAS float*)(lds + (cg8 >> 3) * 16384) + (c0 & 63);
#pragma unroll
        for (int t = 0; t < 8; ++t) {
            f32x4 o0, o1;
#pragma unroll
            for (int q = 0; q < 4; ++q) {
                const float lo = bb[q >> 1][(2 * q) & 3] + w[0][q >> 1][(2 * q) & 3] * bflo(r[t][q]) + w[1][q >> 1][(2 * q) & 3] * bflo(r[t + 1][q]) + w[2][q >> 1][(2 * q) & 3] * bflo(r[t + 2][q]) + w[3][q >> 1][(2 * q) & 3] * bflo(r[t + 3][q]);
                const float hi = bb[q >> 1][(2 * q + 1) & 3] + w[0][q >> 1][(2 * q + 1) & 3] * bfhi(r[t][q]) + w[1][q >> 1][(2 * q + 1) & 3] * bfhi(r[t + 1][q]) + w[2][q >> 1][(2 * q + 1) & 3] * bfhi(r[t + 2][q]) + w[3][q >> 1][(2 * q + 1) & 3] * bfhi(r[t + 3][q]);
                if (q < 2) { o0[2 * q] = lo; o0[2 * q + 1] = hi; } else { o1[2 * (q - 2)] = lo; o1[2 * (q - 2) + 1] = hi; }
            }
            *(LAS f32x4*)(xt + (tb + t) * 64) = o0; *(LAS f32x4*)(xt + (tb + t) * 64 + 4) = o1;
        }
    }
    __syncthreads();
    const float* wa = P.in(5) + ((size_t)l * 8 + wave) * 4096; const float* wx = P.in(7) + ((size_t)l * 8 + wave) * 4096;
    const float ba = P.in(6)[l * 512 + ch], bx = P.in(8)[l * 512 + ch];
    const float lam = P.in(9)[l * 512 + ch]; const float sp = softplusf_(-lam);
    float h = 0.f, ap = 1.f;
    for (int half = 0; half < 2; ++half) {
        float ra[32], ia[32];
#pragma unroll
        for (int t = 0; t < 32; ++t) { ra[t] = ba; ia[t] = bx; }
        float n0 = wa[lane], n1 = wa[64 + lane], n2 = wa[128 + lane], n3 = wa[192 + lane], n4 = wx[lane], n5 = wx[64 + lane], n6 = wx[128 + lane], n7 = wx[192 + lane];
        for (int c = 0; c < 64; c += 4) {
            const float a0 = n0, a1 = n1, a2 = n2, a3 = n3, b0 = n4, b1 = n5, b2 = n6, b3 = n7;
            { const int cn = (c + 4 < 64) ? c + 4 : c;
              n0 = wa[(cn + 0) * 64 + lane]; n1 = wa[(cn + 1) * 64 + lane]; n2 = wa[(cn + 2) * 64 + lane]; n3 = wa[(cn + 3) * 64 + lane];
              n4 = wx[(cn + 0) * 64 + lane]; n5 = wx[(cn + 1) * 64 + lane]; n6 = wx[(cn + 2) * 64 + lane]; n7 = wx[(cn + 3) * 64 + lane]; }
#pragma unroll
            for (int t = 0; t < 32; ++t) {
                const f32x4 xv = *(const LAS f32x4*)(xw + (half * 32 + t) * 64 + c);
                ra[t] += xv.x * a0 + xv.y * a1 + xv.z * a2 + xv.w * a3;
                ia[t] += xv.x * b0 + xv.y * b1 + xv.z * b2 + xv.w * b3;
            }
        }
#pragma unroll
        for (int t = 0; t < 32; ++t) {
            const int tt = half * 32 + t;
            const float r = sigmoidf_(ra[t]), ig = sigmoidf_(ia[t]);
            const float log_a = -8.0f * r * sp;
            const float a = __expf(log_a);
            const float u = __builtin_amdgcn_sqrtf(fmaxf(1.0f - a * a, 0.f)) * (ig * xw[tt * 64 + lane]);
            LA[(m0 + tt) * 512 + ch] = a; LU[(m0 + tt) * 512 + ch] = u;
            h = a * h + u; ap *= a;
        }
    }
    AGG[((size_t)unit * 2 + 0) * 512 + ch] = ap; AGG[((size_t)unit * 2 + 1) * 512 + ch] = h;
}

__device__ __forceinline__ void fox_cumsum_unit(const Ctx& P, int l, int unit, LAS unsigned char* lds, int tid, int wave, int lane) {
    const float* GL = (const float*)(P.ws() + WS_GL); float* FC = (float*)(P.ws() + WS_FOXC);
    const int b = unit >> 2, hh = unit & 3; const float fb = P.in(10)[l * 4 + hh];
    LAS float* wtot = (LAS float*)lds;
    float v[16]; float s = 0.f;
#pragma unroll
    for (int i = 0; i < 16; ++i) { const float x = GL[((size_t)b * T + tid * 16 + i) * 16 + hh] + fb; const float lf = fminf(x, 0.f) - log1pf(__expf(-fabsf(x))); s += lf; v[i] = s; }
    float sc = s;
#pragma unroll
    for (int o = 1; o < 64; o <<= 1) { const float n = __shfl_up(sc, o); if (lane >= o) sc += n; }
    __syncthreads();
    if (lane == 63) wtot[wave] = sc;
    __syncthreads();
    float base = sc - s;
    for (int w = 0; w < wave; ++w) base += wtot[w];
#pragma unroll
    for (int i = 0; i < 16; ++i) FC[((size_t)unit) * T + tid * 16 + i] = (base + v[i]) * 1.4426950408889634f;
    __syncthreads();
}

__device__ __forceinline__ void gdn_prep_unit(const Ctx& P, int l, int unit, LAS unsigned char* lds, int tid, int wave, int lane) {
    const bf16_t* Z = (const bf16_t*)(P.ws() + WS_Z); const float* GL = (const float*)(P.ws() + WS_GL);
    const int bh = unit >> 7, n = unit & 127, b = bh >> 2, hh = bh & 3; const size_t m0 = (size_t)b * T + n * 64;
    LAS float* Kf = (LAS float*)lds; LAS float* Qf = Kf + 64 * 132; LAS float* Vf = Qf + 64 * 132; LAS float* KK = Vf + 64 * 132; LAS float* QKm = KK + 64 * 68;
    LAS float* gcs = QKm + 64 * 68; LAS float* bet = gcs + 64; LAS float* eg = bet + 64;
    __syncthreads();
    {
        const int cg = tid & 15, tg = tid >> 4, tb = 2 * tg;
        const float* cw = P.in(11) + (size_t)l * 4 * 1536;
#pragma unroll
        for (int part = 0; part < 3; ++part) {
            const int cc = part * 512 + hh * 128 + 8 * cg; const int zc = ZC_CQ + cc;
            f32x4 w[4][2];
#pragma unroll
            for (int k = 0; k < 4; ++k) { w[k][0] = *(const f32x4*)(cw + k * 1536 + cc); w[k][1] = *(const f32x4*)(cw + k * 1536 + cc + 4); }
            u32x4 r[5];
#pragma unroll
            for (int j = 0; j < 5; ++j) {
                const int tt = n * 64 + tb + j - 3;
                if (tt >= 0) r[j] = *(const u32x4*)(Z + (m0 + tb + j - 3) * NZ + zc); else r[j] = (u32x4){0u, 0u, 0u, 0u};
            }
            LAS float* dst = ((part == 0) ? Qf : (part == 1 ? Kf : Vf)) + 8 * cg;
#pragma unroll
            for (int t = 0; t < 2; ++t) {
                f32x4 o0, o1;
#pragma unroll
                for (int q = 0; q < 4; ++q) {
                    const float lo = w[0][q >> 1][(2 * q) & 3] * bflo(r[t][q]) + w[1][q >> 1][(2 * q) & 3] * bflo(r[t + 1][q]) + w[2][q >> 1][(2 * q) & 3] * bflo(r[t + 2][q]) + w[3][q >> 1][(2 * q) & 3] * bflo(r[t + 3][q]);
                    const float hi = w[0][q >> 1][(2 * q + 1) & 3] * bfhi(r[t][q]) + w[1][q >> 1][(2 * q + 1) & 3] * bfhi(r[t + 1][q]) + w[2][q >> 1][(2 * q + 1) & 3] * bfhi(r[t + 2][q]) + w[3][q >> 1][(2 * q + 1) & 3] * bfhi(r[t + 3][q]);
                    if (q < 2) { o0[2 * q] = siluf_(lo); o0[2 * q + 1] = siluf_(hi); } else { o1[2 * (q - 2)] = siluf_(lo); o1[2 * (q - 2) + 1] = siluf_(hi); }
                }
                *(LAS f32x4*)(dst + (tb + t) * 132) = o0; *(LAS f32x4*)(dst + (tb + t) * 132 + 4) = o1;
            }
        }
        if (tid < 64) {
            const float bl = GL[(m0 + tid) * 16 + 4 + hh], al = GL[(m0 + tid) * 16 + 8 + hh];
            const float g = -__expf(P.in(12)[l * 4 + hh]) * softplusf_(al + P.in(13)[l * 4 + hh]);
            float sc = g;
#pragma unroll
            for (int o = 1; o < 64; o <<= 1) { const float nn = __shfl_up(sc, o); if (lane >= o) sc += nn; }
            gcs[tid] = sc; eg[tid] = __expf(sc); bet[tid] = sigmoidf_(bl);
        }
    }
    __syncthreads();
    {
        for (int i = tid; i < 2 * 64 * 68; i += NTHR) KK[i] = 0.f;
        const int row = tid >> 2, j = tid & 3; LAS float* base = (row < 64) ? (Qf + row * 132) : (Kf + (row - 64) * 132);
        float ss = 0.f;
#pragma unroll 8
        for (int e = 0; e < 32; ++e) { const float x = base[4 * e + j]; ss += x * x; }
        ss += __shfl_xor(ss, 1); ss += __shfl_xor(ss, 2);
        const float rn = rsqrtf(ss + EPS) * ((row < 64) ? 0.08838834764831845f : 1.0f);
#pragma unroll 8
        for (int e = 0; e < 32; ++e) base[4 * e + j] *= rn;
    }
    __syncthreads();
    {
        const int fr = lane & 15, g = lane >> 4;
        for (int ti = wave; ti < 10; ti += 8) {
            const int it = (ti < 1) ? 0 : (ti < 3 ? 1 : (ti < 6 ? 2 : 3));
            const int jt = ti - ((it * (it + 1)) >> 1);
            const LAS float* AK = Kf + (16 * it + fr) * 132 + 8 * g;
            const LAS float* AQ = Qf + (16 * it + fr) * 132 + 8 * g;
            const LAS float* Brow = Kf + (16 * jt + fr) * 132 + 8 * g;
            f32x4 accK = {0.f, 0.f, 0.f, 0.f}, accQ = {0.f, 0.f, 0.f, 0.f};
#pragma unroll
            for (int ks = 0; ks < 4; ++ks) {
                const f32x4 b0 = *(const LAS f32x4*)(Brow + 32 * ks), b1 = *(const LAS f32x4*)(Brow + 32 * ks + 4);
                u32x4 bh, bl;
                bh.x = pk2(b0.x, b0.y); bh.y = pk2(b0.z, b0.w); bh.z = pk2(b1.x, b1.y); bh.w = pk2(b1.z, b1.w);
                bl.x = pk2(b0.x - bflo(bh.x), b0.y - bfhi(bh.x)); bl.y = pk2(b0.z - bflo(bh.y), b0.w - bfhi(bh.y)); bl.z = pk2(b1.x - bflo(bh.z), b1.y - bfhi(bh.z)); bl.w = pk2(b1.z - bflo(bh.w), b1.w - bfhi(bh.w));
                const bf16x8 BH = __builtin_bit_cast(bf16x8, bh), BL = __builtin_bit_cast(bf16x8, bl);
#pragma unroll
                for (int kind = 0; kind < 2; ++kind) {
                    const LAS float* Ar = (kind == 0) ? AK : AQ;
                    const f32x4 a0 = *(const LAS f32x4*)(Ar + 32 * ks), a1 = *(const LAS f32x4*)(Ar + 32 * ks + 4);
                    u32x4 ah, al;
                    ah.x = pk2(a0.x, a0.y); ah.y = pk2(a0.z, a0.w); ah.z = pk2(a1.x, a1.y); ah.w = pk2(a1.z, a1.w);
                    al.x = pk2(a0.x - bflo(ah.x), a0.y - bfhi(ah.x)); al.y = pk2(a0.z - bflo(ah.y), a0.w - bfhi(ah.y)); al.z = pk2(a1.x - bflo(ah.z), a1.y - bfhi(ah.z)); al.w = pk2(a1.z - bflo(ah.w), a1.w - bfhi(ah.w));
                    const bf16x8 AH = __builtin_bit_cast(bf16x8, ah), AL = __builtin_bit_cast(bf16x8, al);
                    if (kind == 0) { accK = __builtin_amdgcn_mfma_f32_16x16x32_bf16(AL, BH, accK, 0, 0, 0); accK = __builtin_amdgcn_mfma_f32_16x16x32_bf16(AH, BL, accK, 0, 0, 0); accK = __builtin_amdgcn_mfma_f32_16x16x32_bf16(AH, BH, accK, 0, 0, 0); }
                    else           { accQ = __builtin_amdgcn_mfma_f32_16x16x32_bf16(AL, BH, accQ, 0, 0, 0); accQ = __builtin_amdgcn_mfma_f32_16x16x32_bf16(AH, BL, accQ, 0, 0, 0); accQ = __builtin_amdgcn_mfma_f32_16x16x32_bf16(AH, BH, accQ, 0, 0, 0); }
                }
            }
            const int j = 16 * jt + fr; const float gj = gcs[j];
#pragma unroll
            for (int i4 = 0; i4 < 4; ++i4) {
                const int i = 16 * it + 4 * g + i4;
                const float dec = (j <= i) ? __expf(gcs[i] - gj) : 0.f;
                KK[i * 68 + j] = (j < i) ? accK[i4] * bet[i] * dec : 0.f;
                QKm[i * 68 + j] = accQ[i4] * dec;
            }
        }
    }
    __syncthreads();
    unsigned char* rec = P.ws() + WS_GREC + (size_t)unit * GREC_BYTES;
    {
#pragma unroll
        for (int it = 0; it < 2; ++it) {
            const int chunk = tid + it * NTHR, c = chunk >> 4, p0 = (chunk & 15) * 8; const float e = eg[c]; float v[8];
#pragma unroll
            for (int j = 0; j < 8; ++j) v[j] = Qf[c * 132 + (p0 & ~31) + perm32((p0 & 31) + j)] * e;
            u32x4 o; o.x = pk2(v[0], v[1]); o.y = pk2(v[2], v[3]); o.z = pk2(v[4], v[5]); o.w = pk2(v[6], v[7]);
            *(u32x4*)(rec + 16384 + (size_t)(c * 128 + p0) * 2) = o;
        }
        {
            const int i = tid >> 3, p0 = (tid & 7) * 8; float v[8];
#pragma unroll
            for (int j = 0; j < 8; ++j) v[j] = QKm[i * 68 + (p0 & ~31) + perm32((p0 & 31) + j)];
            u32x4 o; o.x = pk2(v[0], v[1]); o.y = pk2(v[2], v[3]); o.z = pk2(v[4], v[5]); o.w = pk2(v[6], v[7]);
            *(u32x4*)(rec + 32768 + (size_t)(i * 64 + p0) * 2) = o;
        }
        const float glast = gcs[63];
#pragma unroll
        for (int it = 0; it < 2; ++it) {
            const int chunk = tid + it * NTHR, dk = chunk & 127, p0 = (chunk >> 7) * 8; float v[8];
#pragma unroll
            for (int j = 0; j < 8; ++j) { const int c = (p0 & ~31) + perm32((p0 & 31) + j); v[j] = Kf[c * 132 + dk] * __expf(glast - gcs[c]); }
            u32x4 o; o.x = pk2(v[0], v[1]); o.y = pk2(v[2], v[3]); o.z = pk2(v[4], v[5]); o.w = pk2(v[6], v[7]);
            *(u32x4*)(rec + 40960 + (size_t)(dk * 64 + p0) * 2) = o;
        }
        if (tid == 0) ((float*)(P.ws() + WS_GLAST))[unit] = __expf(glast);
    }
    if (tid < 256) {
        const int col = tid; float sol[64];
        if (col < 128) {
#pragma unroll
            for (int j = 0; j < 64; ++j) sol[j] = Vf[j * 132 + col] * bet[j];
        } else {
#pragma unroll
            for (int j = 0; j < 64; ++j) sol[j] = Kf[j * 132 + (col - 128)] * bet[j] * eg[j];
        }
#pragma unroll
        for (int i = 1; i < 64; ++i) {
            float acc0 = 0.f, acc1 = 0.f, acc2 = 0.f, acc3 = 0.f;
#pragma unroll
            for (int j4 = 0; j4 < (i + 3) / 4; ++j4) {
                const f32x4 kk = *(const LAS f32x4*)(KK + i * 68 + 4 * j4);
                acc0 += kk.x * sol[4 * j4 + 0]; acc1 += kk.y * sol[4 * j4 + 1]; acc2 += kk.z * sol[4 * j4 + 2]; acc3 += kk.w * sol[4 * j4 + 3];
            }
            sol[i] = sol[i] - ((acc0 + acc1) + (acc2 + acc3));
        }
        if (col < 128) {
            float* U = (float*)(P.ws() + WS_GU) + (size_t)unit * 8192;
#pragma unroll
            for (int i = 0; i < 64; ++i) U[i * 128 + col] = sol[i];
        } else {
            const int dk = col - 128; const int pos = (dk & ~31) + invperm32(dk & 31);
            bf16_t* Wp = (bf16_t*)rec;
#pragma unroll
            for (int i = 0; i < 64; ++i) Wp[i * 128 + pos] = (bf16_t)f2bf(-sol[i]);
        }
    }
    __syncthreads();
}

__device__ __forceinline__ void kv_pack_unit(const Ctx& P, int unit, int tid) {
    const bf16_t* Z = (const bf16_t*)(P.ws() + WS_Z);
    const int bh = unit >> 5, blk = unit & 31, b = bh >> 2, hh = bh & 3;
    u32x4* KP = (u32x4*)(P.ws() + WS_KP) + ((size_t)bh * T + blk * 256) * 16; u32x4* VP = (u32x4*)(P.ws() + WS_VP) + ((size_t)bh * T + blk * 256) * 16;
    u32x4 kv[8], vv[8];
#pragma unroll
    for (int i = 0; i < 8; ++i) { const int c = tid + i * NTHR, row = c >> 4, ch = c & 15;
        const bf16_t* rp = Z + ((size_t)b * T + blk * 256 + row) * NZ + hh * 128 + ch * 8;
        kv[i] = *(const u32x4*)(rp + ZC_BK); vv[i] = *(const u32x4*)(rp + ZC_BV); }
#pragma unroll
    for (int i = 0; i < 8; ++i) { const int c = tid + i * NTHR; KP[c] = kv[i]; VP[c] = vv[i]; }
}


constexpr int AT_KSTR = 272, AT_VSTR = 320;
constexpr int AT_KBUF = 64 * AT_KSTR, AT_VBUF = 64 * AT_VSTR;
constexpr int AT_BUFSZ = 38 * 1024;

__device__ __forceinline__ s16x4 vtr(const LAS unsigned char* p) {
    typedef short v4i16_t __attribute__((ext_vector_type(4)));
    return __builtin_bit_cast(s16x4, __builtin_amdgcn_ds_read_tr16_b64_v4i16((LAS v4i16_t*)p));
}

template <int MODE>
__device__ __forceinline__ void attn_unit(const Ctx& P, int l, LAS unsigned char* lds, int tid, int wave, int lane,
                                          int b, int hh, int dil, int res, int m0, int branch) {
    const bf16_t* Z = (const bf16_t*)(P.ws() + WS_Z);
    const int qcol = (MODE == 0 ? ZC_BQ : ZC_DQ) + hh * 128, kcol = (MODE == 0 ? ZC_BK : ZC_DK) + hh * 128, vcol = (MODE == 0 ? ZC_BV : ZC_DV) + hh * 128;
    const size_t rowbase = (size_t)b * T + res;
    const float* FC = (const float*)(P.ws() + WS_FOXC) + (size_t)(b * 4 + hh) * T;
    const int ql = lane & 31, hi = lane >> 5;
    const int mq_lo = m0 + 32 * wave, mq = mq_lo + ql, mq_hi = mq_lo + 31;
    const int kt_lo = (MODE == 0) ? 0 : ((m0 >= 128 ? m0 - 128 : 0) >> 6), kt_hi = (m0 >> 6) + 3;
#ifdef PROBE_DBL_S
    constexpr float SC2 = 0.5f * 0.08838834764831845f * 1.4426950408889634f, L2E = 1.4426950408889634f;
#else
    constexpr float SC2 = 0.08838834764831845f * 1.4426950408889634f, L2E = 1.4426950408889634f;
#endif


    bf16x8 qf[8];
    {
        const bf16_t* qp = Z + (rowbase + (size_t)mq * dil) * NZ + qcol + 8 * hi;
#pragma unroll
        for (int ks = 0; ks < 8; ++ks) qf[ks] = *(const bf16x8*)(qp + 16 * ks);
    }
    float cq2 = 0.f;
    if (MODE == 0) cq2 = FC[mq];

    const unsigned rstride = (unsigned)dil * NZ * 2u;
    unsigned goff[5];
#pragma unroll
    for (int i = 0; i < 5; ++i) {
        const int I = wave + 8 * i; unsigned gof = 0u;
        if (I < 17) { const int o = 1024 * I + 16 * lane, row = o / AT_KSTR, cb = o - row * AT_KSTR; gof = (unsigned)row * rstride + (unsigned)kcol * 2u + (unsigned)(cb < 256 ? cb : 0); }
        else if (I < 37) { const int o = 1024 * (I - 17) + 16 * lane, row = o / AT_VSTR, cb = o - row * AT_VSTR; gof = (unsigned)row * rstride + (unsigned)vcol * 2u + (unsigned)(cb < 256 ? cb : 0); }
        goff[i] = gof;
    }
#define AT_ISSUE(kt_, slot_) do { \
        const unsigned char* tb_ = (const unsigned char*)(Z + (rowbase + (size_t)(64 * (kt_)) * dil) * NZ); \
        LAS unsigned char* lb_ = lds + (slot_) * AT_BUFSZ + 1024 * wave; \
        _Pragma("unroll") for (int i_ = 0; i_ < 4; ++i_) \
            __builtin_amdgcn_global_load_lds((const unsigned*)(tb_ + goff[i_]), (LAS unsigned*)(lb_ + 8192 * i_), 16, 0, 0); \
        { const int I_ = wave + 32; \
          const unsigned char* src_ = tb_ + goff[4]; \
          if (MODE == 0 && I_ == 37) src_ = (const unsigned char*)(FC + 64 * (kt_) + 4 * (lane & 15)); \
          LAS unsigned char* dst_ = (I_ < 38) ? (lb_ + 8192 * 4) : (lds + 3 * AT_BUFSZ + 1024 * (I_ - 38)); \
          __builtin_amdgcn_global_load_lds((const unsigned*)src_, (LAS unsigned*)dst_, 16, 0, 0); } \
    } while (0)
#define AT_WAITBAR(n_) do { asm volatile("s_waitcnt vmcnt(" #n_ ")" ::: "memory"); __builtin_amdgcn_s_barrier(); asm volatile("" ::: "memory"); } while (0)

    f32x16 O[4];
#pragma unroll
    for (int mt = 0; mt < 4; ++mt)
#pragma unroll
        for (int r = 0; r < 16; ++r) O[mt][r] = 0.f;
    float m_run = -INFINITY, l_run = 0.f;

    asm volatile("s_waitcnt vmcnt(0)" ::: "memory");
    __syncthreads();
    AT_ISSUE(kt_lo, 0);
    if (kt_lo + 1 <= kt_hi) AT_ISSUE(kt_lo + 1, 1);

    const int gq = lane >> 4, li = lane & 15, tq = li >> 2, tp = li & 3;
    const int vbase_lane = (4 * (gq >> 1) + tq) * AT_VSTR + (16 * (gq & 1) + 4 * tp) * 2;

    int slot = 0;
    for (int kt = kt_lo; kt <= kt_hi; ++kt) {
        if (kt + 1 <= kt_hi) AT_WAITBAR(5); else AT_WAITBAR(0);
        if (kt + 2 <= kt_hi) { const int s2 = (slot >= 1) ? slot - 1 : 2; AT_ISSUE(kt + 2, s2); }
        const bool need = (MODE == 0) ? (64 * kt <= mq_hi) : ((64 * kt + 63 >= mq_lo - 128) && (64 * kt <= mq_hi));
        if (need) {
            const LAS unsigned char* kb = lds + slot * AT_BUFSZ + ql * AT_KSTR + hi * 16;
            f32x16 p0, p1;
#pragma unroll
            for (int r = 0; r < 16; ++r) { p0[r] = 0.f; p1[r] = 0.f; }
#ifdef PROBE_DBL_S
#pragma unroll 1
            for (int rep = 0; rep < 2; ++rep)
#endif
#pragma unroll
            for (int ks = 0; ks < 8; ++ks) {
                const bf16x8 a0 = *(const LAS bf16x8*)(kb + ks * 32);
                const bf16x8 a1 = *(const LAS bf16x8*)(kb + 32 * AT_KSTR + ks * 32);
                p0 = __builtin_amdgcn_mfma_f32_32x32x16_bf16(a0, qf[ks], p0, 0, 0, 0);
                p1 = __builtin_amdgcn_mfma_f32_32x32x16_bf16(a1, qf[ks], p1, 0, 0, 0);
            }
            const LAS float* cb = (const LAS float*)(lds + slot * AT_BUFSZ + 37 * 1024);
            float mx = -INFINITY;
            const bool interior = (MODE == 0) ? (64 * kt + 63 <= mq_lo) : ((64 * kt + 63 <= mq_lo) && (mq_hi - 64 * kt <= 128));
            if (interior) {
#pragma unroll
                for (int a = 0; a < 4; ++a) {
                    f32x4 c0 = {0.f, 0.f, 0.f, 0.f}, c1 = {0.f, 0.f, 0.f, 0.f};
                    if (MODE == 0) { c0 = *(const LAS f32x4*)(cb + 8 * a + 4 * hi); c1 = *(const LAS f32x4*)(cb + 32 + 8 * a + 4 * hi); }
#pragma unroll
                    for (int e = 0; e < 4; ++e) {
                        const int r = 4 * a + e;
                        float s0 = p0[r] * SC2, s1 = p1[r] * SC2;
                        if (MODE == 0) { s0 += cq2 - c0[e]; s1 += cq2 - c1[e]; }
                        p0[r] = s0; p1[r] = s1; mx = fmaxf(mx, fmaxf(s0, s1));
                    }
                }
            } else
#pragma unroll
            for (int a = 0; a < 4; ++a) {
                f32x4 c0 = {0.f, 0.f, 0.f, 0.f}, c1 = {0.f, 0.f, 0.f, 0.f};
                if (MODE == 0) { c0 = *(const LAS f32x4*)(cb + 8 * a + 4 * hi); c1 = *(const LAS f32x4*)(cb + 32 + 8 * a + 4 * hi); }
#pragma unroll
                for (int e = 0; e < 4; ++e) {
                    const int r = 4 * a + e; const int k0 = 64 * kt + 8 * a + 4 * hi + e, k1 = k0 + 32;
                    float s0 = p0[r] * SC2, s1 = p1[r] * SC2;
                    if (MODE == 0) { s0 += cq2 - c0[e]; s1 += cq2 - c1[e]; }
                    const bool ok0 = (MODE == 0) ? (k0 <= mq) : (k0 <= mq && mq - k0 <= 128);
                    const bool ok1 = (MODE == 0) ? (k1 <= mq) : (k1 <= mq && mq - k1 <= 128);
                    s0 = ok0 ? s0 : -INFINITY; s1 = ok1 ? s1 : -INFINITY;
                    p0[r] = s0; p1[r] = s1; mx = fmaxf(mx, fmaxf(s0, s1));
                }
            }
            mx = fmaxf(mx, __shfl_xor(mx, 32));
            const float m_new = fmaxf(m_run, mx);
            const float m_use = (m_new == -INFINITY) ? 0.f : m_new;
            const float alpha = __builtin_amdgcn_exp2f(m_run - m_use);
            float ls = 0.f;
#pragma unroll
            for (int r = 0; r < 16; ++r) { p0[r] = __builtin_amdgcn_exp2f(p0[r] - m_use); p1[r] = __builtin_amdgcn_exp2f(p1[r] - m_use); ls += p0[r] + p1[r]; }
            const float m_run_prev = m_run;
            l_run = l_run * alpha + ls; m_run = m_new;
            if (!__all(m_new == m_run_prev)) {
#pragma unroll
            for (int mt = 0; mt < 4; ++mt)
#pragma unroll
                for (int r = 0; r < 16; ++r) O[mt][r] *= alpha;
            }
            bf16x8 pf[4];
#pragma unroll
            for (int s = 0; s < 4; ++s) {
                u32x4 w;
                if (s < 2) { w.x = pk2(p0[8 * s + 0], p0[8 * s + 1]); w.y = pk2(p0[8 * s + 2], p0[8 * s + 3]); w.z = pk2(p0[8 * s + 4], p0[8 * s + 5]); w.w = pk2(p0[8 * s + 6], p0[8 * s + 7]); }
                else { const int s2 = s - 2; w.x = pk2(p1[8 * s2 + 0], p1[8 * s2 + 1]); w.y = pk2(p1[8 * s2 + 2], p1[8 * s2 + 3]); w.z = pk2(p1[8 * s2 + 4], p1[8 * s2 + 5]); w.w = pk2(p1[8 * s2 + 6], p1[8 * s2 + 7]); }
                pf[s] = __builtin_bit_cast(bf16x8, w);
            }
            const LAS unsigned char* vb = lds + slot * AT_BUFSZ + AT_KBUF + vbase_lane;
#pragma unroll
            for (int mt = 0; mt < 4; ++mt)
#pragma unroll
                for (int s = 0; s < 4; ++s) {
                    const s16x4 lo = vtr(vb + (16 * s) * AT_VSTR + mt * 64);
                    const s16x4 hi4 = vtr(vb + (16 * s + 8) * AT_VSTR + mt * 64);
                    const bf16x8 vf = {lo[0], lo[1], lo[2], lo[3], hi4[0], hi4[1], hi4[2], hi4[3]};
                    O[mt] = __builtin_amdgcn_mfma_f32_32x32x16_bf16(vf, pf[s], O[mt], 0, 0, 0);
                }
        }
        slot = (slot == 2) ? 0 : slot + 1;
    }
#undef AT_ISSUE
#undef AT_WAITBAR
    const float l_tot = l_run + __shfl_xor(l_run, 32);
    const float inv = 1.0f / l_tot;
    const size_t orow = rowbase + (size_t)mq * dil;
    if (MODE == 0) {
        float ss = 0.f;
#pragma unroll
        for (int mt = 0; mt < 4; ++mt)
#pragma unroll
            for (int r = 0; r < 16; ++r) { O[mt][r] *= inv; ss += O[mt][r] * O[mt][r]; }
        ss += __shfl_xor(ss, 32);
        const float rn = rsqrtf(ss * (1.0f / 128.0f) + EPS);
        const float* nb = P.in(16) + l * 512 + hh * 128;
        bf16_t* yp = (bf16_t*)(P.ws() + WS_Y) + orow * DM + 512 + hh * 128;
#pragma unroll
        for (int mt = 0; mt < 4; ++mt)
#pragma unroll
            for (int a = 0; a < 4; ++a) {
                const int dv = 32 * mt + 8 * a + 4 * hi; const f32x4 g = *(const f32x4*)(nb + dv);
                u32x2 w; w.x = pk2(O[mt][4 * a + 0] * rn * g.x, O[mt][4 * a + 1] * rn * g.y); w.y = pk2(O[mt][4 * a + 2] * rn * g.z, O[mt][4 * a + 3] * rn * g.w);
                *(u32x2*)(yp + dv) = w;
            }
    } else {
        bf16_t* op = (bf16_t*)(P.ws() + WS_OD) + ((size_t)branch * M + orow) * 512 + hh * 128;
#pragma unroll
        for (int mt = 0; mt < 4; ++mt)
#pragma unroll
            for (int a = 0; a < 4; ++a) {
                const int dv = 32 * mt + 8 * a + 4 * hi;
                u32x2 w; w.x = pk2(O[mt][4 * a + 0] * inv, O[mt][4 * a + 1] * inv); w.y = pk2(O[mt][4 * a + 2] * inv, O[mt][4 * a + 3] * inv);
                *(u32x2*)(op + dv) = w;
            }
        if (hi == 0) ((float*)(P.ws() + WS_LSE))[((size_t)branch * M + orow) * 4 + hh] = (m_run + __builtin_amdgcn_logf(l_tot)) * 0.6931471805599453f;
    }
}

constexpr int GS_WP = 0, GS_QP = 64 * 272, GS_QK = 2 * 64 * 272, GS_KT = GS_QK + 64 * 144, GS_BUF = GS_KT + 128 * 144;
__device__ __forceinline__ void gdn_seq_unit(const Ctx& P, int l, int unit, LAS unsigned char* lds, int tid, int wave, int lane) {
    const int bh = unit >> 2, dvb = 32 * (unit & 3) + 16 * wave; const bool active = wave < 2;
    const int b = bh >> 2, hh = bh & 3;
    const unsigned char* recs = P.ws() + WS_GREC + (size_t)bh * 128 * GREC_BYTES;
    const float* Ug = (const float*)(P.ws() + WS_GU) + (size_t)bh * 128 * 8192;
    const float* GLv = (const float*)(P.ws() + WS_GLAST) + bh * 128;
    float* OC = (float*)(P.ws() + WS_OC);
    const int fr = lane & 15, g = lane >> 4;
    const int it = tid - 128;
#define GS_OFF(q_) (((q_) < 1024) ? (GS_WP + ((q_) >> 4) * 272 + ((q_) & 15) * 16) : (((q_) < 2048) ? (GS_QP + (((q_) - 1024) >> 4) * 272 + ((q_) & 15) * 16) : (((q_) < 2560) ? (GS_QK + (((q_) - 2048) >> 3) * 144 + ((q_) & 7) * 16) : (GS_KT + (((q_) - 2560) >> 3) * 144 + ((q_) & 7) * 16))))
#define GS_Q(i_) (((i_) < 9) ? (it + 384 * (i_)) : ((it + 3456 < 3584) ? (it + 3456) : 3583))
#define GS_LOADSET(set_, n_) do { const u32x4* src_ = (const u32x4*)(recs + (size_t)(n_) * GREC_BYTES); _Pragma("unroll") for (int i_ = 0; i_ < 10; ++i_) { set_[i_] = src_[GS_Q(i_)]; } } while (0)
#define GS_STORESET(set_, buf_) do { _Pragma("unroll") for (int i_ = 0; i_ < 10; ++i_) { const int q_ = GS_Q(i_); *(LAS u32x4*)(lds + (buf_) * GS_BUF + GS_OFF(q_)) = set_[i_]; } } while (0)
#define GS_BAR() do { asm volatile("s_waitcnt lgkmcnt(0)" ::: "memory"); __builtin_amdgcn_s_barrier(); asm volatile("" ::: "memory"); } while (0)
    __syncthreads();
    if (!active) {
        u32x4 r0[10], r1[10], r2[10];
        unsigned far_dummy = 0u;
#define GS_FAR 10
#define GS_TOUCH(n_) do { if ((n_) < 128) { const unsigned char* tp_ = recs + (size_t)(n_) * GREC_BYTES + (size_t)it * 128; \
            asm volatile("global_load_dword %0, %1, off" : "+v"(far_dummy) : "v"(tp_) : "memory"); \
            if (it < 64) { const unsigned char* tq_ = tp_ + 384 * 128; asm volatile("global_load_dword %0, %1, off" : "+v"(far_dummy) : "v"(tq_) : "memory"); } \
            else if (it < 128) { const float* tu_ = Ug + (size_t)(n_) * 8192 + (it - 64) * 128 + 32 * (unit & 3); asm volatile("global_load_dword %0, %1, off" : "+v"(far_dummy) : "v"(tu_) : "memory"); } } } while (0)
        GS_LOADSET(r0, 0); GS_STORESET(r0, 0); GS_LOADSET(r1, 1); GS_LOADSET(r2, 2);
#pragma unroll 1
        for (int k = 3; k < GS_FAR; ++k) GS_TOUCH(k);
        GS_BAR();
        for (int n = 0; n < 126; n += 3) {
            GS_STORESET(r1, (n + 1) & 1); GS_LOADSET(r0, n + 3); GS_TOUCH(n + GS_FAR); GS_BAR();
            GS_STORESET(r2, (n + 2) & 1); if (n + 4 < 128) GS_LOADSET(r1, n + 4); GS_TOUCH(n + 1 + GS_FAR); GS_BAR();
            GS_STORESET(r0, (n + 3) & 1); if (n + 5 < 128) GS_LOADSET(r2, n + 5); GS_TOUCH(n + 2 + GS_FAR); GS_BAR();
        }
        GS_STORESET(r1, 1); GS_BAR();
        GS_BAR();
        asm volatile("s_waitcnt vmcnt(0)" : "+v"(far_dummy) :: "memory");
#undef GS_TOUCH
#undef GS_FAR
    } else {
    f32x4 S[8];
#pragma unroll
    for (int i = 0; i < 8; ++i) S[i] = (f32x4){0.f, 0.f, 0.f, 0.f};
    f32x4 un[4]; float gln = 0.f;
    if (active) {
#pragma unroll
        for (int mt = 0; mt < 4; ++mt)
#pragma unroll
            for (int i = 0; i < 4; ++i) un[mt][i] = Ug[(16 * mt + 4 * g + i) * 128 + dvb + fr];
        gln = GLv[0];
    }
    GS_BAR();
    for (int n = 0; n < 128; ++n) {
        const int buf = n & 1;
#ifdef TG_GDN
        const unsigned long long tg0 = __builtin_amdgcn_s_memrealtime();
#endif
        {
        const LAS unsigned char* base = lds + buf * GS_BUF;
        f32x4 vn[4];
#pragma unroll
        for (int mt = 0; mt < 4; ++mt) vn[mt] = un[mt];
        const float gl = gln;
        if (n < 127) {
            const float* U = Ug + (size_t)(n + 1) * 8192;
#pragma unroll
            for (int mt = 0; mt < 4; ++mt)
#pragma unroll
                for (int i = 0; i < 4; ++i) un[mt][i] = U[(16 * mt + 4 * g + i) * 128 + dvb + fr];
            gln = GLv[n + 1];
        }
        bf16x8 sb[4];
#pragma unroll
        for (int s = 0; s < 4; ++s) {
            u32x4 w; w.x = pk2(S[2 * s][0], S[2 * s][1]); w.y = pk2(S[2 * s][2], S[2 * s][3]); w.z = pk2(S[2 * s + 1][0], S[2 * s + 1][1]); w.w = pk2(S[2 * s + 1][2], S[2 * s + 1][3]);
            sb[s] = __builtin_bit_cast(bf16x8, w);
        }
        f32x4 oa[4];
#pragma unroll
        for (int mt = 0; mt < 4; ++mt) oa[mt] = (f32x4){0.f, 0.f, 0.f, 0.f};
#pragma unroll
        for (int s = 0; s < 4; ++s) {
#pragma unroll
            for (int mt = 0; mt < 4; ++mt) {
                const bf16x8 aw = *(const LAS bf16x8*)(base + GS_WP + (16 * mt + fr) * 272 + (32 * s + 8 * g) * 2);
                const bf16x8 aq = *(const LAS bf16x8*)(base + GS_QP + (16 * mt + fr) * 272 + (32 * s + 8 * g) * 2);
                vn[mt] = __builtin_amdgcn_mfma_f32_16x16x32_bf16(aw, sb[s], vn[mt], 0, 0, 0);
                oa[mt] = __builtin_amdgcn_mfma_f32_16x16x32_bf16(aq, sb[s], oa[mt], 0, 0, 0);
            }
        }
        bf16x8 vb[2];
#pragma unroll
        for (int s = 0; s < 2; ++s) {
            u32x4 w; w.x = pk2(vn[2 * s][0], vn[2 * s][1]); w.y = pk2(vn[2 * s][2], vn[2 * s][3]); w.z = pk2(vn[2 * s + 1][0], vn[2 * s + 1][1]); w.w = pk2(vn[2 * s + 1][2], vn[2 * s + 1][3]);
            vb[s] = __builtin_bit_cast(bf16x8, w);
        }
#pragma unroll
        for (int dt = 0; dt < 8; ++dt) S[dt] = S[dt] * gl;
#pragma unroll
        for (int s = 0; s < 2; ++s) {
#pragma unroll
            for (int mt = 0; mt < 4; ++mt) {
                const bf16x8 a = *(const LAS bf16x8*)(base + GS_QK + (16 * mt + fr) * 144 + (32 * s + 8 * g) * 2);
                oa[mt] = __builtin_amdgcn_mfma_f32_16x16x32_bf16(a, vb[s], oa[mt], 0, 0, 0);
            }
#pragma unroll
            for (int dt = 0; dt < 8; ++dt) {
                const bf16x8 a = *(const LAS bf16x8*)(base + GS_KT + (16 * dt + fr) * 144 + (32 * s + 8 * g) * 2);
                S[dt] = __builtin_amdgcn_mfma_f32_16x16x32_bf16(a, vb[s], S[dt], 0, 0, 0);
            }
        }
        {
            float* op = OC + ((size_t)b * T + n * 64) * 512 + hh * 128 + dvb + fr;
#pragma unroll
            for (int mt = 0; mt < 4; ++mt)
#pragma unroll
                for (int i = 0; i < 4; ++i) op[(size_t)(16 * mt + 4 * g + i) * 512] = oa[mt][i];
        }
        }
#ifdef TG_GDN
        if (TG_GDN == 0 && tid == 0) { volatile LAS unsigned* macc = (volatile LAS unsigned*)(lds + LDS_MISC) + 2; macc[0] += (unsigned)(__builtin_amdgcn_s_memrealtime() - tg0); macc[1] += 1u; }
#endif
        GS_BAR();
#ifdef TG_GDN
        if (TG_GDN == 1 && tid == 0) { volatile LAS unsigned* macc = (volatile LAS unsigned*)(lds + LDS_MISC) + 2; macc[0] += (unsigned)(__builtin_amdgcn_s_memrealtime() - tg0); macc[1] += 1u; }
#endif
    }
    }
#undef GS_OFF
#undef GS_Q
#undef GS_LOADSET
#undef GS_STORESET
#undef GS_BAR
}

__device__ __forceinline__ void lru_final_unit(const Ctx& P, int l, int unit, int tid, int wave, int lane) {
    const bf16_t* Z = (const bf16_t*)(P.ws() + WS_Z);
    const float* LA = (const float*)(P.ws() + WS_LRUA); const float* LU = (const float*)(P.ws() + WS_LRUU); const float* AGG = (const float*)(P.ws() + WS_LAGG);
    bf16_t* Y = (bf16_t*)(P.ws() + WS_Y);
    const int b = unit >> 7, ck = unit & 127; const size_t m0 = (size_t)b * T + ck * 64; const int ch = tid;
    float h = 0.f;
    {
        const float* ag = AGG + (size_t)(b * 128) * 2 * 512 + ch;
        for (int j0 = 0; j0 < ck; j0 += 32) {
            float aa[32], hh2[32];
#pragma unroll
            for (int q = 0; q < 32; ++q) { const int j = (j0 + q < ck) ? (j0 + q) : (ck - 1); aa[q] = ag[(size_t)(j * 2 + 0) * 512]; hh2[q] = ag[(size_t)(j * 2 + 1) * 512]; }
#pragma unroll
            for (int q = 0; q < 32; ++q) { const bool ok = (j0 + q < ck); h = ok ? (aa[q] * h + hh2[q]) : h; }
        }
    }
    const float gn = P.in(15)[l * 512 + ch];
    for (int t0 = 0; t0 < 64; t0 += 16) {
        float av[16], uv[16], gv[16], hv[16], sv[16];
#pragma unroll
        for (int q = 0; q < 16; ++q) { av[q] = __builtin_nontemporal_load(LA + (m0 + t0 + q) * 512 + ch); uv[q] = __builtin_nontemporal_load(LU + (m0 + t0 + q) * 512 + ch); gv[q] = bf2f(Z[(m0 + t0 + q) * NZ + ZC_AG + ch]); }
#pragma unroll
        for (int q = 0; q < 16; ++q) { h = av[q] * h + uv[q]; hv[q] = h; sv[q] = h * h; }
#pragma unroll
        for (int o = 1; o < 64; o <<= 1) {
#pragma unroll
            for (int q = 0; q < 16; ++q) sv[q] += __shfl_xor(sv[q], o);
        }
#pragma unroll
        for (int q = 0; q < 16; ++q) {
            const float y = hv[q] * rsqrtf(sv[q] * (1.0f / 64.0f) + EPS) * gn * gelu_tanh(gv[q]);
            Y[(m0 + t0 + q) * DM + ch] = (bf16_t)f2bf(y);
        }
    }
}

__device__ __forceinline__ void finalize_phase(const Ctx& P, int l, int wave, int lane, int bid, int nblk) {
    const bf16_t* Z = (const bf16_t*)(P.ws() + WS_Z); const float* OC = (const float*)(P.ws() + WS_OC);
    const bf16_t* OD = (const bf16_t*)(P.ws() + WS_OD); const float* LSE = (const float*)(P.ws() + WS_LSE);
    bf16_t* Y = (bf16_t*)(P.ws() + WS_Y);
    const float gc0 = P.in(14)[l * 128 + 2 * lane], gc1 = P.in(14)[l * 128 + 2 * lane + 1];
    for (int m = bid * 8 + wave; m < M; m += nblk * 8) {
        float o0[4], o1[4]; unsigned zz[4], a0[4], a1[4], a2[4]; float l0[4], l1[4], l2[4], g0[4], g1[4];
#pragma unroll
        for (int hh = 0; hh < 4; ++hh) {
            const f32x2_t ov = __builtin_nontemporal_load((const f32x2_t*)(OC + (size_t)m * 512 + hh * 128 + 2 * lane)); o0[hh] = ov.x; o1[hh] = ov.y;
            zz[hh] = *(const unsigned*)(Z + (size_t)m * NZ + ZC_CZ + hh * 128 + 2 * lane);
            l0[hh] = LSE[((size_t)0 * M + m) * 4 + hh]; l1[hh] = LSE[((size_t)1 * M + m) * 4 + hh]; l2[hh] = LSE[((size_t)2 * M + m) * 4 + hh];
            a0[hh] = __builtin_nontemporal_load((const unsigned*)(OD + ((size_t)0 * M + m) * 512 + hh * 128 + 2 * lane));
            a1[hh] = __builtin_nontemporal_load((const unsigned*)(OD + ((size_t)1 * M + m) * 512 + hh * 128 + 2 * lane));
            a2[hh] = __builtin_nontemporal_load((const unsigned*)(OD + ((size_t)2 * M + m) * 512 + hh * 128 + 2 * lane));
            const f32x2_t gv = *(const f32x2_t*)(P.in(17) + l * 512 + hh * 128 + 2 * lane); g0[hh] = gv.x; g1[hh] = gv.y;
        }
        float sc[4], sd[4], d0[4], d1[4];
#pragma unroll
        for (int hh = 0; hh < 4; ++hh) {
            sc[hh] = o0[hh] * o0[hh] + o1[hh] * o1[hh];
            const float mx = fmaxf(l0[hh], fmaxf(l1[hh], l2[hh]));
            float w0 = __expf(l0[hh] - mx), w1 = __expf(l1[hh] - mx), w2 = __expf(l2[hh] - mx);
            const float inv = 1.0f / (w0 + w1 + w2); w0 *= inv; w1 *= inv; w2 *= inv;
            d0[hh] = w0 * bflo(a0[hh]) + w1 * bflo(a1[hh]) + w2 * bflo(a2[hh]); d1[hh] = w0 * bfhi(a0[hh]) + w1 * bfhi(a1[hh]) + w2 * bfhi(a2[hh]);
            sd[hh] = d0[hh] * d0[hh] + d1[hh] * d1[hh];
        }
#pragma unroll
        for (int o = 1; o < 64; o <<= 1) {
#pragma unroll
            for (int hh = 0; hh < 4; ++hh) { sc[hh] += __shfl_xor(sc[hh], o); sd[hh] += __shfl_xor(sd[hh], o); }
        }
#pragma unroll
        for (int hh = 0; hh < 4; ++hh) {
            const float rc = rsqrtf(sc[hh] * (1.0f / 128.0f) + EPS), rd = rsqrtf(sd[hh] * (1.0f / 128.0f) + EPS);
            const float z0 = bflo(zz[hh]), z1 = bfhi(zz[hh]);
            *(unsigned*)(Y + (size_t)m * DM + 1024 + hh * 128 + 2 * lane) = pk2(o0[hh] * rc * gc0 * siluf_(z0), o1[hh] * rc * gc1 * siluf_(z1));
            *(unsigned*)(Y + (size_t)m * DM + 1536 + hh * 128 + 2 * lane) = pk2(d0[hh] * rd * g0[hh], d1[hh] * rd * g1[hh]);
        }
    }
}

__device__ __forceinline__ void ffn_act_phase(const Ctx& P, int l, int tid, int bid, int nblk) {
    const bf16_t* U = (const bf16_t*)(P.ws() + WS_U); bf16_t* ACT = (bf16_t*)(P.ws() + WS_ACT);
    const float* cw = P.in(21) + (size_t)l * 3 * NFF2; const float* cb = P.in(22) + (size_t)l * NFF2;
    constexpr int CG = DFF / 8, RUN = 32, NRUN = M / RUN;
    for (int item = bid * NTHR + tid; item < CG * NRUN; item += nblk * NTHR) {
        const int cg8 = item % CG, run = item / CG; const int c0 = cg8 * 8; const size_t mstart = (size_t)run * RUN; const int tin = (int)(mstart % T);
        float wu[3][8], wg[3][8], bu[8], bg[8];
#pragma unroll
        for (int k = 0; k < 3; ++k)
#pragma unroll
            for (int e = 0; e < 8; ++e) { wu[k][e] = cw[k * NFF2 + c0 + e]; wg[k][e] = cw[k * NFF2 + DFF + c0 + e]; }
#pragma unroll
        for (int e = 0; e < 8; ++e) { bu[e] = cb[c0 + e]; bg[e] = cb[DFF + c0 + e]; }
        u32x4 u2 = {0, 0, 0, 0}, u1 = {0, 0, 0, 0}, g2 = {0, 0, 0, 0}, g1 = {0, 0, 0, 0};
        if (tin > 0) {
            u2 = *(const u32x4*)(U + (mstart - 2) * NFF2 + c0); u1 = *(const u32x4*)(U + (mstart - 1) * NFF2 + c0);
            g2 = *(const u32x4*)(U + (mstart - 2) * NFF2 + DFF + c0); g1 = *(const u32x4*)(U + (mstart - 1) * NFF2 + DFF + c0);
        }
        for (int t = 0; t < RUN; ++t) {
            const u32x4 u0 = __builtin_nontemporal_load((const u32x4*)(U + (mstart + t) * NFF2 + c0)), g0 = __builtin_nontemporal_load((const u32x4*)(U + (mstart + t) * NFF2 + DFF + c0));
            float r[8];
#pragma unroll
            for (int q = 0; q < 4; ++q) {
                const float up0 = bu[2 * q] + wu[0][2 * q] * bflo(u2[q]) + wu[1][2 * q] * bflo(u1[q]) + wu[2][2 * q] * bflo(u0[q]);
                const float up1 = bu[2 * q + 1] + wu[0][2 * q + 1] * bfhi(u2[q]) + wu[1][2 * q + 1] * bfhi(u1[q]) + wu[2][2 * q + 1] * bfhi(u0[q]);
                const float ga0 = bg[2 * q] + wg[0][2 * q] * bflo(g2[q]) + wg[1][2 * q] * bflo(g1[q]) + wg[2][2 * q] * bflo(g0[q]);
                const float ga1 = bg[2 * q + 1] + wg[0][2 * q + 1] * bfhi(g2[q]) + wg[1][2 * q + 1] * bfhi(g1[q]) + wg[2][2 * q + 1] * bfhi(g0[q]);
                r[2 * q] = siluf_(ga0) * up0; r[2 * q + 1] = siluf_(ga1) * up1;
            }
            u32x4 o; o.x = pk2(r[0], r[1]); o.y = pk2(r[2], r[3]); o.z = pk2(r[4], r[5]); o.w = pk2(r[6], r[7]);
            *(u32x4*)(ACT + (mstart + t) * DFF + c0) = o;
            u2 = u1; u1 = u0; g2 = g1; g1 = g0;
        }
    }
}

#ifndef N_LAYERS_RUN
#define N_LAYERS_RUN DEPTH
#endif
constexpr int D_NUNITS = 32 + 256 + 768 + 256;
constexpr int D_PER_Q = 4 + 32 + 96 + 32;
constexpr int D_PER_QX = D_PER_Q + 196;

__global__ void __launch_bounds__(NTHR, 2) fwd_megakernel(Params KP) {
    extern __shared__ __attribute__((aligned(16))) unsigned char lds_raw[];
    LAS unsigned char* lds0 = (LAS unsigned char*)lds_raw;
    cg::grid_group grid = cg::this_grid();
    const int tid = threadIdx.x, lane = tid & 63, wave = __builtin_amdgcn_readfirstlane(tid >> 6);
    const int bid = blockIdx.x, nblk = gridDim.x;
    volatile LAS int* misc = (volatile LAS int*)(lds0 + LDS_MISC);
    if (threadIdx.x < 16) misc[threadIdx.x] = 0;
    __syncthreads();
    XcdBarrier xbar = xcd_barrier_post((unsigned*)(KP.ws + WS_CTL) + 4096, (volatile LAS unsigned*)(lds0 + LDS_MISC) + 8);
    {
        LAS unsigned long long* tabw = (LAS unsigned long long*)(lds0 + LDS_MISC + 64);
        if (threadIdx.x == 0) {
#pragma unroll
            for (int i = 0; i < 25; ++i) tabw[i] = (unsigned long long)KP.in[i];
            tabw[25] = (unsigned long long)KP.out; tabw[26] = (unsigned long long)KP.ws;
        }
        __syncthreads();
    }
    Ctx P; P.tab = (const LAS unsigned*)(lds0 + LDS_MISC + 64);
#define WSP (P.ws())
#define XP (P.out())

#ifdef DUP_SYNC
#define GSYNC() do { grid.sync(); grid.sync(); } while (0)
#else
#define GSYNC() xcd_barrier(xbar)
#endif
#ifdef TU_TYPE
    unsigned long long tu_acc = 0, tu_cnt = 0;
#endif
#ifdef TP_GROUP
    unsigned long long tp_acc = 0, tp_t0 = 0;
#define TP_B(g) do { if ((g) == TP_GROUP) tp_t0 = __builtin_amdgcn_s_memrealtime(); } while (0)
#define TP_E(g) do { if ((g) == TP_GROUP) tp_acc += __builtin_amdgcn_s_memrealtime() - tp_t0; } while (0)
#else
#define TP_B(g)
#define TP_E(g)
#endif
    TP_B(1);
#ifndef SK_P0
    p0_prologue(P, lds0, bid * 8 + wave, nblk * 8, wave, lane);
#ifdef DUP_P0
    __syncthreads();
    p0_prologue(P, lds0, bid * 8 + wave, nblk * 8, wave, lane);
#endif
#endif
    grid.sync();
    TP_E(1);

    for (int l0 = 0; l0 < N_LAYERS_RUN; ++l0) {
#define FRESH() LAS unsigned char* lds = lds0; asm volatile("" : "+v"(lds)); int l = l0; asm volatile("" : "+s"(l)); int tid = threadIdx.x; asm volatile("" : "+v"(tid)); const int lane = tid & 63, wave = __builtin_amdgcn_readfirstlane(tid >> 6); (void)lane; (void)wave; (void)l;
        TP_B(2);
#ifndef SK_A
        { FRESH()
        norm_gates_phase(l == 0 ? P.in(0) : XP, l == 0 ? XP : nullptr, P.in(1) + l * DM, (bf16_t*)(WSP + WS_HB), (const float*)(WSP + WS_WG) + (size_t)l * 12 * DM,
                         (float*)(WSP + WS_GL), lds, tid, wave, lane, bid, nblk);
#ifdef DUP_A
        norm_phase<true>(l == 0 ? P.in(0) : XP, l == 0 ? XP : nullptr, P.in(1) + l * DM, (bf16_t*)(WSP + WS_HB), (const float*)(WSP + WS_WG) + (size_t)l * 12 * DM, (float*)(WSP + WS_GL), lds, tid, wave, lane, bid, nblk);
#endif
        }
#endif
        GSYNC(); TP_E(2);
        TP_B(6);
#ifndef SK_B
        { FRESH()
            pg8::Gemm g{(const bf16_t*)(WSP + WS_HB), (const bf16_t*)(WSP + WS_WIN) + (size_t)l * NZ * DM, M, NZ, DM};
            pg8::StaticOrder S; S.init(M, NZ, nblk, bid);
            pg8::EpiBf16<0> E{(bf16_t*)(WSP + WS_Z), NZ, nullptr, 0, 0, 1.f};
            pg8::gemm_phase<pg8::EpiBf16<0>, pg8::StaticOrder, true, true>(lds, g, S, E);
#ifdef DUP_B
            __syncthreads();
            pg8::gemm_phase<pg8::EpiBf16<0>, pg8::StaticOrder, true, true>(lds, g, S, E);
#endif
        }
#endif
        GSYNC(); TP_E(6);
        TP_B(3);
#ifdef DUP_C
        for (int pass = 0; pass < 2; ++pass)
#endif
        for (int u = bid; u < 1024 + 256 + 8; u += nblk) { FRESH()
#ifndef SK_C3
            if (u < 1024) { TP_B(10); gdn_prep_unit(P, l, u, lds, tid, wave, lane); TP_E(10); } else
#endif
#ifndef SK_C1
            if (u >= 1024 && u < 1280) { TP_B(11); __syncthreads(); lru_chunk_unit(P, l, u - 1024, lds, tid, wave, lane); __syncthreads(); TP_E(11); } else
#endif
#ifndef SK_C2
            if (u >= 1280) fox_cumsum_unit(P, l, u - 1280, lds, tid, wave, lane);
#else
            {}
#endif
        }
        GSYNC(); TP_E(3);
        TP_B(4); TP_B(8);
        {
            {
            unsigned* ctrs = (unsigned*)(WSP + WS_CTL) + 8192 + 1024 * l0;
            const int home = (int)(xbar.x & 7u);
            const int perq = (l0 < DEPTH - 1) ? D_PER_QX : D_PER_Q;
            int qoff = 0;
            for (;;) {
                __syncthreads();
                if (threadIdx.x == 0) {
                    int found = -1;
                    while (qoff < 8) {
                        const int q = (home + qoff) & 7;
                        const int j = (int)atomicAdd(ctrs + 64 * q, 1u);
                        if (j < perq) { found = q * D_PER_QX + j; break; }
                        ++qoff;
                    }
                    misc[0] = found; misc[1] = qoff;
                }
                __syncthreads();
                const int uu = misc[0]; qoff = misc[1];
                if (uu < 0) break;
                FRESH()
                const int bh = uu / D_PER_QX;
#ifdef GDN_LAST
                const int j0 = uu % D_PER_QX; const int j = (j0 < 160) ? j0 + 4 : (j0 < 164 ? j0 - 160 : j0);
#else
                const int j = uu % D_PER_QX;
#endif
#ifdef TU_TYPE
                const int tu_type = (j < 4) ? 0 : (j < 36 ? 1 : (j < 68 ? 3 : 2));
                const unsigned long long tu_t0 = __builtin_amdgcn_s_memrealtime();
#endif
                if (j < 4) gdn_seq_unit(P, l, bh * 4 + j, lds, tid, wave, lane);
                else if (j < 36) attn_unit<0>(P, l, lds, tid, wave, lane, bh >> 2, bh & 3, 1, 0, (31 - (j - 4)) * 256, 0);
                else if (j < 68) lru_final_unit(P, l, bh * 32 + (j - 36), tid, wave, lane);
                else if (j < D_PER_Q) {
                    const int jj = j - 68;
                    const int br = jj >> 5, k = jj & 31;
                    const int dil = (br == 0) ? 1 : (br == 1 ? 4 : 16);
                    const int nqb = 32 / dil;
                    const int res = k / nqb, qb = k % nqb;
                    attn_unit<1>(P, l, lds, tid, wave, lane, bh >> 2, bh & 3, dil, res, qb * 256, br);
                }
                else p0_unit(P, l + 1, bh * 196 + (j - D_PER_Q), lds, wave, lane);
#ifdef TU_TYPE
                if (tu_type == TU_TYPE && !(TU_TYPE == 1 && j - 4 > 8)) { tu_acc += __builtin_amdgcn_s_memrealtime() - tu_t0;
                    tu_cnt += (tu_type == 0) ? 128 : (tu_type == 1 ? 4 * (32 - (j - 4)) : 1); }
#endif
            }
            }
#ifdef DUP_SUB
            {
            unsigned* ctr = (unsigned*)(WSP + WS_CTL) + 64 * (1 + l0) + 32;
            for (;;) {
                __syncthreads();
                if (threadIdx.x == 0) misc[0] = (int)atomicAdd(ctr, 1u);
                __syncthreads();
                const int u = misc[0] + DUP_SUB_LO;
                if (u >= DUP_SUB_HI) break;
                FRESH()
                if (u < 32) gdn_seq_unit(P, l, u, lds, tid, wave, lane);
                else if (u < 288) { const int i = u - 32; attn_unit<0>(P, l, lds, tid, wave, lane, (i & 7) >> 2, i & 3, 1, 0, (31 - (i >> 3)) * 256, 0); }
                else if (u < 1056) {
                    const int i = u - 288; const int bh = i & 7, j = i >> 3;
                    const int br = j >> 5, k = j & 31;
                    const int dil = (br == 0) ? 1 : (br == 1 ? 4 : 16);
                    const int nqb = 32 / dil;
                    const int res = k / nqb, qb = k % nqb;
                    attn_unit<1>(P, l, lds, tid, wave, lane, bh >> 2, bh & 3, dil, res, qb * 256, br);
                }
                else lru_final_unit(P, l, u - 1056, tid, wave, lane);
            }
            }
#endif
        }
        TP_E(8); TP_B(9); GSYNC(); TP_E(9); TP_E(4);
        TP_B(2);
#ifndef SK_E
        { FRESH() finalize_phase(P, l, wave, lane, bid, nblk);
#ifdef DUP_E
          finalize_phase(P, l, wave, lane, bid, nblk);
#endif
        }
#endif
        GSYNC(); TP_E(2);
        TP_B(7);
#ifndef SK_F
        { FRESH()
            pg8::Gemm g{(const bf16_t*)(WSP + WS_Y), (const bf16_t*)(WSP + WS_WOUT) + (size_t)l * DM * DM, M, DM, DM};
            pg8::StaticOrder S; S.init(M, DM, nblk, bid);
            EpiResAdd E{XP, DM};
            pg8::gemm_phase<EpiResAdd, pg8::StaticOrder, true, true>(lds, g, S, E);
#ifdef DUP_F
            __syncthreads();
            EpiResAdd E2{(float*)(WSP + WS_ACT), DM};
            pg8::gemm_phase<EpiResAdd, pg8::StaticOrder, true, true>(lds, g, S, E2);
#endif
        }
#endif
        GSYNC(); TP_E(7);
        TP_B(2);
#ifndef SK_G
        { FRESH() norm_phase<false>(XP, nullptr, P.in(19) + l * DM, (bf16_t*)(WSP + WS_HB), nullptr, nullptr, lds, tid, wave, lane, bid, nblk);
#ifdef DUP_G
          norm_phase<false>(XP, nullptr, P.in(19) + l * DM, (bf16_t*)(WSP + WS_HB), nullptr, nullptr, lds, tid, wave, lane, bid, nblk);
#endif
        }
#endif
        GSYNC(); TP_E(2);
        TP_B(6);
#ifndef SK_H
        { FRESH()
            pg8::Gemm g{(const bf16_t*)(WSP + WS_HB), (const bf16_t*)(WSP + WS_WUP) + (size_t)l * NFF2 * DM, M, NFF2, DM};
            pg8::StaticOrder S; S.init(M, NFF2, nblk, bid);
            pg8::EpiBf16<0> E{(bf16_t*)(WSP + WS_U), NFF2, nullptr, 0, 0, 1.f};
            pg8::gemm_phase<pg8::EpiBf16<0>, pg8::StaticOrder, true, true>(lds, g, S, E);
#ifdef DUP_H
            __syncthreads();
            pg8::gemm_phase<pg8::EpiBf16<0>, pg8::StaticOrder, true, true>(lds, g, S, E);
#endif
        }
#endif
        GSYNC(); TP_E(6);
        TP_B(5);
#ifndef SK_I
        { FRESH() ffn_act_phase(P, l, tid, bid, nblk);
#ifdef DUP_I
          ffn_act_phase(P, l, tid, bid, nblk);
#endif
        }
#endif
        GSYNC(); TP_E(5);
        TP_B(7);
#ifndef SK_J
        { FRESH()
            pg8::Gemm g{(const bf16_t*)(WSP + WS_ACT), (const bf16_t*)(WSP + WS_WDN) + (size_t)l * DM * DFF, M, DM, DFF};
            pg8::StaticOrder S; S.init(M, DM, nblk, bid);
            EpiResAdd E{XP, DM};
            pg8::gemm_phase<EpiResAdd, pg8::StaticOrder, true, true>(lds, g, S, E);
#ifdef DUP_J
            __syncthreads();
            EpiResAdd E2{(float*)(WSP + WS_Z), DM};
            pg8::gemm_phase<EpiResAdd, pg8::StaticOrder, true, true>(lds, g, S, E2);
#endif
        }
#endif
        GSYNC(); TP_E(7);
    }
#ifndef SK_FN
    { int tid = threadIdx.x; asm volatile("" : "+v"(tid)); const int lane = tid & 63, wave = __builtin_amdgcn_readfirstlane(tid >> 6);
      final_norm_phase(XP, P.in(24), wave, lane, bid, nblk); }
#ifdef TG_GDN
    if (misc[3]) { const unsigned long long spin = (unsigned long long)misc[2] * 1000ull / (unsigned long long)misc[3]; const unsigned long long ts = __builtin_amdgcn_s_memrealtime(); while (__builtin_amdgcn_s_memrealtime() - ts < spin) __builtin_amdgcn_s_sleep(8); }
#endif
#ifdef TU_TYPE
    if (tu_cnt) { const unsigned long long spin = tu_acc * TU_SCALE / tu_cnt; const unsigned long long ts = __builtin_amdgcn_s_memrealtime(); while (__builtin_amdgcn_s_memrealtime() - ts < spin) __builtin_amdgcn_s_sleep(8); }
#endif
#ifdef TP_GROUP
    if (blockIdx.x == 0) { const unsigned long long ts = __builtin_amdgcn_s_memrealtime(); while (__builtin_amdgcn_s_memrealtime() - ts < tp_acc) __builtin_amdgcn_s_sleep(8); }
#endif
#endif
}

extern "C" void kernel_launch(void* const* d_in, const int* in_sizes, int n_in, void* d_out, int out_size, void* d_ws, size_t ws_size, hipStream_t stream) {
    static int grid_blocks = 0;
    if (grid_blocks == 0) {
        if (n_in != 25 || ws_size < WS_END) { fprintf(stderr, "kernel_launch: unexpected inputs (n_in %d, ws %zu < %zu)\n", n_in, ws_size, (size_t)WS_END); grid_blocks = -1; return; }
        int dev = 0, cus = 0, per_cu = 0;
        (void)hipGetDevice(&dev);
        (void)hipDeviceGetAttribute(&cus, hipDeviceAttributeMultiprocessorCount, dev);
        if (hipFuncSetAttribute((const void*)fwd_megakernel, hipFuncAttributeMaxDynamicSharedMemorySize, LDS_BYTES) != hipSuccess) { fprintf(stderr, "kernel_launch: hipFuncSetAttribute failed\n"); grid_blocks = -1; return; }
        if (hipOccupancyMaxActiveBlocksPerMultiprocessor(&per_cu, (const void*)fwd_megakernel, NTHR, LDS_BYTES) != hipSuccess || per_cu < 1) { fprintf(stderr, "kernel_launch: occupancy query says %d\n", per_cu); per_cu = 1; }
        (void)hipGetLastError();
        grid_blocks = cus * per_cu;
        if (grid_blocks > 256) grid_blocks = 256;
    }
    if (grid_blocks < 0) return;
    (void)hipMemsetAsync((char*)d_ws + WS_CTL, 0, 65536, stream);
    Params p{};
    for (int i = 0; i < 25; ++i) p.in[i] = (const float*)d_in[i];
    p.out = (float*)d_out; p.ws = (unsigned char*)d_ws;
    void* args[] = {&p};
    hipError_t e = hipLaunchCooperativeKernel((const void*)fwd_megakernel, dim3(grid_blocks), dim3(NTHR), args, LDS_BYTES, stream);
    if (e != hipSuccess) fprintf(stderr, "cooperative launch failed: %s (grid %d)\n", hipGetErrorString(e), grid_blocks);
}
```

```cpp
#include <hip/hip_runtime.h>
#include <hip/hip_cooperative_groups.h>
#include <cstdio>
#include <cstdint>
namespace cg = cooperative_groups;
namespace pg8 {
#define PG8_LAS __attribute__((address_space(3)))
typedef unsigned short bf16_t;
typedef short bf16x8 __attribute__((ext_vector_type(8)));
typedef float f32x4 __attribute__((ext_vector_type(4)));
typedef unsigned u32x4 __attribute__((ext_vector_type(4)));
constexpr int BM = 256, BK = 64, HALF = 128, HTB = HALF * BK * 2  , STAGE_BYTES = 8 * HTB, NXCD = 8, WGM = 8;

__host__ __device__ __forceinline__ int lds_byte(int r, int c) { const int st = (r >> 4) * 2 + (c >> 5), rr = r & 15, cc = c & 31, ob = rr * 64 + cc * 2; return st * 1024 + (ob ^ (((ob >> 9) & 1) << 5)); }
__host__ __device__ __forceinline__ void stage_rc(int b, int& R, int& C) { const int st = b / 1024, sb = b % 1024, swz = sb ^ (((sb >> 9) & 1) << 5); R = (st >> 1) * 16 + swz / 64; C = (st & 1) * 32 + (swz % 64) / 2; }
__host__ __device__ __forceinline__ int perm32(int rho) { const int n = rho >> 4, i = rho & 15; return 8 * (i >> 2) + 4 * n + (i & 3); }

struct Unit { int pm, pn; };
struct Gemm { const bf16_t* A; const bf16_t* Bt; int M, N, K; };

struct StaticOrder {
    int nM, nN, nwg, G, c;
    __host__ __device__ void init(int M, int N, int G_, int c_) { nM = M / BM; nN = N / BM; nwg = nM * nN; G = G_; c = c_; }
    __host__ __device__ bool next(int i, Unit& u) const {
        const long L = (long)i * G + c; if (L >= nwg) return false;
        int wgid = (int)L; { const int q = nwg / NXCD, r = nwg % NXCD, xcd = wgid % NXCD, off = wgid / NXCD; wgid = (xcd < r ? xcd * (q + 1) : r * (q + 1) + (xcd - r) * q) + off; }
        const int nig = WGM * nN, gid = wgid / nig, fm = gid * WGM, gsz = (nM - fm) < WGM ? (nM - fm) : WGM;
        u.pm = fm + ((wgid % nig) % gsz); u.pn = (wgid % nig) / gsz; return true;
    }
    __device__ __forceinline__ void a_ready(const Unit&) const {}
    __device__ __forceinline__ void done(const Unit&) const {}
};

__device__ __forceinline__ unsigned cvt_pk_bf16(float lo, float hi) { unsigned r; asm volatile("v_cvt_pk_bf16_f32 %0, %1, %2" : "=v"(r) : "v"(lo), "v"(hi)); return r; }
typedef float f32x2 __attribute__((ext_vector_type(2)));
__device__ __forceinline__ f32x2 gelu_pk(f32x2 v) {
    const f32x2 av = __builtin_elementwise_abs(v), d = av * 0.2316418882f + 1.0f;
    f32x2 t; t.x = __builtin_amdgcn_rcpf(d.x); t.y = __builtin_amdgcn_rcpf(d.y);
    f32x2 q = t * 0.5307027145f + (-0.7265760135f); q = q * t + 0.7107068705f; q = q * t + (-0.142248368f); q = q * t + 0.127414796f; q = q * t;
    const f32x2 s = (v * v) * (-0.72134752044f);
    f32x2 e; e.x = __builtin_amdgcn_exp2f(s.x); e.y = __builtin_amdgcn_exp2f(s.y);
    const f32x2 m = v * (q * e), r = v - m;
    f32x2 o; o.x = v.x < 0.f ? m.x : r.x; o.y = v.y < 0.f ? m.y : r.y; return o;
}

template <int ACT  > struct EpiBf16 {
    static constexpr bool PERM = true, AFTER_DRAIN = false; static_assert(ACT == 0 || ACT == 1, "EpiBf16: ACT is 0 (none) or 1 (gelu_pk)");
    bf16_t* O; int ldc; const float* bias; int split_cols; size_t split_stride; float scale0;
    __device__ __forceinline__ void operator()(const f32x4 (&acc)[2][2][4][2], const Unit& u, int wr, int wc, int fr, int fq) const {
        const int row0 = u.pm * BM + wr * 64 + fr; int colt = u.pn * BM; bf16_t* base = O;
        float sc = 1.f; if (split_cols) { const int t = colt / split_cols; base += (size_t)t * split_stride; colt -= t * split_cols; if (t == 0) sc = scale0; }
        const int col0 = colt + wc * 32 + 8 * fq, bcol0 = u.pn * BM + wc * 32 + 8 * fq;
        f32x4 bv[2][2];
#pragma unroll
        for (int bj = 0; bj < 2; ++bj)
#pragma unroll
            for (int n = 0; n < 2; ++n) bv[bj][n] = bias ? *(const f32x4*)(bias + bcol0 + bj * HALF + 4 * n) : (f32x4){0.f, 0.f, 0.f, 0.f};
#pragma unroll
        for (int ai = 0; ai < 2; ++ai)
#pragma unroll
            for (int m = 0; m < 4; ++m) { bf16_t* rowp = base + (size_t)(row0 + ai * HALF + m * 16) * ldc + col0;
#pragma unroll
                for (int bj = 0; bj < 2; ++bj) { f32x4 v0 = acc[ai][bj][m][0] + bv[bj][0], v1 = acc[ai][bj][m][1] + bv[bj][1];
                    if (ACT == 1) { f32x2 a = gelu_pk((f32x2){v0[0], v0[1]}), b = gelu_pk((f32x2){v0[2], v0[3]}), c = gelu_pk((f32x2){v1[0], v1[1]}), d = gelu_pk((f32x2){v1[2], v1[3]});
                        v0 = (f32x4){a.x, a.y, b.x, b.y}; v1 = (f32x4){c.x, c.y, d.x, d.y}; }
                    v0 = v0 * sc; v1 = v1 * sc; u32x4 w; w.x = cvt_pk_bf16(v0[0], v0[1]); w.y = cvt_pk_bf16(v0[2], v0[3]); w.z = cvt_pk_bf16(v1[0], v1[1]); w.w = cvt_pk_bf16(v1[2], v1[3]);
                    *(u32x4*)(rowp + bj * HALF) = w; } }
    }
};
template <class Epi, class Sched, bool ALIGN_EPI = false, bool SP2 = false>
__device__ __forceinline__ void gemm_phase(PG8_LAS unsigned char* lds, const Gemm g, const Sched& S, const Epi& E) {
    int tid_l = threadIdx.x; asm volatile("" : "+v"(tid_l)); const int tid = tid_l, wid = __builtin_amdgcn_readfirstlane(tid >> 6), lane = tid & 63, wr = wid >> 2, wc = wid & 3, fr = lane & 15, fq = lane >> 4;
    const int K = g.K, nt = K / BK;
    unsigned voffA[2], voffB[2];
#pragma unroll
    for (int i = 0; i < 2; ++i) { int R, C; stage_rc(tid * 16 + i * 8192, R, C); const int Rb = Epi::PERM ? ((R & ~31) + perm32(R & 31)) : R;
        voffA[i] = (unsigned)(R * K + C) * 2u; voffB[i] = (unsigned)(Rb * K + C) * 2u; }
    const size_t kstep = (size_t)(BK * 2);
    const size_t hstep = (size_t)HALF * K * 2;
    const size_t tstep = 2 * hstep;
    const unsigned ldsw = (unsigned)wid * 1024u;
    const int aoff = lds_byte(wr * 64 + fr, fq * 8), boff = lds_byte(wc * 32 + fr, fq * 8);
#define PG8_SA(b, h) (((b) * 2 + (h)) * HTB)
#define PG8_SB(b, h) ((4 + (b) * 2 + (h)) * HTB)
#define PG8_STAGE(bufoff, gbase, voff) do { _Pragma("unroll") for (int _i = 0; _i < 2; ++_i) \
        __builtin_amdgcn_global_load_lds((const unsigned*)((const char*)(gbase) + (voff)[_i]), (PG8_LAS unsigned*)(lds + (bufoff) + ldsw + _i * 8192), 16, 0, 0); } while (0)
#define PG8_LDA(dst, b, h) do { _Pragma("unroll") for (int m = 0; m < 4; ++m) _Pragma("unroll") for (int k = 0; k < 2; ++k) dst[m][k] = *(const PG8_LAS bf16x8*)(lds + PG8_SA(b, h) + aoff + m * 2048 + k * 1024); } while (0)
#define PG8_LDB(dst, b, h) do { _Pragma("unroll") for (int n = 0; n < 2; ++n) _Pragma("unroll") for (int k = 0; k < 2; ++k) dst[n][k] = *(const PG8_LAS bf16x8*)(lds + PG8_SB(b, h) + boff + n * 2048 + k * 1024); } while (0)
#define PG8_MMA(ai, bj, At, Bt) do { __builtin_amdgcn_s_setprio(1); _Pragma("unroll") for (int m = 0; m < 4; ++m) _Pragma("unroll") for (int n = 0; n < 2; ++n) _Pragma("unroll") for (int k = 0; k < 2; ++k) \
        acc[ai][bj][m][n] = __builtin_amdgcn_mfma_f32_16x16x32_bf16(Bt[n][k], At[m][k], acc[ai][bj][m][n], 0, 0, 0); __builtin_amdgcn_s_setprio(0); } while (0)
#define PG8_WAIT_V(n) asm volatile("s_waitcnt vmcnt(" #n ")" ::: "memory")
#define PG8_WAIT_L(n) asm volatile("s_waitcnt lgkmcnt(" #n ")" ::: "memory")
#define PG8_BAR __builtin_amdgcn_s_barrier()
#define PG8_SCHED __builtin_amdgcn_sched_barrier(0)
    Unit cur, nxt; int ui = 0;
    if (!S.next(0, cur)) return;
    f32x4 acc[2][2][4][2];
#pragma unroll
    for (int a = 0; a < 2; ++a)
#pragma unroll
        for (int b = 0; b < 2; ++b)
#pragma unroll
            for (int m = 0; m < 4; ++m)
#pragma unroll
                for (int n = 0; n < 2; ++n) acc[a][b][m][n] = (f32x4){0.f, 0.f, 0.f, 0.f};
    bf16x8 At[4][2], B0[2][2], B1[2][2];
    const char* cA = (const char*)g.A + (size_t)cur.pm * tstep; const char* cB = (const char*)g.Bt + (size_t)cur.pn * tstep;
    S.a_ready(cur);
    if constexpr (SP2) {
        PG8_STAGE(PG8_SB(0, 0), cB, voffB); PG8_STAGE(PG8_SB(0, 1), cB + hstep, voffB); PG8_STAGE(PG8_SA(0, 0), cA, voffA); PG8_STAGE(PG8_SA(0, 1), cA + hstep, voffA);
        if (wr == 1) PG8_BAR;
        PG8_WAIT_V(2); PG8_BAR;
        PG8_STAGE(PG8_SB(1, 0), cB + kstep, voffB); PG8_STAGE(PG8_SA(1, 0), cA + kstep, voffA); PG8_STAGE(PG8_SB(1, 1), cB + hstep + kstep, voffB);
        PG8_WAIT_V(6); PG8_BAR;
    } else {
        PG8_STAGE(PG8_SB(0, 0), cB, voffB); PG8_STAGE(PG8_SA(0, 0), cA, voffA); PG8_STAGE(PG8_SB(0, 1), cB + hstep, voffB); PG8_STAGE(PG8_SA(0, 1), cA + hstep, voffA);
        if (wr == 1) PG8_BAR;
        PG8_WAIT_V(4); PG8_BAR;
        PG8_STAGE(PG8_SB(1, 0), cB + kstep, voffB); PG8_STAGE(PG8_SA(1, 0), cA + kstep, voffA); PG8_STAGE(PG8_SB(1, 1), cB + hstep + kstep, voffB);
        PG8_WAIT_V(6); PG8_BAR;
    }
    for (;;) {
        const bool has_next = S.next(ui + 1, nxt);
        const char* nA = has_next ? (const char*)g.A + (size_t)nxt.pm * tstep : cA; const char* nB = has_next ? (const char*)g.Bt + (size_t)nxt.pn * tstep : cB;
        for (int t = 0; t < nt; t += 2) {
            const bool last = (t == nt - 2);
            const char* a1 = cA + (size_t)(t + 1) * kstep;
            const char* a2 = last ? nA : cA + (size_t)(t + 2) * kstep; const char* b2 = last ? nB : cB + (size_t)(t + 2) * kstep;
            const char* a3 = a2 + kstep; const char* b3 = b2 + kstep;
            if (last && has_next) S.a_ready(nxt);
            if constexpr (SP2) {
            PG8_LDB(B0, 0, 0); PG8_LDB(B1, 0, 1); PG8_SCHED; PG8_LDA(At, 0, 0); PG8_STAGE(PG8_SA(1, 1), a1 + hstep, voffA);
            PG8_WAIT_V(8); PG8_WAIT_L(0); PG8_BAR; PG8_MMA(0, 0, At, B0); PG8_MMA(0, 1, At, B1); PG8_BAR; PG8_SCHED;
            PG8_LDA(At, 0, 1); PG8_STAGE(PG8_SB(0, 0), b2, voffB); PG8_STAGE(PG8_SB(0, 1), b2 + hstep, voffB); PG8_STAGE(PG8_SA(0, 0), a2, voffA);
            PG8_WAIT_V(8); PG8_WAIT_L(0); PG8_BAR; PG8_MMA(1, 0, At, B0); PG8_MMA(1, 1, At, B1); PG8_BAR; PG8_SCHED;
            PG8_LDB(B0, 1, 0); PG8_LDB(B1, 1, 1); PG8_SCHED; PG8_LDA(At, 1, 0); PG8_STAGE(PG8_SA(0, 1), a2 + hstep, voffA);
            PG8_WAIT_V(8); PG8_WAIT_L(0); PG8_BAR; PG8_MMA(0, 0, At, B0); PG8_MMA(0, 1, At, B1); PG8_BAR; PG8_SCHED;
            PG8_LDA(At, 1, 1); PG8_STAGE(PG8_SB(1, 0), b3, voffB); PG8_STAGE(PG8_SB(1, 1), b3 + hstep, voffB); PG8_STAGE(PG8_SA(1, 0), a3, voffA);
            PG8_WAIT_V(8); PG8_WAIT_L(0); PG8_BAR; PG8_MMA(1, 0, At, B0); PG8_MMA(1, 1, At, B1); PG8_BAR; PG8_SCHED;
            } else {
            PG8_LDB(B0, 0, 0); PG8_SCHED; PG8_LDA(At, 0, 0); PG8_STAGE(PG8_SA(1, 1), a1 + hstep, voffA);
            PG8_WAIT_L(8); PG8_BAR; PG8_WAIT_L(0); PG8_MMA(0, 0, At, B0); PG8_BAR; PG8_SCHED;
            PG8_LDB(B1, 0, 1); PG8_STAGE(PG8_SB(0, 0), b2, voffB);
            PG8_BAR; PG8_WAIT_L(0); PG8_MMA(0, 1, At, B1); PG8_BAR;
            PG8_LDA(At, 0, 1); PG8_STAGE(PG8_SA(0, 0), a2, voffA);
            PG8_BAR; PG8_WAIT_L(0); PG8_MMA(1, 0, At, B0); PG8_BAR; PG8_SCHED;
            PG8_STAGE(PG8_SB(0, 1), b2 + hstep, voffB);
            PG8_WAIT_V(6); PG8_BAR; PG8_MMA(1, 1, At, B1); PG8_BAR;
            PG8_LDB(B0, 1, 0); PG8_SCHED; PG8_LDA(At, 1, 0); PG8_STAGE(PG8_SA(0, 1), a2 + hstep, voffA);
            PG8_WAIT_L(8); PG8_BAR; PG8_WAIT_L(0); PG8_MMA(0, 0, At, B0); PG8_BAR; PG8_SCHED;
            PG8_LDB(B1, 1, 1); PG8_STAGE(PG8_SB(1, 0), b3, voffB);
            PG8_BAR; PG8_WAIT_L(0); PG8_MMA(0, 1, At, B1); PG8_BAR;
            PG8_LDA(At, 1, 1); PG8_STAGE(PG8_SA(1, 0), a3, voffA);
            PG8_BAR; PG8_WAIT_L(0); PG8_MMA(1, 0, At, B0); PG8_BAR; PG8_SCHED;
            PG8_STAGE(PG8_SB(1, 1), b3 + hstep, voffB);
            PG8_WAIT_V(6); PG8_BAR; PG8_MMA(1, 1, At, B1); PG8_BAR;
            }
        }
        if constexpr (ALIGN_EPI) { if (wr == 0) PG8_BAR; }
        if constexpr (!Epi::AFTER_DRAIN) { E(acc, cur, wr, wc, fr, fq); S.done(cur); }
        if (!has_next) break;
#pragma unroll
        for (int a = 0; a < 2; ++a)
#pragma unroll
            for (int b = 0; b < 2; ++b)
#pragma unroll
                for (int m = 0; m < 4; ++m)
#pragma unroll
                    for (int n = 0; n < 2; ++n) acc[a][b][m][n] = (f32x4){0.f, 0.f, 0.f, 0.f};
        cur = nxt; cA = nA; cB = nB; ++ui;
        if constexpr (ALIGN_EPI) { if (wr == 1) PG8_BAR; }
    }
    PG8_WAIT_V(0);
    if constexpr (!ALIGN_EPI) { if (wr == 0) PG8_BAR; }
    PG8_BAR;
    if constexpr (Epi::AFTER_DRAIN) { E.fused(acc, cur, wr, wc, fr, fq, lds, wid, lane); S.done(cur); }
#undef PG8_SA
#undef PG8_SB
#undef PG8_STAGE
#undef PG8_LDA
#undef PG8_LDB
#undef PG8_MMA
#undef PG8_WAIT_V
#undef PG8_WAIT_L
#undef PG8_BAR
#undef PG8_SCHED
}
}

#define LAS __attribute__((address_space(3)))
typedef unsigned short bf16_t;
typedef short bf16x8 __attribute__((ext_vector_type(8)));
typedef short s16x4 __attribute__((ext_vector_type(4)));
typedef float f32x4 __attribute__((ext_vector_type(4)));
typedef float f32x16 __attribute__((ext_vector_type(16)));
typedef unsigned u32x4 __attribute__((ext_vector_type(4)));
typedef unsigned u32x2 __attribute__((ext_vector_type(2)));

constexpr int NB = 2, T = 8192, M = NB * T, DM = 2048, NZ = 6144, DFF = 5632, NFF2 = 11264, DEPTH = 4;
constexpr int WIN_COLS = 6156;
constexpr int ZC_AX = 0, ZC_AG = 512, ZC_BQ = 1024, ZC_BK = 1536, ZC_BV = 2048, ZC_CQ = 2560, ZC_CZ = 4096, ZC_DQ = 4608, ZC_DK = 5120, ZC_DV = 5632;
constexpr float EPS = 1e-6f;
constexpr int NTHR = 512;

constexpr size_t MiB = 1u << 20;
constexpr size_t WS_CTL = 0, WS_WIN = 1 * MiB, WS_WOUT = 97 * MiB, WS_WUP = 129 * MiB, WS_WDN = 305 * MiB, WS_WG = 393 * MiB, WS_HB = 394 * MiB, WS_ACT = 458 * MiB;
constexpr size_t WS_Z = 634 * MiB, WS_Y = 826 * MiB, WS_GL = 890 * MiB, WS_FOXC = 891 * MiB, WS_LRUA = 892 * MiB, WS_LRUU = 924 * MiB, WS_LAGG = 956 * MiB;
constexpr size_t WS_GREC = 957 * MiB, WS_GU = 1013 * MiB, WS_GLAST = 1045 * MiB, WS_OC = 1046 * MiB, WS_OD = 1078 * MiB, WS_LSE = 1126 * MiB, WS_KP = 1127 * MiB, WS_VP = 1143 * MiB, WS_END = 1159 * MiB;
constexpr size_t WS_U = 634 * MiB;
constexpr int GREC_BYTES = 57344;

constexpr int LDS_BYTES = 147456;
constexpr int LDS_MISC = 140 * 1024;

__device__ __forceinline__ unsigned f2bf(float f) { unsigned u = __builtin_bit_cast(unsigned, f); return (u + 0x7fffu + ((u >> 16) & 1u)) >> 16; }
typedef float f32x2_t __attribute__((ext_vector_type(2))); typedef __bf16 bf16x2_t __attribute__((ext_vector_type(2)));
__device__ __forceinline__ unsigned pk2(float lo, float hi) { const f32x2_t v = {lo, hi}; const bf16x2_t b = __builtin_convertvector(v, bf16x2_t); return __builtin_bit_cast(unsigned, b); }
__device__ __forceinline__ float bf2f(unsigned short u) { return __builtin_bit_cast(float, (unsigned)u << 16); }
__device__ __forceinline__ float bflo(unsigned w) { return __builtin_bit_cast(float, w << 16); }
__device__ __forceinline__ float bfhi(unsigned w) { return __builtin_bit_cast(float, w & 0xffff0000u); }
__device__ __forceinline__ float wave_sum(float v) {
#pragma unroll
    for (int o = 1; o < 64; o <<= 1) v += __shfl_xor(v, o);
    return v;
}
__device__ __forceinline__ float sigmoidf_(float x) { return 1.0f / (1.0f + __expf(-x)); }
__device__ __forceinline__ float siluf_(float x) { return x / (1.0f + __expf(-x)); }
__device__ __forceinline__ float softplusf_(float x) { return fmaxf(x, 0.f) + log1pf(__expf(-fabsf(x))); }
__device__ __forceinline__ float gelu_tanh(float x) { const float u = 0.7978845608028654f * (x + 0.044715f * x * x * x); return x * __builtin_amdgcn_rcpf(1.0f + __expf(-2.0f * u)); }
__device__ __forceinline__ int perm32(int p) { const int g = p >> 3, j = p & 7; return (j < 4) ? (4 * g + j) : (16 + 4 * g + (j - 4)); }
__device__ __forceinline__ int invperm32(int x) { return (x < 16) ? (8 * (x >> 2) + (x & 3)) : (8 * ((x - 16) >> 2) + 4 + (x & 3)); }

struct Params {
    const float* in[25];
    float* out;
    unsigned char* ws;
};
struct Ctx {
    const LAS unsigned* tab;
    __device__ __forceinline__ unsigned long long ld(int i) const {
        const LAS unsigned* t = tab; asm volatile("" : "+v"(t));
        const unsigned lo = __builtin_amdgcn_readfirstlane(t[2 * i]), hi = __builtin_amdgcn_readfirstlane(t[2 * i + 1]);
        return ((unsigned long long)hi << 32) | lo;
    }
    __device__ __forceinline__ const float* in(int i) const { return (const float*)ld(i); }
    __device__ __forceinline__ float* out() const { return (float*)ld(25); }
    __device__ __forceinline__ unsigned char* ws() const { return (unsigned char*)ld(26); }
};

__device__ __forceinline__ void p0_item(const float* W, int ldw, int ncol0, bf16_t* WT, int K, int nrow0, int k0, LAS float* scr, int lane) {
    {
        const int row = lane >> 4, c4 = (lane & 15) * 4;
        const float* src = W + (size_t)(k0 + row) * ldw + ncol0 + c4;
#pragma unroll
        for (int i = 0; i < 16; ++i) {
            const f32x4 v = *(const f32x4*)(src + (size_t)(4 * i) * ldw);
            LAS float* d = scr + (4 * i + row) * 65 + c4;
            d[0] = v.x; d[1] = v.y; d[2] = v.z; d[3] = v.w;
        }
    }
    asm volatile("s_waitcnt lgkmcnt(0)" ::: "memory");
    const int c = lane & 7, ns = lane >> 3;
#pragma unroll
    for (int j = 0; j < 8; ++j) {
        const int n = ns + 8 * j; const LAS float* s = scr + (8 * c) * 65 + n;
        u32x4 o; o.x = pk2(s[0 * 65], s[1 * 65]); o.y = pk2(s[2 * 65], s[3 * 65]); o.z = pk2(s[4 * 65], s[5 * 65]); o.w = pk2(s[6 * 65], s[7 * 65]);
        *(u32x4*)(WT + (size_t)(nrow0 + n) * K + k0 + 8 * c) = o;
    }
    asm volatile("s_waitcnt lgkmcnt(0)" ::: "memory");
}
__device__ __forceinline__ int win_orig_col(int p) { return p < 2560 ? p : (p < 4096 ? p + 4 : (p < 4608 ? p + 4 : p + 12)); }

constexpr int P0_I_IN = (DM / 64) * (NZ / 64), P0_I_OUT = (DM / 64) * (DM / 64), P0_I_UP = (DM / 64) * (NFF2 / 64), P0_I_DN = (DFF / 64) * (DM / 64);
constexpr int P0_PER_L = P0_I_IN + P0_I_OUT + P0_I_UP + P0_I_DN;
__device__ __forceinline__ void p0_do_item(const Ctx& P, int l, int r, LAS float* scr, int lane) {
    unsigned char* ws = P.ws();
    if (r < P0_I_IN) { const int nblk = NZ / 64, kb = r / nblk, nb = r % nblk;
        p0_item(P.in(2) + (size_t)l * DM * WIN_COLS, WIN_COLS, win_orig_col(64 * nb), (bf16_t*)(ws + WS_WIN) + (size_t)l * NZ * DM, DM, 64 * nb, 64 * kb, scr, lane); return; }
    r -= P0_I_IN;
    if (r < P0_I_OUT) { const int nblk = DM / 64, kb = r / nblk, nb = r % nblk;
        p0_item(P.in(18) + (size_t)l * DM * DM, DM, 64 * nb, (bf16_t*)(ws + WS_WOUT) + (size_t)l * DM * DM, DM, 64 * nb, 64 * kb, scr, lane); return; }
    r -= P0_I_OUT;
    if (r < P0_I_UP) { const int nblk = NFF2 / 64, kb = r / nblk, nb = r % nblk;
        p0_item(P.in(20) + (size_t)l * DM * NFF2, NFF2, 64 * nb, (bf16_t*)(ws + WS_WUP) + (size_t)l * NFF2 * DM, DM, 64 * nb, 64 * kb, scr, lane); return; }
    r -= P0_I_UP;
    { const int nblk = DM / 64, kb = r / nblk, nb = r % nblk;
        p0_item(P.in(23) + (size_t)l * DFF * DM, DM, 64 * nb, (bf16_t*)(ws + WS_WDN) + (size_t)l * DM * DFF, DFF, 64 * nb, 64 * kb, scr, lane); }
}
__device__ __forceinline__ void p0_prologue(const Ctx& P, LAS unsigned char* lds, int gw, int NGW, int wave, int lane) {
    LAS float* scr = (LAS float*)(lds + wave * 16640);
    for (int it = gw; it < P0_PER_L; it += NGW) p0_do_item(P, 0, it, scr, lane);
    float* WG = (float*)(P.ws() + WS_WG);
    const int gt = gw * 64 + lane, NGT = NGW * 64;
    for (int i = gt; i < DEPTH * 12 * DM; i += NGT) {
        const int l = i / (12 * DM), j = (i / DM) % 12, k = i % DM;
        const int col = (j < 4) ? (2560 + j) : (j < 8 ? 4612 + (j - 4) : 4616 + (j - 8));
        WG[i] = P.in(2)[(size_t)l * DM * WIN_COLS + (size_t)k * WIN_COLS + col];
    }
}
__device__ __forceinline__ void p0_unit(const Ctx& P, int l, int idx, LAS unsigned char* lds, int wave, int lane) {
    __syncthreads();
    const int r = idx * 8 + wave;
    if (r < P0_PER_L) p0_do_item(P, l, r, (LAS float*)(lds + wave * 16640), lane);
    __syncthreads();
}

template <bool GATES>
__device__ __forceinline__ void norm_phase(const float* src, float* copy_dst, const float* gain, bf16_t* HB, const float* WGl, float* GL,
                                           LAS unsigned char* lds, int tid, int wave, int lane, int bid, int nblk) {
    LAS float* wg = (LAS float*)lds;
    if (GATES) {
        for (int i = tid; i < 12 * DM / 4; i += NTHR) ((LAS f32x4*)wg)[i] = ((const f32x4*)WGl)[i];
        __syncthreads();
    }
    f32x4 gv[8];
#pragma unroll
    for (int j = 0; j < 8; ++j) gv[j] = ((const f32x4*)gain)[lane + 64 * j];
    f32x4 vn[8];
    {
        const f32x4* xr0 = (const f32x4*)(src + (size_t)(bid * 8 + wave) * DM);
#pragma unroll
        for (int j = 0; j < 8; ++j) vn[j] = xr0[lane + 64 * j];
    }
    for (int m = bid * 8 + wave; m < M; m += nblk * 8) {
        f32x4 v[8]; float ss = 0.f;
#pragma unroll
        for (int j = 0; j < 8; ++j) { v[j] = vn[j]; ss += (v[j].x * v[j].x + v[j].y * v[j].y) + (v[j].z * v[j].z + v[j].w * v[j].w); }
        if (m + nblk * 8 < M) {
            const f32x4* xr = (const f32x4*)(src + (size_t)(m + nblk * 8) * DM);
#pragma unroll
            for (int j = 0; j < 8; ++j) vn[j] = xr[lane + 64 * j];
        }
        if (copy_dst) {
            f32x4* cr = (f32x4*)(copy_dst + (size_t)m * DM);
#pragma unroll
            for (int j = 0; j < 8; ++j) cr[lane + 64 * j] = v[j];
        }
        const float rs = rsqrtf(wave_sum(ss) * (1.0f / DM) + EPS);
        u32x2* o8 = (u32x2*)(HB + (size_t)m * DM);
#pragma unroll
        for (int j = 0; j < 8; ++j) { v[j] = v[j] * rs * gv[j]; u32x2 w; w.x = pk2(v[j].x, v[j].y); w.y = pk2(v[j].z, v[j].w); o8[lane + 64 * j] = w; }
        if (GATES) {
            float myv = 0.f;
#pragma unroll 1
            for (int g = 0; g < 12; ++g) {
                float a = 0.f;
#pragma unroll
                for (int j = 0; j < 8; ++j) { const f32x4 w = ((LAS f32x4*)(wg + g * DM))[lane + 64 * j]; a += (v[j].x * w.x + v[j].y * w.y) + (v[j].z * w.z + v[j].w * w.w); }
                a = wave_sum(a);
                if (lane == g) myv = a;
            }
            if (lane < 12) GL[(size_t)m * 16 + lane] = myv;
        }
    }
    if (GATES) __syncthreads();
}

__device__ __forceinline__ void norm_gates_phase(const float* src, float* copy_dst, const float* gain, bf16_t* HB, const float* WGl, float* GL,
                                                 LAS unsigned char* lds, int tid, int wave, int lane, int bid, int nblk) {
    constexpr int NR = 2;
    LAS float* wg = (LAS float*)lds;
    for (int i = tid; i < 12 * DM / 4; i += NTHR) ((LAS f32x4*)wg)[i] = ((const f32x4*)WGl)[i];
    __syncthreads();
    const int stride = nblk * 8;
    for (int m = bid * 8 + wave; m < M; m += NR * stride) {
        int mr[NR];
#pragma unroll
        for (int r = 0; r < NR; ++r) mr[r] = (m + r * stride < M) ? m + r * stride : m;
        f32x4 v[NR][8]; float ss[NR];
#pragma unroll
        for (int r = 0; r < NR; ++r) { const f32x4* xr = (const f32x4*)(src + (size_t)mr[r] * DM);
#pragma unroll
            for (int j = 0; j < 8; ++j) v[r][j] = xr[lane + 64 * j]; }
#pragma unroll
        for (int r = 0; r < NR; ++r) { float s = 0.f;
#pragma unroll
            for (int j = 0; j < 8; ++j) s += (v[r][j].x * v[r][j].x + v[r][j].y * v[r][j].y) + (v[r][j].z * v[r][j].z + v[r][j].w * v[r][j].w);
            ss[r] = s; }
        if (copy_dst) {
#pragma unroll
            for (int r = 0; r < NR; ++r) { f32x4* cr = (f32x4*)(copy_dst + (size_t)mr[r] * DM);
#pragma unroll
                for (int j = 0; j < 8; ++j) cr[lane + 64 * j] = v[r][j]; }
        }
#pragma unroll
        for (int o = 1; o < 64; o <<= 1) {
#pragma unroll
            for (int r = 0; r < NR; ++r) ss[r] += __shfl_xor(ss[r], o);
        }
#pragma unroll
        for (int r = 0; r < NR; ++r) {
            const float rs = rsqrtf(ss[r] * (1.0f / DM) + EPS);
            u32x2* o8 = (u32x2*)(HB + (size_t)mr[r] * DM);
#pragma unroll
            for (int j = 0; j < 8; ++j) { const f32x4 g = ((const f32x4*)gain)[lane + 64 * j]; v[r][j] = v[r][j] * rs * g;
                u32x2 w; w.x = pk2(v[r][j].x, v[r][j].y); w.y = pk2(v[r][j].z, v[r][j].w); o8[lane + 64 * j] = w; }
        }
        float y[NR];
#pragma unroll
        for (int r = 0; r < NR; ++r) y[r] = 0.f;
#pragma unroll 1
        for (int g = 0; g < 12; ++g) {
            float a[NR];
#pragma unroll
            for (int r = 0; r < NR; ++r) a[r] = 0.f;
#pragma unroll
            for (int j = 0; j < 8; ++j) { const f32x4 w = ((LAS f32x4*)(wg + g * DM))[lane + 64 * j];
#pragma unroll
                for (int r = 0; r < NR; ++r) a[r] += (v[r][j].x * w.x + v[r][j].y * w.y) + (v[r][j].z * w.z + v[r][j].w * w.w); }
#pragma unroll
            for (int o = 1; o < 64; o <<= 1) {
#pragma unroll
                for (int r = 0; r < NR; ++r) a[r] += __shfl_xor(a[r], o);
            }
            if (lane == g) {
#pragma unroll
                for (int r = 0; r < NR; ++r) y[r] = a[r];
            }
        }
        if (lane < 12) {
#pragma unroll
            for (int r = 0; r < NR; ++r) GL[(size_t)mr[r] * 16 + lane] = y[r];
        }
    }
    __syncthreads();
}

__device__ __forceinline__ void final_norm_phase(float* X, const float* gain, int wave, int lane, int bid, int nblk) {
    f32x4 gv[8];
#pragma unroll
    for (int j = 0; j < 8; ++j) gv[j] = ((const f32x4*)gain)[lane + 64 * j];
    for (int m = bid * 8 + wave; m < M; m += nblk * 8) {
        f32x4* xr = (f32x4*)(X + (size_t)m * DM);
        f32x4 v[8]; float ss = 0.f;
#pragma unroll
        for (int j = 0; j < 8; ++j) { v[j] = xr[lane + 64 * j]; ss += (v[j].x * v[j].x + v[j].y * v[j].y) + (v[j].z * v[j].z + v[j].w * v[j].w); }
        const float rs = rsqrtf(wave_sum(ss) * (1.0f / DM) + EPS);
#pragma unroll
        for (int j = 0; j < 8; ++j) xr[lane + 64 * j] = v[j] * rs * gv[j];
    }
}

struct EpiBf16NT {
    static constexpr bool PERM = true, AFTER_DRAIN = false;
    bf16_t* O; int ldc;
    __device__ __forceinline__ void operator()(const pg8::f32x4 (&acc)[2][2][4][2], const pg8::Unit& u, int wr, int wc, int fr, int fq) const {
        const int row0 = u.pm * 256 + wr * 64 + fr; const int col0 = u.pn * 256 + wc * 32 + 8 * fq;
#pragma unroll
        for (int ai = 0; ai < 2; ++ai)
#pragma unroll
            for (int m = 0; m < 4; ++m) {
                bf16_t* rowp = O + (size_t)(row0 + ai * 128 + m * 16) * ldc + col0;
#pragma unroll
                for (int bj = 0; bj < 2; ++bj) {
                    const pg8::f32x4 v0 = acc[ai][bj][m][0], v1 = acc[ai][bj][m][1];
                    u32x4 w; w.x = pk2(v0[0], v0[1]); w.y = pk2(v0[2], v0[3]); w.z = pk2(v1[0], v1[1]); w.w = pk2(v1[2], v1[3]);
                    __builtin_nontemporal_store(w, (u32x4*)(rowp + bj * 128));
                }
            }
    }
};
struct EpiResAdd {
    static constexpr bool PERM = true, AFTER_DRAIN = false;
    float* X; int ldc;
    __device__ __forceinline__ void operator()(const pg8::f32x4 (&acc)[2][2][4][2], const pg8::Unit& u, int wr, int wc, int fr, int fq) const {
#pragma unroll
        for (int ai = 0; ai < 2; ++ai)
#pragma unroll
            for (int m = 0; m < 4; ++m) {
                float* rowp = X + (size_t)(u.pm * 256 + ai * 128 + wr * 64 + m * 16 + fr) * ldc + u.pn * 256 + wc * 32 + 8 * fq;
                pg8::f32x4 v[2][2];
#pragma unroll
                for (int bj = 0; bj < 2; ++bj)
#pragma unroll
                    for (int n = 0; n < 2; ++n) v[bj][n] = *(const pg8::f32x4*)(rowp + bj * 128 + n * 4);
#pragma unroll
                for (int bj = 0; bj < 2; ++bj)
#pragma unroll
                    for (int n = 0; n < 2; ++n) *(pg8::f32x4*)(rowp + bj * 128 + n * 4) = v[bj][n] + acc[ai][bj][m][n];
            }
    }
};
#define XB_TMO      128
#define XB_XCNT(j)  (256  + 64 * (j))
#define XB_XSUB(j)  (1280 + 64 * (j))
#define XB_XGEN(j)  (2304 + 64 * (j))
#define XB_TOP      3328
#define XB_TOPGEN   3392
#define XCD_BAR_WORDS 3456
#define XB_SPIN_CAP (1u << 18)

__device__ __forceinline__ unsigned xb_ld(unsigned* p)              { return __hip_atomic_load(p, __ATOMIC_RELAXED, __HIP_MEMORY_SCOPE_AGENT); }
__device__ __forceinline__ unsigned xb_add(unsigned* p, unsigned v) { return __hip_atomic_fetch_add(p, v, __ATOMIC_RELAXED, __HIP_MEMORY_SCOPE_AGENT); }
__device__ __forceinline__ unsigned xb_xcc_id() { return (unsigned)__builtin_amdgcn_s_getreg((3 << 11) | 20) & 0xFu; }
#define XB_SPIN(cond, bar) do { unsigned _sp = 0; while (cond) { __builtin_amdgcn_s_sleep(1); \
    if ((++_sp & 255u) == 0u) { if (xb_ld(&(bar)[XB_TMO])) break; if (_sp > XB_SPIN_CAP) { atomicAdd(&(bar)[XB_TMO], 1u); break; } } } } while (0)

struct XcdBarrier {
    unsigned* bar; unsigned x;
    volatile LAS unsigned* st;
};

__device__ __forceinline__ XcdBarrier xcd_barrier_post(unsigned* bar, volatile LAS unsigned* st) {
    XcdBarrier b; b.bar = bar; b.x = xb_xcc_id(); b.st = st;
    if (threadIdx.x == 0) (void)xb_add(&bar[XB_XCNT(b.x)], 1u);
    return b;
}
__device__ __forceinline__ void xcd_barrier_complete(unsigned* bar, unsigned x, unsigned& nloc, unsigned& nx) {
    const unsigned G = gridDim.x * gridDim.y * gridDim.z;
    unsigned sum, cnt, mine, sp = 0u;
    for (;;) {
        sum = 0u; cnt = 0u; mine = 0u;
#pragma unroll
        for (unsigned j = 0; j < 16; ++j) { const unsigned c = xb_ld(&bar[XB_XCNT(j)]); sum += c; cnt += (c > 0u) ? 1u : 0u; mine = (j == x) ? c : mine; }
        if (sum == G) break;
        __builtin_amdgcn_s_sleep(1);
        if ((++sp & 255u) == 0u) { if (xb_ld(&bar[XB_TMO])) break; if (sp > XB_SPIN_CAP) { atomicAdd(&bar[XB_TMO], 1u); break; } }
    }
    nloc = mine > 0u ? mine : 1u; nx = cnt > 0u ? cnt : 1u;
}

__device__ __forceinline__ void xcd_barrier(const XcdBarrier& b) {
    asm volatile("s_waitcnt vmcnt(0)" ::: "memory");
    __syncthreads();
    if (threadIdx.x == 0) {
        unsigned* bar = b.bar;
        __builtin_amdgcn_s_waitcnt(0);
        unsigned nloc = b.st[0], nx = b.st[1];
        if (nloc == 0u) { xcd_barrier_complete(bar, b.x, nloc, nx); b.st[0] = nloc; b.st[1] = nx; }
        const unsigned old = xb_add(&bar[XB_XSUB(b.x)], 1u);
        const unsigned gen = old / nloc;
        if (old + 1u == (gen + 1u) * nloc) {
            __builtin_amdgcn_fence(__ATOMIC_RELEASE, "agent");
            asm volatile("s_waitcnt vmcnt(0)" ::: "memory");
            const unsigned og = xb_add(&bar[XB_TOP], 1u);
            const unsigned tg = og / nx;
            if (og + 1u == (tg + 1u) * nx) xb_add(&bar[XB_TOPGEN], 1u);
            else XB_SPIN(xb_ld(&bar[XB_TOPGEN]) == tg, bar);
            __builtin_amdgcn_fence(__ATOMIC_ACQUIRE, "agent");
            xb_add(&bar[XB_XGEN(b.x)], 1u);
            asm volatile("s_waitcnt vmcnt(0)" ::: "memory");
        } else {
            XB_SPIN(xb_ld(&bar[XB_XGEN(b.x)]) == gen, bar);
            __builtin_amdgcn_fence(__ATOMIC_ACQUIRE, "agent");
            asm volatile("s_waitcnt vmcnt(0)" ::: "memory");
        }
    }
    __syncthreads();
}

__device__ __forceinline__ void lru_chunk_unit(const Ctx& P, int l, int unit, LAS unsigned char* lds, int tid, int wave, int lane) {
    const bf16_t* Z = (const bf16_t*)(P.ws() + WS_Z);
    float* LA = (float*)(P.ws() + WS_LRUA); float* LU = (float*)(P.ws() + WS_LRUU); float* AGG = (float*)(P.ws() + WS_LAGG);
    const int b = unit >> 7, ck = unit & 127, t0 = ck * 64; const size_t m0 = (size_t)b * T + t0;
    const int ch = tid;
    LAS float* xw = (LAS float*)(lds + wave * 16384);
    {
        const int cg8 = tid & 63, tg = tid >> 6, c0 = 8 * cg8, tb = 8 * tg;
        const float* cw = P.in(3) + (size_t)l * 4 * 512 + c0; const float* cbp = P.in(4) + l * 512 + c0;
        f32x4 w[4][2], bb[2];
#pragma unroll
        for (int k = 0; k < 4; ++k) { w[k][0] = *(const f32x4*)(cw + k * 512); w[k][1] = *(const f32x4*)(cw + k * 512 + 4); }
        bb[0] = *(const f32x4*)cbp; bb[1] = *(const f32x4*)(cbp + 4);
        u32x4 r[11];
#pragma unroll
        for (int j = 0; j < 11; ++j) {
            const int tt = t0 + tb + j - 3;
            if (tt >= 0) r[j] = *(const u32x4*)(Z + (m0 + tb + j - 3) * NZ + ZC_AX + c0); else r[j] = (u32x4){0u, 0u, 0u, 0u};
        }
        LAS float* xt = (LAS float*)(lds + (cg8 >> 3) * 16384) + (c0 & 63);
#pragma unroll
        for (int t = 0; t < 8; ++t) {
            f32x4 o0, o1;
#pragma unroll
            for (int q = 0; q < 4; ++q) {
                const float lo = bb[q >> 1][(2 * q) & 3] + w[0][q >> 1][(2 * q) & 3] * bflo(r[t][q]) + w[1][q >> 1][(2 * q) & 3] * bflo(r[t + 1][q]) + w[2][q >> 1][(2 * q) & 3] * bflo(r[t + 2][q]) + w[3][q >> 1][(2 * q) & 3] * bflo(r[t + 3][q]);
                const float hi = bb[q >> 1][(2 * q + 1) & 3] + w[0][q >> 1][(2 * q + 1) & 3] * bfhi(r[t][q]) + w[1][q >> 1][(2 * q + 1) & 3] * bfhi(r[t + 1][q]) + w[2][q >> 1][(2 * q + 1) & 3] * bfhi(r[t + 2][q]) + w[3][q >> 1][(2 * q + 1) & 3] * bfhi(r[t + 3][q]);
                if (q < 2) { o0[2 * q] = lo; o0[2 * q + 1] = hi; } else { o1[2 * (q - 2)] = lo; o1[2 * (q - 2) + 1] = hi; }
            }
            *(LAS f32x4*)(xt + (tb + t) * 64) = o0; *(LAS f32x4*)(xt + (tb + t) * 64 + 4) = o1;
        }
    }
    __syncthreads();
    const float* wa = P.in(5) + ((size_t)l * 8 + wave) * 4096; const float* wx = P.in(7) + ((size_t)l * 8 + wave) * 4096;
    const float ba = P.in(6)[l * 512 + ch], bx = P.in(8)[l * 512 + ch];
    const float lam = P.in(9)[l * 512 + ch]; const float sp = softplusf_(-lam);
    float h = 0.f, ap = 1.f;
    for (int half = 0; half < 2; ++half) {
        float ra[32], ia[32];
#pragma unroll
        for (int t = 0; t < 32; ++t) { ra[t] = ba; ia[t] = bx; }
        float n0 = wa[lane], n1 = wa[64 + lane], n2 = wa[128 + lane], n3 = wa[192 + lane], n4 = wx[lane], n5 = wx[64 + lane], n6 = wx[128 + lane], n7 = wx[192 + lane];
        for (int c = 0; c < 64; c += 4) {
            const float a0 = n0, a1 = n1, a2 = n2, a3 = n3, b0 = n4, b1 = n5, b2 = n6, b3 = n7;
            { const int cn = (c + 4 < 64) ? c + 4 : c;
              n0 = wa[(cn + 0) * 64 + lane]; n1 = wa[(cn + 1) * 64 + lane]; n2 = wa[(cn + 2) * 64 + lane]; n3 = wa[(cn + 3) * 64 + lane];
              n4 = wx[(cn + 0) * 64 + lane]; n5 = wx[(cn + 1) * 64 + lane]; n6 = wx[(cn + 2) * 64 + lane]; n7 = wx[(cn + 3) * 64 + lane]; }
#pragma unroll
            for (int t = 0; t < 32; ++t) {
                const f32x4 xv = *(const LAS f32x4*)(xw + (half * 32 + t) * 64 + c);
                ra[t] += xv.x * a0 + xv.y * a1 + xv.z * a2 + xv.w * a3;
                ia[t] += xv.x * b0 + xv.y * b1 + xv.z * b2 + xv.w * b3;
            }
        }
#pragma unroll
        for (int t = 0; t < 32; ++t) {
            const int tt = half * 32 + t;
            const float r = sigmoidf_(ra[t]), ig = sigmoidf_(ia[t]);
            const float log_a = -8.0f * r * sp;
            const float a = __expf(log_a);
            const float u = __builtin_amdgcn_sqrtf(fmaxf(1.0f - a * a, 0.f)) * (ig * xw[tt * 64 + lane]);
            LA[(m0 + tt) * 512 + ch] = a; LU[(m0 + tt) * 512 + ch] = u;
            h = a * h + u; ap *= a;
        }
    }
    AGG[((size_t)unit * 2 + 0) * 512 + ch] = ap; AGG[((size_t)unit * 2 + 1) * 512 + ch] = h;
}

__device__ __forceinline__ void fox_cumsum_unit(const Ctx& P, int l, int unit, LAS unsigned char* lds, int tid, int wave, int lane) {
    const float* GL = (const float*)(P.ws() + WS_GL); float* FC = (float*)(P.ws() + WS_FOXC);
    const int b = unit >> 2, hh = unit & 3; const float fb = P.in(10)[l * 4 + hh];
    LAS float* wtot = (LAS float*)lds;
    float v[16]; float s = 0.f;
#pragma unroll
    for (int i = 0; i < 16; ++i) { const float x = GL[((size_t)b * T + tid * 16 + i) * 16 + hh] + fb; const float lf = fminf(x, 0.f) - log1pf(__expf(-fabsf(x))); s += lf; v[i] = s; }
    float sc = s;
#pragma unroll
    for (int o = 1; o < 64; o <<= 1) { const float n = __shfl_up(sc, o); if (lane >= o) sc += n; }
    __syncthreads();
    if (lane == 63) wtot[wave] = sc;
    __syncthreads();
    float base = sc - s;
    for (int w = 0; w < wave; ++w) base += wtot[w];
#pragma unroll
    for (int i = 0; i < 16; ++i) FC[((size_t)unit) * T + tid * 16 + i] = (base + v[i]) * 1.4426950408889634f;
    __syncthreads();
}

__device__ __forceinline__ void gdn_prep_unit(const Ctx& P, int l, int unit, LAS unsigned char* lds, int tid, int wave, int lane) {
    const bf16_t* Z = (const bf16_t*)(P.ws() + WS_Z); const float* GL = (const float*)(P.ws() + WS_GL);
    const int bh = unit >> 7, n = unit & 127, b = bh >> 2, hh = bh & 3; const size_t m0 = (size_t)b * T + n * 64;
    LAS float* Kf = (LAS float*)lds; LAS float* Qf = Kf + 64 * 132; LAS float* Vf = Qf + 64 * 132; LAS float* KK = Vf + 64 * 132; LAS float* QKm = KK + 64 * 68;
    LAS float* gcs = QKm + 64 * 68; LAS float* bet = gcs + 64; LAS float* eg = bet + 64;
    __syncthreads();
    {
        const int cg = tid & 15, tg = tid >> 4, tb = 2 * tg;
        const float* cw = P.in(11) + (size_t)l * 4 * 1536;
#pragma unroll
        for (int part = 0; part < 3; ++part) {
            const int cc = part * 512 + hh * 128 + 8 * cg; const int zc = ZC_CQ + cc;
            f32x4 w[4][2];
#pragma unroll
            for (int k = 0; k < 4; ++k) { w[k][0] = *(const f32x4*)(cw + k * 1536 + cc); w[k][1] = *(const f32x4*)(cw + k * 1536 + cc + 4); }
            u32x4 r[5];
#pragma unroll
            for (int j = 0; j < 5; ++j) {
                const int tt = n * 64 + tb + j - 3;
                if (tt >= 0) r[j] = *(const u32x4*)(Z + (m0 + tb + j - 3) * NZ + zc); else r[j] = (u32x4){0u, 0u, 0u, 0u};
            }
            LAS float* dst = ((part == 0) ? Qf : (part == 1 ? Kf : Vf)) + 8 * cg;
#pragma unroll
            for (int t = 0; t < 2; ++t) {
                f32x4 o0, o1;
#pragma unroll
                for (int q = 0; q < 4; ++q) {
                    const float lo = w[0][q >> 1][(2 * q) & 3] * bflo(r[t][q]) + w[1][q >> 1][(2 * q) & 3] * bflo(r[t + 1][q]) + w[2][q >> 1][(2 * q) & 3] * bflo(r[t + 2][q]) + w[3][q >> 1][(2 * q) & 3] * bflo(r[t + 3][q]);
                    const float hi = w[0][q >> 1][(2 * q + 1) & 3] * bfhi(r[t][q]) + w[1][q >> 1][(2 * q + 1) & 3] * bfhi(r[t + 1][q]) + w[2][q >> 1][(2 * q + 1) & 3] * bfhi(r[t + 2][q]) + w[3][q >> 1][(2 * q + 1) & 3] * bfhi(r[t + 3][q]);
                    if (q < 2) { o0[2 * q] = siluf_(lo); o0[2 * q + 1] = siluf_(hi); } else { o1[2 * (q - 2)] = siluf_(lo); o1[2 * (q - 2) + 1] = siluf_(hi); }
                }
                *(LAS f32x4*)(dst + (tb + t) * 132) = o0; *(LAS f32x4*)(dst + (tb + t) * 132 + 4) = o1;
            }
        }
        if (tid < 64) {
            const float bl = GL[(m0 + tid) * 16 + 4 + hh], al = GL[(m0 + tid) * 16 + 8 + hh];
            const float g = -__expf(P.in(12)[l * 4 + hh]) * softplusf_(al + P.in(13)[l * 4 + hh]);
            float sc = g;
#pragma unroll
            for (int o = 1; o < 64; o <<= 1) { const float nn = __shfl_up(sc, o); if (lane >= o) sc += nn; }
            gcs[tid] = sc; eg[tid] = __expf(sc); bet[tid] = sigmoidf_(bl);
        }
    }
    __syncthreads();
    {
        for (int i = tid; i < 2 * 64 * 68; i += NTHR) KK[i] = 0.f;
        const int row = tid >> 2, j = tid & 3; LAS float* base = (row < 64) ? (Qf + row * 132) : (Kf + (row - 64) * 132);
        float ss = 0.f;
#pragma unroll 8
        for (int e = 0; e < 32; ++e) { const float x = base[4 * e + j]; ss += x * x; }
        ss += __shfl_xor(ss, 1); ss += __shfl_xor(ss, 2);
        const float rn = rsqrtf(ss + EPS) * ((row < 64) ? 0.08838834764831845f : 1.0f);
#pragma unroll 8
        for (int e = 0; e < 32; ++e) base[4 * e + j] *= rn;
    }
    __syncthreads();
    {
        const int fr = lane & 15, g = lane >> 4;
        for (int ti = wave; ti < 10; ti += 8) {
            const int it = (ti < 1) ? 0 : (ti < 3 ? 1 : (ti < 6 ? 2 : 3));
            const int jt = ti - ((it * (it + 1)) >> 1);
            const LAS float* AK = Kf + (16 * it + fr) * 132 + 8 * g;
            const LAS float* AQ = Qf + (16 * it + fr) * 132 + 8 * g;
            const LAS float* Brow = Kf + (16 * jt + fr) * 132 + 8 * g;
            f32x4 accK = {0.f, 0.f, 0.f, 0.f}, accQ = {0.f, 0.f, 0.f, 0.f};
#pragma unroll
            for (int ks = 0; ks < 4; ++ks) {
                const f32x4 b0 = *(const LAS f32x4*)(Brow + 32 * ks), b1 = *(const LAS f32x4*)(Brow + 32 * ks + 4);
                u32x4 bh, bl;
                bh.x = pk2(b0.x, b0.y); bh.y = pk2(b0.z, b0.w); bh.z = pk2(b1.x, b1.y); bh.w = pk2(b1.z, b1.w);
                bl.x = pk2(b0.x - bflo(bh.x), b0.y - bfhi(bh.x)); bl.y = pk2(b0.z - bflo(bh.y), b0.w - bfhi(bh.y)); bl.z = pk2(b1.x - bflo(bh.z), b1.y - bfhi(bh.z)); bl.w = pk2(b1.z - bflo(bh.w), b1.w - bfhi(bh.w));
                const bf16x8 BH = __builtin_bit_cast(bf16x8, bh), BL = __builtin_bit_cast(bf16x8, bl);
#pragma unroll
                for (int kind = 0; kind < 2; ++kind) {
                    const LAS float* Ar = (kind == 0) ? AK : AQ;
                    const f32x4 a0 = *(const LAS f32x4*)(Ar + 32 * ks), a1 = *(const LAS f32x4*)(Ar + 32 * ks + 4);
                    u32x4 ah, al;
                    ah.x = pk2(a0.x, a0.y); ah.y = pk2(a0.z, a0.w); ah.z = pk2(a1.x, a1.y); ah.w = pk2(a1.z, a1.w);
                    al.x = pk2(a0.x - bflo(ah.x), a0.y - bfhi(ah.x)); al.y = pk2(a0.z - bflo(ah.y), a0.w - bfhi(ah.y)); al.z = pk2(a1.x - bflo(ah.z), a1.y - bfhi(ah.z)); al.w = pk2(a1.z - bflo(ah.w), a1.w - bfhi(ah.w));
                    const bf16x8 AH = __builtin_bit_cast(bf16x8, ah), AL = __builtin_bit_cast(bf16x8, al);
                    if (kind == 0) { accK = __builtin_amdgcn_mfma_f32_16x16x32_bf16(AL, BH, accK, 0, 0, 0); accK = __builtin_amdgcn_mfma_f32_16x16x32_bf16(AH, BL, accK, 0, 0, 0); accK = __builtin_amdgcn_mfma_f32_16x16x32_bf16(AH, BH, accK, 0, 0, 0); }
                    else           { accQ = __builtin_amdgcn_mfma_f32_16x16x32_bf16(AL, BH, accQ, 0, 0, 0); accQ = __builtin_amdgcn_mfma_f32_16x16x32_bf16(AH, BL, accQ, 0, 0, 0); accQ = __builtin_amdgcn_mfma_f32_16x16x32_bf16(AH, BH, accQ, 0, 0, 0); }
                }
            }
            const int j = 16 * jt + fr; const float gj = gcs[j];
#pragma unroll
            for (int i4 = 0; i4 < 4; ++i4) {
                const int i = 16 * it + 4 * g + i4;
                const float dec = (j <= i) ? __expf(gcs[i] - gj) : 0.f;
                KK[i * 68 + j] = (j < i) ? accK[i4] * bet[i] * dec : 0.f;
                QKm[i * 68 + j] = accQ[i4] * dec;
            }
        }
    }
    __syncthreads();
    unsigned char* rec = P.ws() + WS_GREC + (size_t)unit * GREC_BYTES;
    {
#pragma unroll
        for (int it = 0; it < 2; ++it) {
            const int chunk = tid + it * NTHR, c = chunk >> 4, p0 = (chunk & 15) * 8; const float e = eg[c]; float v[8];
#pragma unroll
            for (int j = 0; j < 8; ++j) v[j] = Qf[c * 132 + (p0 & ~31) + perm32((p0 & 31) + j)] * e;
            u32x4 o; o.x = pk2(v[0], v[1]); o.y = pk2(v[2], v[3]); o.z = pk2(v[4], v[5]); o.w = pk2(v[6], v[7]);
            *(u32x4*)(rec + 16384 + (size_t)(c * 128 + p0) * 2) = o;
        }
        {
            const int i = tid >> 3, p0 = (tid & 7) * 8; float v[8];
#pragma unroll
            for (int j = 0; j < 8; ++j) v[j] = QKm[i * 68 + (p0 & ~31) + perm32((p0 & 31) + j)];
            u32x4 o; o.x = pk2(v[0], v[1]); o.y = pk2(v[2], v[3]); o.z = pk2(v[4], v[5]); o.w = pk2(v[6], v[7]);
            *(u32x4*)(rec + 32768 + (size_t)(i * 64 + p0) * 2) = o;
        }
        const float glast = gcs[63];
#pragma unroll
        for (int it = 0; it < 2; ++it) {
            const int chunk = tid + it * NTHR, dk = chunk & 127, p0 = (chunk >> 7) * 8; float v[8];
#pragma unroll
            for (int j = 0; j < 8; ++j) { const int c = (p0 & ~31) + perm32((p0 & 31) + j); v[j] = Kf[c * 132 + dk] * __expf(glast - gcs[c]); }
            u32x4 o; o.x = pk2(v[0], v[1]); o.y = pk2(v[2], v[3]); o.z = pk2(v[4], v[5]); o.w = pk2(v[6], v[7]);
            *(u32x4*)(rec + 40960 + (size_t)(dk * 64 + p0) * 2) = o;
        }
        if (tid == 0) ((float*)(P.ws() + WS_GLAST))[unit] = __expf(glast);
    }
    if (tid < 256) {
        const int col = tid; float sol[64];
        if (col < 128) {
#pragma unroll
            for (int j = 0; j < 64; ++j) sol[j] = Vf[j * 132 + col] * bet[j];
        } else {
#pragma unroll
            for (int j = 0; j < 64; ++j) sol[j] = Kf[j * 132 + (col - 128)] * bet[j] * eg[j];
        }
#pragma unroll
        for (int i = 1; i < 64; ++i) {
            float acc0 = 0.f, acc1 = 0.f, acc2 = 0.f, acc3 = 0.f;
#pragma unroll
            for (int j4 = 0; j4 < (i + 3) / 4; ++j4) {
                const f32x4 kk = *(const LAS f32x4*)(KK + i * 68 + 4 * j4);
                acc0 += kk.x * sol[4 * j4 + 0]; acc1 += kk.y * sol[4 * j4 + 1]; acc2 += kk.z * sol[4 * j4 + 2]; acc3 += kk.w * sol[4 * j4 + 3];
            }
            sol[i] = sol[i] - ((acc0 + acc1) + (acc2 + acc3));
        }
        if (col < 128) {
            float* U = (float*)(P.ws() + WS_GU) + (size_t)unit * 8192;
#pragma unroll
            for (int i = 0; i < 64; ++i) U[i * 128 + col] = sol[i];
        } else {
            const int dk = col - 128; const int pos = (dk & ~31) + invperm32(dk & 31);
            bf16_t* Wp = (bf16_t*)rec;
#pragma unroll
            for (int i = 0; i < 64; ++i) Wp[i * 128 + pos] = (bf16_t)f2bf(-sol[i]);
        }
    }
    __syncthreads();
}

__device__ __forceinline__ void kv_pack_unit(const Ctx& P, int unit, int tid) {
    const bf16_t* Z = (const bf16_t*)(P.ws() + WS_Z);
    const int bh = unit >> 5, blk = unit & 31, b = bh >> 2, hh = bh & 3;
    u32x4* KP = (u32x4*)(P.ws() + WS_KP) + ((size_t)bh * T + blk * 256) * 16; u32x4* VP = (u32x4*)(P.ws() + WS_VP) + ((size_t)bh * T + blk * 256) * 16;
    u32x4 kv[8], vv[8];
#pragma unroll
    for (int i = 0; i < 8; ++i) { const int c = tid + i * NTHR, row = c >> 4, ch = c & 15;
        const bf16_t* rp = Z + ((size_t)b * T + blk * 256 + row) * NZ + hh * 128 + ch * 8;
        kv[i] = *(const u32x4*)(rp + ZC_BK); vv[i] = *(const u32x4*)(rp + ZC_BV); }
#pragma unroll
    for (int i = 0; i < 8; ++i) { const int c = tid + i * NTHR; KP[c] = kv[i]; VP[c] = vv[i]; }
}


constexpr int AT_KSTR = 272, AT_VSTR = 320;
constexpr int AT_KBUF = 64 * AT_KSTR, AT_VBUF = 64 * AT_VSTR;
constexpr int AT_BUFSZ = 38 * 1024;

__device__ __forceinline__ s16x4 vtr(const LAS unsigned char* p) {
    typedef short v4i16_t __attribute__((ext_vector_type(4)));
    return __builtin_bit_cast(s16x4, __builtin_amdgcn_ds_read_tr16_b64_v4i16((LAS v4i16_t*)p));
}

template <int MODE>
__device__ __forceinline__ void attn_unit(const Ctx& P, int l, LAS unsigned char* lds, int tid, int wave, int lane,
                                          int b, int hh, int dil, int res, int m0, int branch) {
    const bf16_t* Z = (const bf16_t*)(P.ws() + WS_Z);
    const int qcol = (MODE == 0 ? ZC_BQ : ZC_DQ) + hh * 128, kcol = (MODE == 0 ? ZC_BK : ZC_DK) + hh * 128, vcol = (MODE == 0 ? ZC_BV : ZC_DV) + hh * 128;
    const size_t rowbase = (size_t)b * T + res;
    const float* FC = (const float*)(P.ws() + WS_FOXC) + (size_t)(b * 4 + hh) * T;
    const int ql = lane & 31, hi = lane >> 5;
    const int mq_lo = m0 + 32 * wave, mq = mq_lo + ql, mq_hi = mq_lo + 31;
    const int kt_lo = (MODE == 0) ? 0 : ((m0 >= 128 ? m0 - 128 : 0) >> 6), kt_hi = (m0 >> 6) + 3;
#ifdef PROBE_DBL_S
    constexpr float SC2 = 0.5f * 0.08838834764831845f * 1.4426950408889634f, L2E = 1.4426950408889634f;
#else
    constexpr float SC2 = 0.08838834764831845f * 1.4426950408889634f, L2E = 1.4426950408889634f;
#endif


    bf16x8 qf[8];
    {
        const bf16_t* qp = Z + (rowbase + (size_t)mq * dil) * NZ + qcol + 8 * hi;
#pragma unroll
        for (int ks = 0; ks < 8; ++ks) qf[ks] = *(const bf16x8*)(qp + 16 * ks);
    }
    float cq2 = 0.f;
    if (MODE == 0) cq2 = FC[mq];

    const unsigned rstride = (unsigned)dil * NZ * 2u;
    unsigned goff[5];
#pragma unroll
    for (int i = 0; i < 5; ++i) {
        const int I = wave + 8 * i; unsigned gof = 0u;
        if (I < 17) { const int o = 1024 * I + 16 * lane, row = o / AT_KSTR, cb = o - row * AT_KSTR; gof = (unsigned)row * rstride + (unsigned)kcol * 2u + (unsigned)(cb < 256 ? cb : 0); }
        else if (I < 37) { const int o = 1024 * (I - 17) + 16 * lane, row = o / AT_VSTR, cb = o - row * AT_VSTR; gof = (unsigned)row * rstride + (unsigned)vcol * 2u + (unsigned)(cb < 256 ? cb : 0); }
        goff[i] = gof;
    }
#define AT_ISSUE(kt_, slot_) do { \
        const unsigned char* tb_ = (const unsigned char*)(Z + (rowbase + (size_t)(64 * (kt_)) * dil) * NZ); \
        LAS unsigned char* lb_ = lds + (slot_) * AT_BUFSZ + 1024 * wave; \
        _Pragma("unroll") for (int i_ = 0; i_ < 4; ++i_) \
            __builtin_amdgcn_global_load_lds((const unsigned*)(tb_ + goff[i_]), (LAS unsigned*)(lb_ + 8192 * i_), 16, 0, 0); \
        { const int I_ = wave + 32; \
          const unsigned char* src_ = tb_ + goff[4]; \
          if (MODE == 0 && I_ == 37) src_ = (const unsigned char*)(FC + 64 * (kt_) + 4 * (lane & 15)); \
          LAS unsigned char* dst_ = (I_ < 38) ? (lb_ + 8192 * 4) : (lds + 3 * AT_BUFSZ + 1024 * (I_ - 38)); \
          __builtin_amdgcn_global_load_lds((const unsigned*)src_, (LAS unsigned*)dst_, 16, 0, 0); } \
    } while (0)
#define AT_WAITBAR(n_) do { asm volatile("s_waitcnt vmcnt(" #n_ ")" ::: "memory"); __builtin_amdgcn_s_barrier(); asm volatile("" ::: "memory"); } while (0)

    f32x16 O[4];
#pragma unroll
    for (int mt = 0; mt < 4; ++mt)
#pragma unroll
        for (int r = 0; r < 16; ++r) O[mt][r] = 0.f;
    float m_run = -INFINITY, l_run = 0.f;

    asm volatile("s_waitcnt vmcnt(0)" ::: "memory");
    __syncthreads();
    AT_ISSUE(kt_lo, 0);
    if (kt_lo + 1 <= kt_hi) AT_ISSUE(kt_lo + 1, 1);

    const int gq = lane >> 4, li = lane & 15, tq = li >> 2, tp = li & 3;
    const int vbase_lane = (4 * (gq >> 1) + tq) * AT_VSTR + (16 * (gq & 1) + 4 * tp) * 2;

    int slot = 0;
    for (int kt = kt_lo; kt <= kt_hi; ++kt) {
        if (kt + 1 <= kt_hi) AT_WAITBAR(5); else AT_WAITBAR(0);
        if (kt + 2 <= kt_hi) { const int s2 = (slot >= 1) ? slot - 1 : 2; AT_ISSUE(kt + 2, s2); }
        const bool need = (MODE == 0) ? (64 * kt <= mq_hi) : ((64 * kt + 63 >= mq_lo - 128) && (64 * kt <= mq_hi));
        if (need) {
            const LAS unsigned char* kb = lds + slot * AT_BUFSZ + ql * AT_KSTR + hi * 16;
            f32x16 p0, p1;
#pragma unroll
            for (int r = 0; r < 16; ++r) { p0[r] = 0.f; p1[r] = 0.f; }
#ifdef PROBE_DBL_S
#pragma unroll 1
            for (int rep = 0; rep < 2; ++rep)
#endif
#pragma unroll
            for (int ks = 0; ks < 8; ++ks) {
                const bf16x8 a0 = *(const LAS bf16x8*)(kb + ks * 32);
                const bf16x8 a1 = *(const LAS bf16x8*)(kb + 32 * AT_KSTR + ks * 32);
                p0 = __builtin_amdgcn_mfma_f32_32x32x16_bf16(a0, qf[ks], p0, 0, 0, 0);
                p1 = __builtin_amdgcn_mfma_f32_32x32x16_bf16(a1, qf[ks], p1, 0, 0, 0);
            }
            const LAS float* cb = (const LAS float*)(lds + slot * AT_BUFSZ + 37 * 1024);
            float mx = -INFINITY;
            const bool interior = (MODE == 0) ? (64 * kt + 63 <= mq_lo) : ((64 * kt + 63 <= mq_lo) && (mq_hi - 64 * kt <= 128));
            if (interior) {
#pragma unroll
                for (int a = 0; a < 4; ++a) {
                    f32x4 c0 = {0.f, 0.f, 0.f, 0.f}, c1 = {0.f, 0.f, 0.f, 0.f};
                    if (MODE == 0) { c0 = *(const LAS f32x4*)(cb + 8 * a + 4 * hi); c1 = *(const LAS f32x4*)(cb + 32 + 8 * a + 4 * hi); }
#pragma unroll
                    for (int e = 0; e < 4; ++e) {
                        const int r = 4 * a + e;
                        float s0 = p0[r] * SC2, s1 = p1[r] * SC2;
                        if (MODE == 0) { s0 += cq2 - c0[e]; s1 += cq2 - c1[e]; }
                        p0[r] = s0; p1[r] = s1; mx = fmaxf(mx, fmaxf(s0, s1));
                    }
                }
            } else
#pragma unroll
            for (int a = 0; a < 4; ++a) {
                f32x4 c0 = {0.f, 0.f, 0.f, 0.f}, c1 = {0.f, 0.f, 0.f, 0.f};
                if (MODE == 0) { c0 = *(const LAS f32x4*)(cb + 8 * a + 4 * hi); c1 = *(const LAS f32x4*)(cb + 32 + 8 * a + 4 * hi); }
#pragma unroll
                for (int e = 0; e < 4; ++e) {
                    const int r = 4 * a + e; const int k0 = 64 * kt + 8 * a + 4 * hi + e, k1 = k0 + 32;
                    float s0 = p0[r] * SC2, s1 = p1[r] * SC2;
                    if (MODE == 0) { s0 += cq2 - c0[e]; s1 += cq2 - c1[e]; }
                    const bool ok0 = (MODE == 0) ? (k0 <= mq) : (k0 <= mq && mq - k0 <= 128);
                    const bool ok1 = (MODE == 0) ? (k1 <= mq) : (k1 <= mq && mq - k1 <= 128);
                    s0 = ok0 ? s0 : -INFINITY; s1 = ok1 ? s1 : -INFINITY;
                    p0[r] = s0; p1[r] = s1; mx = fmaxf(mx, fmaxf(s0, s1));
                }
            }
            mx = fmaxf(mx, __shfl_xor(mx, 32));
            const float m_new = fmaxf(m_run, mx);
            const float m_use = (m_new == -INFINITY) ? 0.f : m_new;
            const float alpha = __builtin_amdgcn_exp2f(m_run - m_use);
            float ls = 0.f;
#pragma unroll
            for (int r = 0; r < 16; ++r) { p0[r] = __builtin_amdgcn_exp2f(p0[r] - m_use); p1[r] = __builtin_amdgcn_exp2f(p1[r] - m_use); ls += p0[r] + p1[r]; }
            const float m_run_prev = m_run;
            l_run = l_run * alpha + ls; m_run = m_new;
            if (!__all(m_new == m_run_prev)) {
#pragma unroll
            for (int mt = 0; mt < 4; ++mt)
#pragma unroll
                for (int r = 0; r < 16; ++r) O[mt][r] *= alpha;
            }
            bf16x8 pf[4];
#pragma unroll
            for (int s = 0; s < 4; ++s) {
                u32x4 w;
                if (s < 2) { w.x = pk2(p0[8 * s + 0], p0[8 * s + 1]); w.y = pk2(p0[8 * s + 2], p0[8 * s + 3]); w.z = pk2(p0[8 * s + 4], p0[8 * s + 5]); w.w = pk2(p0[8 * s + 6], p0[8 * s + 7]); }
                else { const int s2 = s - 2; w.x = pk2(p1[8 * s2 + 0], p1[8 * s2 + 1]); w.y = pk2(p1[8 * s2 + 2], p1[8 * s2 + 3]); w.z = pk2(p1[8 * s2 + 4], p1[8 * s2 + 5]); w.w = pk2(p1[8 * s2 + 6], p1[8 * s2 + 7]); }
                pf[s] = __builtin_bit_cast(bf16x8, w);
            }
            const LAS unsigned char* vb = lds + slot * AT_BUFSZ + AT_KBUF + vbase_lane;
#pragma unroll
            for (int mt = 0; mt < 4; ++mt)
#pragma unroll
                for (int s = 0; s < 4; ++s) {
                    const s16x4 lo = vtr(vb + (16 * s) * AT_VSTR + mt * 64);
                    const s16x4 hi4 = vtr(vb + (16 * s + 8) * AT_VSTR + mt * 64);
                    const bf16x8 vf = {lo[0], lo[1], lo[2], lo[3], hi4[0], hi4[1], hi4[2], hi4[3]};
                    O[mt] = __builtin_amdgcn_mfma_f32_32x32x16_bf16(vf, pf[s], O[mt], 0, 0, 0);
                }
        }
        slot = (slot == 2) ? 0 : slot + 1;
    }
#undef AT_ISSUE
#undef AT_WAITBAR
    const float l_tot = l_run + __shfl_xor(l_run, 32);
    const float inv = 1.0f / l_tot;
    const size_t orow = rowbase + (size_t)mq * dil;
    if (MODE == 0) {
        float ss = 0.f;
#pragma unroll
        for (int mt = 0; mt < 4; ++mt)
#pragma unroll
            for (int r = 0; r < 16; ++r) { O[mt][r] *= inv; ss += O[mt][r] * O[mt][r]; }
        ss += __shfl_xor(ss, 32);
        const float rn = rsqrtf(ss * (1.0f / 128.0f) + EPS);
        const float* nb = P.in(16) + l * 512 + hh * 128;
        bf16_t* yp = (bf16_t*)(P.ws() + WS_Y) + orow * DM + 512 + hh * 128;
#pragma unroll
        for (int mt = 0; mt < 4; ++mt)
#pragma unroll
            for (int a = 0; a < 4; ++a) {
                const int dv = 32 * mt + 8 * a + 4 * hi; const f32x4 g = *(const f32x4*)(nb + dv);
                u32x2 w; w.x = pk2(O[mt][4 * a + 0] * rn * g.x, O[mt][4 * a + 1] * rn * g.y); w.y = pk2(O[mt][4 * a + 2] * rn * g.z, O[mt][4 * a + 3] * rn * g.w);
                *(u32x2*)(yp + dv) = w;
            }
    } else {
        bf16_t* op = (bf16_t*)(P.ws() + WS_OD) + ((size_t)branch * M + orow) * 512 + hh * 128;
#pragma unroll
        for (int mt = 0; mt < 4; ++mt)
#pragma unroll
            for (int a = 0; a < 4; ++a) {
                const int dv = 32 * mt + 8 * a + 4 * hi;
                u32x2 w; w.x = pk2(O[mt][4 * a + 0] * inv, O[mt][4 * a + 1] * inv); w.y = pk2(O[mt][4 * a + 2] * inv, O[mt][4 * a + 3] * inv);
                *(u32x2*)(op + dv) = w;
            }
        if (hi == 0) ((float*)(P.ws() + WS_LSE))[((size_t)branch * M + orow) * 4 + hh] = (m_run + __builtin_amdgcn_logf(l_tot)) * 0.6931471805599453f;
    }
}

constexpr int GS_WP = 0, GS_QP = 64 * 272, GS_QK = 2 * 64 * 272, GS_KT = GS_QK + 64 * 144, GS_BUF = GS_KT + 128 * 144;
__device__ __forceinline__ void gdn_seq_unit(const Ctx& P, int l, int unit, LAS unsigned char* lds, int tid, int wave, int lane) {
    const int bh = unit >> 2, dvb = 32 * (unit & 3) + 16 * wave; const bool active = wave < 2;
    const int b = bh >> 2, hh = bh & 3;
    const unsigned char* recs = P.ws() + WS_GREC + (size_t)bh * 128 * GREC_BYTES;
    const float* Ug = (const float*)(P.ws() + WS_GU) + (size_t)bh * 128 * 8192;
    const float* GLv = (const float*)(P.ws() + WS_GLAST) + bh * 128;
    float* OC = (float*)(P.ws() + WS_OC);
    const int fr = lane & 15, g = lane >> 4;
    const int it = tid - 128;
#define GS_OFF(q_) (((q_) < 1024) ? (GS_WP + ((q_) >> 4) * 272 + ((q_) & 15) * 16) : (((q_) < 2048) ? (GS_QP + (((q_) - 1024) >> 4) * 272 + ((q_) & 15) * 16) : (((q_) < 2560) ? (GS_QK + (((q_) - 2048) >> 3) * 144 + ((q_) & 7) * 16) : (GS_KT + (((q_) - 2560) >> 3) * 144 + ((q_) & 7) * 16))))
#define GS_Q(i_) (((i_) < 9) ? (it + 384 * (i_)) : ((it + 3456 < 3584) ? (it + 3456) : 3583))
#define GS_LOADSET(set_, n_) do { const u32x4* src_ = (const u32x4*)(recs + (size_t)(n_) * GREC_BYTES); _Pragma("unroll") for (int i_ = 0; i_ < 10; ++i_) { set_[i_] = src_[GS_Q(i_)]; } } while (0)
#define GS_STORESET(set_, buf_) do { _Pragma("unroll") for (int i_ = 0; i_ < 10; ++i_) { const int q_ = GS_Q(i_); *(LAS u32x4*)(lds + (buf_) * GS_BUF + GS_OFF(q_)) = set_[i_]; } } while (0)
#define GS_BAR() do { asm volatile("s_waitcnt lgkmcnt(0)" ::: "memory"); __builtin_amdgcn_s_barrier(); asm volatile("" ::: "memory"); } while (0)
    __syncthreads();
    if (!active) {
        u32x4 r0[10], r1[10], r2[10];
        unsigned far_dummy = 0u;
#define GS_FAR 10
#define GS_TOUCH(n_) do { } while (0)
        GS_LOADSET(r0, 0); GS_STORESET(r0, 0); GS_LOADSET(r1, 1); GS_LOADSET(r2, 2);
#pragma unroll 1
        for (int k = 3; k < GS_FAR; ++k) GS_TOUCH(k);
        GS_BAR();
        for (int n = 0; n < 126; n += 3) {
            GS_STORESET(r1, (n + 1) & 1); GS_LOADSET(r0, n + 3); GS_TOUCH(n + GS_FAR); GS_BAR();
            GS_STORESET(r2, (n + 2) & 1); if (n + 4 < 128) GS_LOADSET(r1, n + 4); GS_TOUCH(n + 1 + GS_FAR); GS_BAR();
            GS_STORESET(r0, (n + 3) & 1); if (n + 5 < 128) GS_LOADSET(r2, n + 5); GS_TOUCH(n + 2 + GS_FAR); GS_BAR();
        }
        GS_STORESET(r1, 1); GS_BAR();
        GS_BAR();
        asm volatile("s_waitcnt vmcnt(0)" : "+v"(far_dummy) :: "memory");
#undef GS_TOUCH
#undef GS_FAR
    } else {
    f32x4 S[8];
#pragma unroll
    for (int i = 0; i < 8; ++i) S[i] = (f32x4){0.f, 0.f, 0.f, 0.f};
    f32x4 un[4]; float gln = 0.f;
    if (active) {
#pragma unroll
        for (int mt = 0; mt < 4; ++mt)
#pragma unroll
            for (int i = 0; i < 4; ++i) un[mt][i] = Ug[(16 * mt + 4 * g + i) * 128 + dvb + fr];
        gln = GLv[0];
    }
    GS_BAR();
    for (int n = 0; n < 128; ++n) {
        const int buf = n & 1;
#ifdef TG_GDN
        const unsigned long long tg0 = __builtin_amdgcn_s_memrealtime();
#endif
        {
        const LAS unsigned char* base = lds + buf * GS_BUF;
        f32x4 vn[4];
#pragma unroll
        for (int mt = 0; mt < 4; ++mt) vn[mt] = un[mt];
        const float gl = gln;
        if (n < 127) {
            const float* U = Ug + (size_t)(n + 1) * 8192;
#pragma unroll
            for (int mt = 0; mt < 4; ++mt)
#pragma unroll
                for (int i = 0; i < 4; ++i) un[mt][i] = U[(16 * mt + 4 * g + i) * 128 + dvb + fr];
            gln = GLv[n + 1];
        }
        bf16x8 sb[4];
#pragma unroll
        for (int s = 0; s < 4; ++s) {
            u32x4 w; w.x = pk2(S[2 * s][0], S[2 * s][1]); w.y = pk2(S[2 * s][2], S[2 * s][3]); w.z = pk2(S[2 * s + 1][0], S[2 * s + 1][1]); w.w = pk2(S[2 * s + 1][2], S[2 * s + 1][3]);
            sb[s] = __builtin_bit_cast(bf16x8, w);
        }
        f32x4 oa[4];
#pragma unroll
        for (int mt = 0; mt < 4; ++mt) oa[mt] = (f32x4){0.f, 0.f, 0.f, 0.f};
#pragma unroll
        for (int s = 0; s < 4; ++s) {
#pragma unroll
            for (int mt = 0; mt < 4; ++mt) {
                const bf16x8 aw = *(const LAS bf16x8*)(base + GS_WP + (16 * mt + fr) * 272 + (32 * s + 8 * g) * 2);
                const bf16x8 aq = *(const LAS bf16x8*)(base + GS_QP + (16 * mt + fr) * 272 + (32 * s + 8 * g) * 2);
                vn[mt] = __builtin_amdgcn_mfma_f32_16x16x32_bf16(aw, sb[s], vn[mt], 0, 0, 0);
                oa[mt] = __builtin_amdgcn_mfma_f32_16x16x32_bf16(aq, sb[s], oa[mt], 0, 0, 0);
            }
        }
        bf16x8 vb[2];
#pragma unroll
        for (int s = 0; s < 2; ++s) {
            u32x4 w; w.x = pk2(vn[2 * s][0], vn[2 * s][1]); w.y = pk2(vn[2 * s][2], vn[2 * s][3]); w.z = pk2(vn[2 * s + 1][0], vn[2 * s + 1][1]); w.w = pk2(vn[2 * s + 1][2], vn[2 * s + 1][3]);
            vb[s] = __builtin_bit_cast(bf16x8, w);
        }
#pragma unroll
        for (int dt = 0; dt < 8; ++dt) S[dt] = S[dt] * gl;
#pragma unroll
        for (int s = 0; s < 2; ++s) {
#pragma unroll
            for (int mt = 0; mt < 4; ++mt) {
                const bf16x8 a = *(const LAS bf16x8*)(base + GS_QK + (16 * mt + fr) * 144 + (32 * s + 8 * g) * 2);
                oa[mt] = __builtin_amdgcn_mfma_f32_16x16x32_bf16(a, vb[s], oa[mt], 0, 0, 0);
            }
#pragma unroll
            for (int dt = 0; dt < 8; ++dt) {
                const bf16x8 a = *(const LAS bf16x8*)(base + GS_KT + (16 * dt + fr) * 144 + (32 * s + 8 * g) * 2);
                S[dt] = __builtin_amdgcn_mfma_f32_16x16x32_bf16(a, vb[s], S[dt], 0, 0, 0);
            }
        }
        {
            float* op = OC + ((size_t)b * T + n * 64) * 512 + hh * 128 + dvb + fr;
#pragma unroll
            for (int mt = 0; mt < 4; ++mt)
#pragma unroll
                for (int i = 0; i < 4; ++i) op[(size_t)(16 * mt + 4 * g + i) * 512] = oa[mt][i];
        }
        }
#ifdef TG_GDN
        if (TG_GDN == 0 && tid == 0) { volatile LAS unsigned* macc = (volatile LAS unsigned*)(lds + LDS_MISC) + 2; macc[0] += (unsigned)(__builtin_amdgcn_s_memrealtime() - tg0); macc[1] += 1u; }
#endif
        GS_BAR();
#ifdef TG_GDN
        if (TG_GDN == 1 && tid == 0) { volatile LAS unsigned* macc = (volatile LAS unsigned*)(lds + LDS_MISC) + 2; macc[0] += (unsigned)(__builtin_amdgcn_s_memrealtime() - tg0); macc[1] += 1u; }
#endif
    }
    }
#undef GS_OFF
#undef GS_Q
#undef GS_LOADSET
#undef GS_STORESET
#undef GS_BAR
}

__device__ __forceinline__ void lru_final_unit(const Ctx& P, int l, int unit, int tid, int wave, int lane) {
    const bf16_t* Z = (const bf16_t*)(P.ws() + WS_Z);
    const float* LA = (const float*)(P.ws() + WS_LRUA); const float* LU = (const float*)(P.ws() + WS_LRUU); const float* AGG = (const float*)(P.ws() + WS_LAGG);
    bf16_t* Y = (bf16_t*)(P.ws() + WS_Y);
    const int b = unit >> 7, ck = unit & 127; const size_t m0 = (size_t)b * T + ck * 64; const int ch = tid;
    float h = 0.f;
    {
        const float* ag = AGG + (size_t)(b * 128) * 2 * 512 + ch;
        for (int j0 = 0; j0 < ck; j0 += 32) {
            float aa[32], hh2[32];
#pragma unroll
            for (int q = 0; q < 32; ++q) { const int j = (j0 + q < ck) ? (j0 + q) : (ck - 1); aa[q] = ag[(size_t)(j * 2 + 0) * 512]; hh2[q] = ag[(size_t)(j * 2 + 1) * 512]; }
#pragma unroll
            for (int q = 0; q < 32; ++q) { const bool ok = (j0 + q < ck); h = ok ? (aa[q] * h + hh2[q]) : h; }
        }
    }
    const float gn = P.in(15)[l * 512 + ch];
    for (int t0 = 0; t0 < 64; t0 += 16) {
        float av[16], uv[16], gv[16], hv[16], sv[16];
#pragma unroll
        for (int q = 0; q < 16; ++q) { av[q] = __builtin_nontemporal_load(LA + (m0 + t0 + q) * 512 + ch); uv[q] = __builtin_nontemporal_load(LU + (m0 + t0 + q) * 512 + ch); gv[q] = bf2f(Z[(m0 + t0 + q) * NZ + ZC_AG + ch]); }
#pragma unroll
        for (int q = 0; q < 16; ++q) { h = av[q] * h + uv[q]; hv[q] = h; sv[q] = h * h; }
#pragma unroll
        for (int o = 1; o < 64; o <<= 1) {
#pragma unroll
            for (int q = 0; q < 16; ++q) sv[q] += __shfl_xor(sv[q], o);
        }
#pragma unroll
        for (int q = 0; q < 16; ++q) {
            const float y = hv[q] * rsqrtf(sv[q] * (1.0f / 64.0f) + EPS) * gn * gelu_tanh(gv[q]);
            Y[(m0 + t0 + q) * DM + ch] = (bf16_t)f2bf(y);
        }
    }
}

__device__ __forceinline__ void finalize_phase(const Ctx& P, int l, int wave, int lane, int bid, int nblk) {
    const bf16_t* Z = (const bf16_t*)(P.ws() + WS_Z); const float* OC = (const float*)(P.ws() + WS_OC);
    const bf16_t* OD = (const bf16_t*)(P.ws() + WS_OD); const float* LSE = (const float*)(P.ws() + WS_LSE);
    bf16_t* Y = (bf16_t*)(P.ws() + WS_Y);
    const float gc0 = P.in(14)[l * 128 + 2 * lane], gc1 = P.in(14)[l * 128 + 2 * lane + 1];
    for (int m = bid * 8 + wave; m < M; m += nblk * 8) {
        float o0[4], o1[4]; unsigned zz[4], a0[4], a1[4], a2[4]; float l0[4], l1[4], l2[4], g0[4], g1[4];
#pragma unroll
        for (int hh = 0; hh < 4; ++hh) {
            const f32x2_t ov = __builtin_nontemporal_load((const f32x2_t*)(OC + (size_t)m * 512 + hh * 128 + 2 * lane)); o0[hh] = ov.x; o1[hh] = ov.y;
            zz[hh] = *(const unsigned*)(Z + (size_t)m * NZ + ZC_CZ + hh * 128 + 2 * lane);
            l0[hh] = LSE[((size_t)0 * M + m) * 4 + hh]; l1[hh] = LSE[((size_t)1 * M + m) * 4 + hh]; l2[hh] = LSE[((size_t)2 * M + m) * 4 + hh];
            a0[hh] = __builtin_nontemporal_load((const unsigned*)(OD + ((size_t)0 * M + m) * 512 + hh * 128 + 2 * lane));
            a1[hh] = __builtin_nontemporal_load((const unsigned*)(OD + ((size_t)1 * M + m) * 512 + hh * 128 + 2 * lane));
            a2[hh] = __builtin_nontemporal_load((const unsigned*)(OD + ((size_t)2 * M + m) * 512 + hh * 128 + 2 * lane));
            const f32x2_t gv = *(const f32x2_t*)(P.in(17) + l * 512 + hh * 128 + 2 * lane); g0[hh] = gv.x; g1[hh] = gv.y;
        }
        float sc[4], sd[4], d0[4], d1[4];
#pragma unroll
        for (int hh = 0; hh < 4; ++hh) {
            sc[hh] = o0[hh] * o0[hh] + o1[hh] * o1[hh];
            const float mx = fmaxf(l0[hh], fmaxf(l1[hh], l2[hh]));
            float w0 = __expf(l0[hh] - mx), w1 = __expf(l1[hh] - mx), w2 = __expf(l2[hh] - mx);
            const float inv = 1.0f / (w0 + w1 + w2); w0 *= inv; w1 *= inv; w2 *= inv;
            d0[hh] = w0 * bflo(a0[hh]) + w1 * bflo(a1[hh]) + w2 * bflo(a2[hh]); d1[hh] = w0 * bfhi(a0[hh]) + w1 * bfhi(a1[hh]) + w2 * bfhi(a2[hh]);
            sd[hh] = d0[hh] * d0[hh] + d1[hh] * d1[hh];
        }
#pragma unroll
        for (int o = 1; o < 64; o <<= 1) {
#pragma unroll
            for (int hh = 0; hh < 4; ++hh) { sc[hh] += __shfl_xor(sc[hh], o); sd[hh] += __shfl_xor(sd[hh], o); }
        }
#pragma unroll
        for (int hh = 0; hh < 4; ++hh) {
            const float rc = rsqrtf(sc[hh] * (1.0f / 128.0f) + EPS), rd = rsqrtf(sd[hh] * (1.0f / 128.0f) + EPS);
            const float z0 = bflo(zz[hh]), z1 = bfhi(zz[hh]);
            *(unsigned*)(Y + (size_t)m * DM + 1024 + hh * 128 + 2 * lane) = pk2(o0[hh] * rc * gc0 * siluf_(z0), o1[hh] * rc * gc1 * siluf_(z1));
            *(unsigned*)(Y + (size_t)m * DM + 1536 + hh * 128 + 2 * lane) = pk2(d0[hh] * rd * g0[hh], d1[hh] * rd * g1[hh]);
        }
    }
}

__device__ __forceinline__ void ffn_act_phase(const Ctx& P, int l, int tid, int bid, int nblk) {
    const bf16_t* U = (const bf16_t*)(P.ws() + WS_U); bf16_t* ACT = (bf16_t*)(P.ws() + WS_ACT);
    const float* cw = P.in(21) + (size_t)l * 3 * NFF2; const float* cb = P.in(22) + (size_t)l * NFF2;
    constexpr int CG = DFF / 8, RUN = 32, NRUN = M / RUN;
    for (int item = bid * NTHR + tid; item < CG * NRUN; item += nblk * NTHR) {
        const int cg8 = item % CG, run = item / CG; const int c0 = cg8 * 8; const size_t mstart = (size_t)run * RUN; const int tin = (int)(mstart % T);
        float wu[3][8], wg[3][8], bu[8], bg[8];
#pragma unroll
        for (int k = 0; k < 3; ++k)
#pragma unroll
            for (int e = 0; e < 8; ++e) { wu[k][e] = cw[k * NFF2 + c0 + e]; wg[k][e] = cw[k * NFF2 + DFF + c0 + e]; }
#pragma unroll
        for (int e = 0; e < 8; ++e) { bu[e] = cb[c0 + e]; bg[e] = cb[DFF + c0 + e]; }
        u32x4 u2 = {0, 0, 0, 0}, u1 = {0, 0, 0, 0}, g2 = {0, 0, 0, 0}, g1 = {0, 0, 0, 0};
        if (tin > 0) {
            u2 = *(const u32x4*)(U + (mstart - 2) * NFF2 + c0); u1 = *(const u32x4*)(U + (mstart - 1) * NFF2 + c0);
            g2 = *(const u32x4*)(U + (mstart - 2) * NFF2 + DFF + c0); g1 = *(const u32x4*)(U + (mstart - 1) * NFF2 + DFF + c0);
        }
        for (int t = 0; t < RUN; ++t) {
            const u32x4 u0 = __builtin_nontemporal_load((const u32x4*)(U + (mstart + t) * NFF2 + c0)), g0 = __builtin_nontemporal_load((const u32x4*)(U + (mstart + t) * NFF2 + DFF + c0));
            float r[8];
#pragma unroll
            for (int q = 0; q < 4; ++q) {
                const float up0 = bu[2 * q] + wu[0][2 * q] * bflo(u2[q]) + wu[1][2 * q] * bflo(u1[q]) + wu[2][2 * q] * bflo(u0[q]);
                const float up1 = bu[2 * q + 1] + wu[0][2 * q + 1] * bfhi(u2[q]) + wu[1][2 * q + 1] * bfhi(u1[q]) + wu[2][2 * q + 1] * bfhi(u0[q]);
                const float ga0 = bg[2 * q] + wg[0][2 * q] * bflo(g2[q]) + wg[1][2 * q] * bflo(g1[q]) + wg[2][2 * q] * bflo(g0[q]);
                const float ga1 = bg[2 * q + 1] + wg[0][2 * q + 1] * bfhi(g2[q]) + wg[1][2 * q + 1] * bfhi(g1[q]) + wg[2][2 * q + 1] * bfhi(g0[q]);
                r[2 * q] = siluf_(ga0) * up0; r[2 * q + 1] = siluf_(ga1) * up1;
            }
            u32x4 o; o.x = pk2(r[0], r[1]); o.y = pk2(r[2], r[3]); o.z = pk2(r[4], r[5]); o.w = pk2(r[6], r[7]);
            *(u32x4*)(ACT + (mstart + t) * DFF + c0) = o;
            u2 = u1; u1 = u0; g2 = g1; g1 = g0;
        }
    }
}

#ifndef N_LAYERS_RUN
#define N_LAYERS_RUN DEPTH
#endif
constexpr int D_NUNITS = 32 + 256 + 768 + 256;
constexpr int D_PER_Q = 4 + 32 + 96 + 32;
constexpr int D_PER_QX = D_PER_Q + 196;

__global__ void __launch_bounds__(NTHR, 2) fwd_megakernel(Params KP) {
    extern __shared__ __attribute__((aligned(16))) unsigned char lds_raw[];
    LAS unsigned char* lds0 = (LAS unsigned char*)lds_raw;
    cg::grid_group grid = cg::this_grid();
    const int tid = threadIdx.x, lane = tid & 63, wave = __builtin_amdgcn_readfirstlane(tid >> 6);
    const int bid = blockIdx.x, nblk = gridDim.x;
    volatile LAS int* misc = (volatile LAS int*)(lds0 + LDS_MISC);
    if (threadIdx.x < 16) misc[threadIdx.x] = 0;
    __syncthreads();
    XcdBarrier xbar = xcd_barrier_post((unsigned*)(KP.ws + WS_CTL) + 4096, (volatile LAS unsigned*)(lds0 + LDS_MISC) + 8);
    {
        LAS unsigned long long* tabw = (LAS unsigned long long*)(lds0 + LDS_MISC + 64);
        if (threadIdx.x == 0) {
#pragma unroll
            for (int i = 0; i < 25; ++i) tabw[i] = (unsigned long long)KP.in[i];
            tabw[25] = (unsigned long long)KP.out; tabw[26] = (unsigned long long)KP.ws;
        }
        __syncthreads();
    }
    Ctx P; P.tab = (const LAS unsigned*)(lds0 + LDS_MISC + 64);
#define WSP (P.ws())
#define XP (P.out())

#ifdef DUP_SYNC
#define GSYNC() do { grid.sync(); grid.sync(); } while (0)
#else
#define GSYNC() xcd_barrier(xbar)
#endif
#ifdef TU_TYPE
    unsigned long long tu_acc = 0, tu_cnt = 0;
#endif
#ifdef TP_GROUP
    unsigned long long tp_acc = 0, tp_t0 = 0;
#define TP_B(g) do { if ((g) == TP_GROUP) tp_t0 = __builtin_amdgcn_s_memrealtime(); } while (0)
#define TP_E(g) do { if ((g) == TP_GROUP) tp_acc += __builtin_amdgcn_s_memrealtime() - tp_t0; } while (0)
#else
#define TP_B(g)
#define TP_E(g)
#endif
    TP_B(1);
#ifndef SK_P0
    p0_prologue(P, lds0, bid * 8 + wave, nblk * 8, wave, lane);
#ifdef DUP_P0
    __syncthreads();
    p0_prologue(P, lds0, bid * 8 + wave, nblk * 8, wave, lane);
#endif
#endif
    grid.sync();
    TP_E(1);

    for (int l0 = 0; l0 < N_LAYERS_RUN; ++l0) {
#define FRESH() LAS unsigned char* lds = lds0; asm volatile("" : "+v"(lds)); int l = l0; asm volatile("" : "+s"(l)); int tid = threadIdx.x; asm volatile("" : "+v"(tid)); const int lane = tid & 63, wave = __builtin_amdgcn_readfirstlane(tid >> 6); (void)lane; (void)wave; (void)l;
        TP_B(2);
#ifndef SK_A
        { FRESH()
        norm_gates_phase(l == 0 ? P.in(0) : XP, l == 0 ? XP : nullptr, P.in(1) + l * DM, (bf16_t*)(WSP + WS_HB), (const float*)(WSP + WS_WG) + (size_t)l * 12 * DM,
                         (float*)(WSP + WS_GL), lds, tid, wave, lane, bid, nblk);
#ifdef DUP_A
        norm_phase<true>(l == 0 ? P.in(0) : XP, l == 0 ? XP : nullptr, P.in(1) + l * DM, (bf16_t*)(WSP + WS_HB), (const float*)(WSP + WS_WG) + (size_t)l * 12 * DM, (float*)(WSP + WS_GL), lds, tid, wave, lane, bid, nblk);
#endif
        }
#endif
        GSYNC(); TP_E(2);
        TP_B(6);
#ifndef SK_B
        { FRESH()
            pg8::Gemm g{(const bf16_t*)(WSP + WS_HB), (const bf16_t*)(WSP + WS_WIN) + (size_t)l * NZ * DM, M, NZ, DM};
            pg8::StaticOrder S; S.init(M, NZ, nblk, bid);
            pg8::EpiBf16<0> E{(bf16_t*)(WSP + WS_Z), NZ, nullptr, 0, 0, 1.f};
            pg8::gemm_phase<pg8::EpiBf16<0>, pg8::StaticOrder, true, true>(lds, g, S, E);
#ifdef DUP_B
            __syncthreads();
            pg8::gemm_phase<pg8::EpiBf16<0>, pg8::StaticOrder, true, true>(lds, g, S, E);
#endif
        }
#endif
        GSYNC(); TP_E(6);
        TP_B(3);
#ifdef DUP_C
        for (int pass = 0; pass < 2; ++pass)
#endif
        for (int u = bid; u < 1024 + 256 + 8; u += nblk) { FRESH()
#ifndef SK_C3
            if (u < 1024) { TP_B(10); gdn_prep_unit(P, l, u, lds, tid, wave, lane); TP_E(10); } else
#endif
#ifndef SK_C1
            if (u >= 1024 && u < 1280) { TP_B(11); __syncthreads(); lru_chunk_unit(P, l, u - 1024, lds, tid, wave, lane); __syncthreads(); TP_E(11); } else
#endif
#ifndef SK_C2
            if (u >= 1280) fox_cumsum_unit(P, l, u - 1280, lds, tid, wave, lane);
#else
            {}
#endif
        }
        GSYNC(); TP_E(3);
        TP_B(4); TP_B(8);
        {
            {
            unsigned* ctrs = (unsigned*)(WSP + WS_CTL) + 8192 + 1024 * l0;
            const int home = (int)(xbar.x & 7u);
            const int perq = (l0 < DEPTH - 1) ? D_PER_QX : D_PER_Q;
            int qoff = 0;
            for (;;) {
                __syncthreads();
                if (threadIdx.x == 0) {
                    int found = -1;
                    while (qoff < 8) {
                        const int q = (home + qoff) & 7;
                        const int j = (int)atomicAdd(ctrs + 64 * q, 1u);
                        if (j < perq) { found = q * D_PER_QX + j; break; }
                        ++qoff;
                    }
                    misc[0] = found; misc[1] = qoff;
                }
                __syncthreads();
                const int uu = misc[0]; qoff = misc[1];
                if (uu < 0) break;
                FRESH()
                const int bh = uu / D_PER_QX;
#ifdef GDN_LAST
                const int j0 = uu % D_PER_QX; const int j = (j0 < 160) ? j0 + 4 : (j0 < 164 ? j0 - 160 : j0);
#else
                const int j = uu % D_PER_QX;
#endif
#ifdef TU_TYPE
                const int tu_type = (j < 4) ? 0 : (j < 36 ? 1 : (j < 68 ? 3 : 2));
                const unsigned long long tu_t0 = __builtin_amdgcn_s_memrealtime();
#endif
                if (j < 4) gdn_seq_unit(P, l, bh * 4 + j, lds, tid, wave, lane);
                else if (j < 36) attn_unit<0>(P, l, lds, tid, wave, lane, bh >> 2, bh & 3, 1, 0, (31 - (j - 4)) * 256, 0);
                else if (j < 68) lru_final_unit(P, l, bh * 32 + (j - 36), tid, wave, lane);
                else if (j < D_PER_Q) {
                    const int jj = j - 68;
                    const int br = jj >> 5, k = jj & 31;
                    const int dil = (br == 0) ? 1 : (br == 1 ? 4 : 16);
                    const int nqb = 32 / dil;
                    const int res = k / nqb, qb = k % nqb;
                    attn_unit<1>(P, l, lds, tid, wave, lane, bh >> 2, bh & 3, dil, res, qb * 256, br);
                }
                else p0_unit(P, l + 1, bh * 196 + (j - D_PER_Q), lds, wave, lane);
#ifdef TU_TYPE
                if (tu_type == TU_TYPE && !(TU_TYPE == 1 && j - 4 > 8)) { tu_acc += __builtin_amdgcn_s_memrealtime() - tu_t0;
                    tu_cnt += (tu_type == 0) ? 128 : (tu_type == 1 ? 4 * (32 - (j - 4)) : 1); }
#endif
            }
            }
#ifdef DUP_SUB
            {
            unsigned* ctr = (unsigned*)(WSP + WS_CTL) + 64 * (1 + l0) + 32;
            for (;;) {
                __syncthreads();
                if (threadIdx.x == 0) misc[0] = (int)atomicAdd(ctr, 1u);
                __syncthreads();
                const int u = misc[0] + DUP_SUB_LO;
                if (u >= DUP_SUB_HI) break;
                FRESH()
                if (u < 32) gdn_seq_unit(P, l, u, lds, tid, wave, lane);
                else if (u < 288) { const int i = u - 32; attn_unit<0>(P, l, lds, tid, wave, lane, (i & 7) >> 2, i & 3, 1, 0, (31 - (i >> 3)) * 256, 0); }
                else if (u < 1056) {
                    const int i = u - 288; const int bh = i & 7, j = i >> 3;
                    const int br = j >> 5, k = j & 31;
                    const int dil = (br == 0) ? 1 : (br == 1 ? 4 : 16);
                    const int nqb = 32 / dil;
                    const int res = k / nqb, qb = k % nqb;
                    attn_unit<1>(P, l, lds, tid, wave, lane, bh >> 2, bh & 3, dil, res, qb * 256, br);
                }
                else lru_final_unit(P, l, u - 1056, tid, wave, lane);
            }
            }
#endif
        }
        TP_E(8); TP_B(9); GSYNC(); TP_E(9); TP_E(4);
        TP_B(2);
#ifndef SK_E
        { FRESH() finalize_phase(P, l, wave, lane, bid, nblk);
#ifdef DUP_E
          finalize_phase(P, l, wave, lane, bid, nblk);
#endif
        }
#endif
        GSYNC(); TP_E(2);
        TP_B(7);
#ifndef SK_F
        { FRESH()
            pg8::Gemm g{(const bf16_t*)(WSP + WS_Y), (const bf16_t*)(WSP + WS_WOUT) + (size_t)l * DM * DM, M, DM, DM};
            pg8::StaticOrder S; S.init(M, DM, nblk, bid);
            EpiResAdd E{XP, DM};
            pg8::gemm_phase<EpiResAdd, pg8::StaticOrder, true, true>(lds, g, S, E);
#ifdef DUP_F
            __syncthreads();
            EpiResAdd E2{(float*)(WSP + WS_ACT), DM};
            pg8::gemm_phase<EpiResAdd, pg8::StaticOrder, true, true>(lds, g, S, E2);
#endif
        }
#endif
        GSYNC(); TP_E(7);
        TP_B(2);
#ifndef SK_G
        { FRESH() norm_phase<false>(XP, nullptr, P.in(19) + l * DM, (bf16_t*)(WSP + WS_HB), nullptr, nullptr, lds, tid, wave, lane, bid, nblk);
#ifdef DUP_G
          norm_phase<false>(XP, nullptr, P.in(19) + l * DM, (bf16_t*)(WSP + WS_HB), nullptr, nullptr, lds, tid, wave, lane, bid, nblk);
#endif
        }
#endif
        GSYNC(); TP_E(2);
        TP_B(6);
#ifndef SK_H
        { FRESH()
            pg8::Gemm g{(const bf16_t*)(WSP + WS_HB), (const bf16_t*)(WSP + WS_WUP) + (size_t)l * NFF2 * DM, M, NFF2, DM};
            pg8::StaticOrder S; S.init(M, NFF2, nblk, bid);
            pg8::EpiBf16<0> E{(bf16_t*)(WSP + WS_U), NFF2, nullptr, 0, 0, 1.f};
            pg8::gemm_phase<pg8::EpiBf16<0>, pg8::StaticOrder, true, true>(lds, g, S, E);
#ifdef DUP_H
            __syncthreads();
            pg8::gemm_phase<pg8::EpiBf16<0>, pg8::StaticOrder, true, true>(lds, g, S, E);
#endif
        }
#endif
        GSYNC(); TP_E(6);
        TP_B(5);
#ifndef SK_I
        { FRESH() ffn_act_phase(P, l, tid, bid, nblk);
#ifdef DUP_I
          ffn_act_phase(P, l, tid, bid, nblk);
#endif
        }
#endif
        GSYNC(); TP_E(5);
        TP_B(7);
#ifndef SK_J
        { FRESH()
            pg8::Gemm g{(const bf16_t*)(WSP + WS_ACT), (const bf16_t*)(WSP + WS_WDN) + (size_t)l * DM * DFF, M, DM, DFF};
            pg8::StaticOrder S; S.init(M, DM, nblk, bid);
            EpiResAdd E{XP, DM};
            pg8::gemm_phase<EpiResAdd, pg8::StaticOrder, true, true>(lds, g, S, E);
#ifdef DUP_J
            __syncthreads();
            EpiResAdd E2{(float*)(WSP + WS_Z), DM};
            pg8::gemm_phase<EpiResAdd, pg8::StaticOrder, true, true>(lds, g, S, E2);
#endif
        }
#endif
        GSYNC(); TP_E(7);
    }
#ifndef SK_FN
    { int tid = threadIdx.x; asm volatile("" : "+v"(tid)); const int lane = tid & 63, wave = __builtin_amdgcn_readfirstlane(tid >> 6);
      final_norm_phase(XP, P.in(24), wave, lane, bid, nblk); }
#ifdef TG_GDN
    if (misc[3]) { const unsigned long long spin = (unsigned long long)misc[2] * 1000ull / (unsigned long long)misc[3]; const unsigned long long ts = __builtin_amdgcn_s_memrealtime(); while (__builtin_amdgcn_s_memrealtime() - ts < spin) __builtin_amdgcn_s_sleep(8); }
#endif
#ifdef TU_TYPE
    if (tu_cnt) { const unsigned long long spin = tu_acc * TU_SCALE / tu_cnt; const unsigned long long ts = __builtin_amdgcn_s_memrealtime(); while (__builtin_amdgcn_s_memrealtime() - ts < spin) __builtin_amdgcn_s_sleep(8); }
#endif
#ifdef TP_GROUP
    if (blockIdx.x == 0) { const unsigned long long ts = __builtin_amdgcn_s_memrealtime(); while (__builtin_amdgcn_s_memrealtime() - ts < tp_acc) __builtin_amdgcn_s_sleep(8); }
#endif
#endif
}

extern "C" void kernel_launch(void* const* d_in, const int* in_sizes, int n_in, void* d_out, int out_size, void* d_ws, size_t ws_size, hipStream_t stream) {
    static int grid_blocks = 0;
    if (grid_blocks == 0) {
        if (n_in != 25 || ws_size < WS_END) { fprintf(stderr, "kernel_launch: unexpected inputs (n_in %d, ws %zu < %zu)\n", n_in, ws_size, (size_t)WS_END); grid_blocks = -1; return; }
        int dev = 0, cus = 0, per_cu = 0;
        (void)hipGetDevice(&dev);
        (void)hipDeviceGetAttribute(&cus, hipDeviceAttributeMultiprocessorCount, dev);
        if (hipFuncSetAttribute((const void*)fwd_megakernel, hipFuncAttributeMaxDynamicSharedMemorySize, LDS_BYTES) != hipSuccess) { fprintf(stderr, "kernel_launch: hipFuncSetAttribute failed\n"); grid_blocks = -1; return; }
        if (hipOccupancyMaxActiveBlocksPerMultiprocessor(&per_cu, (const void*)fwd_megakernel, NTHR, LDS_BYTES) != hipSuccess || per_cu < 1) { fprintf(stderr, "kernel_launch: occupancy query says %d\n", per_cu); per_cu = 1; }
        (void)hipGetLastError();
        grid_blocks = cus * per_cu;
        if (grid_blocks > 256) grid_blocks = 256;
    }
    if (grid_blocks < 0) return;
    (void)hipMemsetAsync((char*)d_ws + WS_CTL, 0, 65536, stream);
    Params p{};
    for (int i = 0; i < 25; ++i) p.in[i] = (const float*)d_in[i];
    p.out = (float*)d_out; p.ws = (unsigned char*)d_ws;
    void* args[] = {&p};
    hipError_t e = hipLaunchCooperativeKernel((const void*)fwd_megakernel, dim3(grid_blocks), dim3(NTHR), args, LDS_BYTES, stream);
    if (e != hipSuccess) fprintf(stderr, "cooperative launch failed: %s (grid %d)\n", hipGetErrorString(e), grid_blocks);
}
```
